# Optimizing an MI355X kernel written in HIP

```python
import math
import jax, jax.numpy as jnp
from jax import lax
import numpy as np

D_MODEL = 1024
BATCH = 2
SEQ = 16384
DEPTH = 4

D_PLE = 256
SSD_WIDTH = 512
SSD_HEAD_DIM = 64
SSD_HEADS = SSD_WIDTH // SSD_HEAD_DIM
SSD_GROUPS = 2
SSD_STATE = 128
SSD_CONV = 4
SSD_CHUNK = 128
SSD_XBC = SSD_WIDTH + 2 * SSD_GROUPS * SSD_STATE
POOL_WINDOWS = (2, 4, 8, 16)
POOL_WIDTH = D_MODEL - SSD_WIDTH
POOL_GROUP = POOL_WIDTH // len(POOL_WINDOWS)
D_MIX = SSD_WIDTH + POOL_WIDTH
D_IN_PROJ = SSD_WIDTH + SSD_XBC + SSD_HEADS + POOL_WIDTH
D_FF = 2816
FFN_CONV = 3
EPS = 1e-6

kernel_name = 'hymba_ssd_pool_convffn_ple'


def rmsnorm(x, g):
    xf = x.astype(jnp.float32)
    y = xf * lax.rsqrt(jnp.mean(xf * xf, axis=-1, keepdims=True) + EPS)
    return (y * g.astype(jnp.float32)).astype(x.dtype)


def causal_dwconv(x, w, b):
    k_taps = w.shape[0]
    s = x.shape[1]
    xp = jnp.pad(x, ((0, 0), (k_taps - 1, 0), (0, 0)))
    out = b + xp[:, 0:s] * w[0]
    for k in range(1, k_taps):
        out = out + xp[:, k:k + s] * w[k]
    return out


def segsum_exp(a):
    q = a.shape[-1]
    cs = jnp.cumsum(a, axis=-1)
    diff = cs[..., :, None] - cs[..., None, :]
    mask = jnp.tril(jnp.ones((q, q), dtype=bool))
    return jnp.exp(jnp.where(mask, diff, -jnp.inf))


def ssd_scan(x, dt, A, B, C):
    b, l, h, p = x.shape
    g, n = B.shape[-2:]
    e = h // g
    q = SSD_CHUNK
    c = l // q
    X = (x * dt[..., None]).reshape(b, c, q, g, e, p)
    a = (dt * A).reshape(b, c, q, g, e).transpose(0, 3, 4, 1, 2)
    Bc = B.reshape(b, c, q, g, n)
    Cc = C.reshape(b, c, q, g, n)
    a_cs = jnp.cumsum(a, axis=-1)
    CB = jnp.einsum('bclgn,bcsgn->bgcls', Cc, Bc)
    M = CB[:, :, None] * segsum_exp(a)
    y_diag = jnp.einsum('bgecls,bcsgep->bclgep', M, X)
    decay_states = jnp.exp(a_cs[..., -1:] - a_cs).transpose(0, 3, 4, 1, 2)
    states = jnp.einsum('bclgn,bclgep->bcgepn', Bc, X * decay_states[..., None])
    chunk_decay = jnp.exp(a_cs[..., -1])

    def step(s, inp):
        dec, st = inp
        return s * dec[..., None, None] + st, s

    init = jnp.zeros((b, g, e, p, n), jnp.float32)
    _, prev = lax.scan(step, init, (jnp.moveaxis(chunk_decay, -1, 0), jnp.moveaxis(states, 1, 0)))
    y_off = jnp.einsum('bclgn,cbgepn->bclgep', Cc, prev) * jnp.exp(a_cs).transpose(0, 3, 4, 1, 2)[..., None]
    return (y_diag + y_off).reshape(b, l, h, p)


def ssd_branch(z, xbc, dt_raw, conv_w, conv_b, dt_bias, a_log, d_skip, norm_g):
    b, s, _ = z.shape
    f32 = jnp.float32
    xbc = jax.nn.silu(causal_dwconv(xbc, conv_w, conv_b))
    xs, Bm, Cm = jnp.split(xbc, [SSD_WIDTH, SSD_WIDTH + SSD_GROUPS * SSD_STATE], axis=-1)
    dt = jax.nn.softplus(dt_raw.astype(f32) + dt_bias.astype(f32))
    A = -jnp.exp(a_log.astype(f32))
    xh = xs.astype(f32).reshape(b, s, SSD_HEADS, SSD_HEAD_DIM)
    y = ssd_scan(xh, dt, A,
                 Bm.astype(f32).reshape(b, s, SSD_GROUPS, SSD_STATE),
                 Cm.astype(f32).reshape(b, s, SSD_GROUPS, SSD_STATE))
    y = y + xh * d_skip.astype(f32)[:, None]
    y = y.reshape(b, s, SSD_WIDTH) * jax.nn.silu(z.astype(f32))
    gs = SSD_WIDTH // SSD_GROUPS
    y = rmsnorm(y.reshape(b, s, SSD_GROUPS, gs), norm_g.reshape(SSD_GROUPS, gs))
    return y.reshape(b, s, SSD_WIDTH).astype(z.dtype)


def pool_branch(u, pool_w, pool_scale):
    b, s, _ = u.shape
    f32 = jnp.float32
    uf = u.astype(f32).reshape(b, s, len(POOL_WINDOWS), POOL_GROUP)
    cs = jnp.cumsum(uf, axis=1)
    pos = jnp.arange(1, s + 1, dtype=f32)
    outs = []
    for gi, w in enumerate(POOL_WINDOWS):
        c = cs[:, :, gi]
        lag = jnp.pad(c, ((0, 0), (w, 0), (0, 0)))[:, :s]
        mean = (c - lag) / jnp.minimum(pos, float(w))[:, None]
        outs.append(mean - uf[:, :, gi])
    pooled = jnp.stack(outs, axis=2)
    mixed = jnp.einsum('bsgc,gcd->bsgd', pooled, pool_w.astype(f32))
    return (mixed.reshape(b, s, POOL_WIDTH) * pool_scale.astype(f32)).astype(u.dtype)


def conv_ffn(h, w_up, conv_w, conv_b, w_down):
    up = causal_dwconv(h @ w_up, conv_w, conv_b)
    gate, val = jnp.split(up, 2, axis=-1)
    return (jax.nn.gelu(gate) * val) @ w_down


def setup_inputs(seed: int = 0) -> dict:
    key = jax.random.key(seed)
    ks = jax.random.split(key, 24)
    f32 = jnp.float32
    L = DEPTH

    def nrm(k, shape, scale):
        return jax.random.normal(k, shape, f32) * scale

    def gain(k, shape):
        return 1.0 + 0.02 * jax.random.normal(k, shape, f32)

    dt0 = jnp.exp(jax.random.uniform(ks[5], (L, SSD_HEADS), f32, math.log(1e-3), math.log(1e-1)))
    return {
        'x': jax.random.normal(ks[0], (BATCH, SEQ, D_MODEL), f32),
        'p': jax.random.normal(ks[1], (DEPTH, BATCH, SEQ, D_PLE), f32),
        'mix_norm_g': gain(ks[2], (L, D_MODEL)),
        'w_in': nrm(ks[3], (L, D_MODEL, D_IN_PROJ), D_MODEL ** -0.5),
        'ssd_conv_w': nrm(ks[4], (L, SSD_CONV, SSD_XBC), SSD_CONV ** -0.5),
        'ssd_conv_b': nrm(ks[6], (L, SSD_XBC), 0.02),
        'ssd_dt_bias': dt0 + jnp.log(-jnp.expm1(-dt0)),
        'ssd_a_log': jnp.log(jax.random.uniform(ks[7], (L, SSD_HEADS), f32, 1.0, 16.0)),
        'ssd_d': gain(ks[8], (L, SSD_HEADS)),
        'ssd_norm_g': gain(ks[9], (L, SSD_WIDTH)),
        'pool_w': nrm(ks[10], (L, len(POOL_WINDOWS), POOL_GROUP, POOL_GROUP), POOL_GROUP ** -0.5),
        'pool_scale': gain(ks[11], (L, POOL_WIDTH)),
        'w_out': nrm(ks[12], (L, D_MIX, D_MODEL), D_MIX ** -0.5),
        'ffn_norm_g': gain(ks[13], (L, D_MODEL)),
        'ffn_w_up': nrm(ks[14], (L, D_MODEL, 2 * D_FF), D_MODEL ** -0.5),
        'ffn_conv_w': nrm(ks[15], (L, FFN_CONV, 2 * D_FF), FFN_CONV ** -0.5),
        'ffn_conv_b': nrm(ks[16], (L, 2 * D_FF), 0.02),
        'ffn_w_down': nrm(ks[17], (L, D_FF, D_MODEL), D_FF ** -0.5),
        'ple_norm_g': gain(ks[18], (L, D_MODEL)),
        'ple_w_gate': nrm(ks[19], (L, D_MODEL, D_MODEL), D_MODEL ** -0.5),
        'ple_w_proj': nrm(ks[20], (L, D_PLE, D_MODEL), D_PLE ** -0.5),
        'final_norm_g': gain(ks[21], (D_MODEL,)),
    }


def reference(x, p, mix_norm_g, w_in, ssd_conv_w, ssd_conv_b, ssd_dt_bias, ssd_a_log, ssd_d, ssd_norm_g,
              pool_w, pool_scale, w_out, ffn_norm_g, ffn_w_up, ffn_conv_w, ffn_conv_b, ffn_w_down,
              ple_norm_g, ple_w_gate, ple_w_proj, final_norm_g):
    h = x
    splits = [SSD_WIDTH, SSD_WIDTH + SSD_XBC, SSD_WIDTH + SSD_XBC + SSD_HEADS]
    for i in range(DEPTH):
        proj = rmsnorm(h, mix_norm_g[i]) @ w_in[i]
        z, xbc, dt_raw, u = jnp.split(proj, splits, axis=-1)
        y_ssd = ssd_branch(z, xbc, dt_raw, ssd_conv_w[i], ssd_conv_b[i], ssd_dt_bias[i],
                           ssd_a_log[i], ssd_d[i], ssd_norm_g[i])
        y_pool = pool_branch(u, pool_w[i], pool_scale[i])
        h = h + jnp.concatenate([y_ssd, y_pool], axis=-1) @ w_out[i]
        h = h + conv_ffn(rmsnorm(h, ffn_norm_g[i]), ffn_w_up[i], ffn_conv_w[i], ffn_conv_b[i], ffn_w_down[i])
        h = h + (p[i] @ ple_w_proj[i]) * jax.nn.sigmoid(rmsnorm(h, ple_norm_g[i]) @ ple_w_gate[i])
    return rmsnorm(h, final_norm_g)
```

```cpp
#include <hip/hip_runtime.h>
#include <hip/hip_cooperative_groups.h>
#include <cstdio>
#include <cstdint>
namespace cg = cooperative_groups;
namespace pg8 {
#define PG8_LAS __attribute__((address_space(3)))
typedef unsigned short bf16_t;
typedef short bf16x8 __attribute__((ext_vector_type(8)));
typedef float f32x4 __attribute__((ext_vector_type(4)));
typedef unsigned u32x4 __attribute__((ext_vector_type(4)));
constexpr int BM = 256, BK = 64, HALF = 128, HTB = HALF * BK * 2  , STAGE_BYTES = 8 * HTB, NXCD = 8, WGM = 8;

__host__ __device__ __forceinline__ int lds_byte(int r, int c) { const int st = (r >> 4) * 2 + (c >> 5), rr = r & 15, cc = c & 31, ob = rr * 64 + cc * 2; return st * 1024 + (ob ^ (((ob >> 9) & 1) << 5)); }
__host__ __device__ __forceinline__ void stage_rc(int b, int& R, int& C) { const int st = b / 1024, sb = b % 1024, swz = sb ^ (((sb >> 9) & 1) << 5); R = (st >> 1) * 16 + swz / 64; C = (st & 1) * 32 + (swz % 64) / 2; }
__host__ __device__ __forceinline__ int perm32(int rho) { const int n = rho >> 4, i = rho & 15; return 8 * (i >> 2) + 4 * n + (i & 3); }

struct Unit { int pm, pn; };
struct Gemm { const bf16_t* A; const bf16_t* Bt; int M, N, K; };

struct StaticOrder {
    int nM, nN, nwg, G, c;
    __host__ __device__ void init(int M, int N, int G_, int c_) { nM = M / BM; nN = N / BM; nwg = nM * nN; G = G_; c = c_; }
    __host__ __device__ bool next(int i, Unit& u) const {
        const long L = (long)i * G + c; if (L >= nwg) return false;
        int wgid = (int)L; { const int q = nwg / NXCD, r = nwg % NXCD, xcd = wgid % NXCD, off = wgid / NXCD; wgid = (xcd < r ? xcd * (q + 1) : r * (q + 1) + (xcd - r) * q) + off; }
        const int nig = WGM * nN, gid = wgid / nig, fm = gid * WGM, gsz = (nM - fm) < WGM ? (nM - fm) : WGM;
        u.pm = fm + ((wgid % nig) % gsz); u.pn = (wgid % nig) / gsz; return true;
    }
    __device__ __forceinline__ void a_ready(const Unit&) const {}
    __device__ __forceinline__ void done(const Unit&) const {}
};
__device__ __forceinline__ unsigned cvt_pk_bf16(float lo, float hi) { unsigned r; asm volatile("v_cvt_pk_bf16_f32 %0, %1, %2" : "=v"(r) : "v"(lo), "v"(hi)); return r; }
template <class Epi, class Sched, bool STAMP = false>
__device__ __forceinline__ void gemm_phase(PG8_LAS unsigned char* lds, const Gemm g, const Sched& S, const Epi& E, unsigned long long* stamps) {
    int tid_ = threadIdx.x; asm volatile("" : "+v"(tid_));
    const int tid = tid_, wid = __builtin_amdgcn_readfirstlane(tid >> 6), lane = tid & 63, wr = wid >> 2, wc = wid & 3, fr = lane & 15, fq = lane >> 4;
    int K_ = g.K; asm volatile("" : "+s"(K_));
    const int K = K_, nt = K / BK;
    int ts_lo = 0, ts_hi = 0, nts = 0; const unsigned long long rt_entry = STAMP ? (unsigned long long)wall_clock64() : 0ull;
#define PG8_STAMP() do { if (STAMP && wid == 0 && nts < 64) { const unsigned long long _c = (unsigned long long)clock64(); \
        ts_lo = (lane == nts) ? (int)(unsigned)_c : ts_lo; ts_hi = (lane == nts) ? (int)(unsigned)(_c >> 32) : ts_hi; ++nts; } } while (0)
    PG8_STAMP();
    unsigned voffA[2], voffB[2];
#pragma unroll
    for (int i = 0; i < 2; ++i) { int R, C; stage_rc(tid * 16 + i * 8192, R, C); const int Rb = Epi::PERM ? ((R & ~31) + perm32(R & 31)) : R;
        voffA[i] = (unsigned)(R * K + C) * 2u; voffB[i] = (unsigned)(Rb * K + C) * 2u; }
    const size_t kstep = (size_t)(BK * 2);
    const size_t hstep = (size_t)HALF * K * 2;
    const size_t tstep = 2 * hstep;
    const unsigned ldsw = (unsigned)wid * 1024u;
    const int aoff = lds_byte(wr * 64 + fr, fq * 8), boff = lds_byte(wc * 32 + fr, fq * 8);
#define PG8_SA(b, h) (((b) * 2 + (h)) * HTB)
#define PG8_SB(b, h) ((4 + (b) * 2 + (h)) * HTB)
#define PG8_STAGE(bufoff, gbase, voff) do { _Pragma("unroll") for (int _i = 0; _i < 2; ++_i) \
        __builtin_amdgcn_global_load_lds((const unsigned*)((const char*)(gbase) + (voff)[_i]), (PG8_LAS unsigned*)(lds + (bufoff) + ldsw + _i * 8192), 16, 0, 0); } while (0)
#define PG8_LDA(dst, b, h) do { _Pragma("unroll") for (int m = 0; m < 4; ++m) _Pragma("unroll") for (int k = 0; k < 2; ++k) dst[m][k] = *(const PG8_LAS bf16x8*)(lds + PG8_SA(b, h) + aoff + m * 2048 + k * 1024); } while (0)
#define PG8_LDB(dst, b, h) do { _Pragma("unroll") for (int n = 0; n < 2; ++n) _Pragma("unroll") for (int k = 0; k < 2; ++k) dst[n][k] = *(const PG8_LAS bf16x8*)(lds + PG8_SB(b, h) + boff + n * 2048 + k * 1024); } while (0)
#define PG8_MMA(ai, bj, At, Bt) do { __builtin_amdgcn_s_setprio(1); _Pragma("unroll") for (int m = 0; m < 4; ++m) _Pragma("unroll") for (int n = 0; n < 2; ++n) _Pragma("unroll") for (int k = 0; k < 2; ++k) \
        acc[ai][bj][m][n] = __builtin_amdgcn_mfma_f32_16x16x32_bf16(Bt[n][k], At[m][k], acc[ai][bj][m][n], 0, 0, 0); __builtin_amdgcn_s_setprio(0); } while (0)
#define PG8_WAIT_V(n) asm volatile("s_waitcnt vmcnt(" #n ")" ::: "memory")
#define PG8_WAIT_L(n) asm volatile("s_waitcnt lgkmcnt(" #n ")" ::: "memory")
#define PG8_BAR __builtin_amdgcn_s_barrier()
#define PG8_SCHED __builtin_amdgcn_sched_barrier(0)
    Unit cur, nxt; int ui = 0;
    if (!S.next(0, cur)) return;
    f32x4 acc[2][2][4][2];
#pragma unroll
    for (int a = 0; a < 2; ++a)
#pragma unroll
        for (int b = 0; b < 2; ++b)
#pragma unroll
            for (int m = 0; m < 4; ++m)
#pragma unroll
                for (int n = 0; n < 2; ++n) acc[a][b][m][n] = (f32x4){0.f, 0.f, 0.f, 0.f};
    bf16x8 At[4][2], B0[2][2], B1[2][2];
    const char* cA = (const char*)g.A + (size_t)cur.pm * tstep; const char* cB = (const char*)g.Bt + (size_t)cur.pn * tstep;
    S.a_ready(cur);
    PG8_STAGE(PG8_SB(0, 0), cB, voffB); PG8_STAGE(PG8_SA(0, 0), cA, voffA); PG8_STAGE(PG8_SB(0, 1), cB + hstep, voffB); PG8_STAGE(PG8_SA(0, 1), cA + hstep, voffA);
    if (wr == 1) PG8_BAR;
    PG8_WAIT_V(4); PG8_BAR;
    PG8_STAGE(PG8_SB(1, 0), cB + kstep, voffB); PG8_STAGE(PG8_SA(1, 0), cA + kstep, voffA); PG8_STAGE(PG8_SB(1, 1), cB + hstep + kstep, voffB);
    PG8_WAIT_V(6); PG8_BAR;
    PG8_STAMP();
    for (;;) {
        const bool has_next = S.next(ui + 1, nxt);
        const char* nA = has_next ? (const char*)g.A + (size_t)nxt.pm * tstep : cA; const char* nB = has_next ? (const char*)g.Bt + (size_t)nxt.pn * tstep : cB;
        for (int t = 0; t < nt; t += 2) {
            const bool last = (t == nt - 2);
            const char* a1 = cA + (size_t)(t + 1) * kstep;
            const char* a2 = last ? nA : cA + (size_t)(t + 2) * kstep; const char* b2 = last ? nB : cB + (size_t)(t + 2) * kstep;
            const char* a3 = a2 + kstep; const char* b3 = b2 + kstep;
            if (last && has_next) S.a_ready(nxt);
            PG8_LDB(B0, 0, 0); PG8_SCHED; PG8_LDA(At, 0, 0); PG8_STAGE(PG8_SA(1, 1), a1 + hstep, voffA);
            PG8_WAIT_L(8); PG8_BAR; PG8_WAIT_L(0); PG8_MMA(0, 0, At, B0); PG8_BAR; PG8_SCHED;
            PG8_LDB(B1, 0, 1); PG8_STAGE(PG8_SB(0, 0), b2, voffB);
            PG8_BAR; PG8_WAIT_L(0); PG8_MMA(0, 1, At, B1); PG8_BAR;
            PG8_LDA(At, 0, 1); PG8_STAGE(PG8_SA(0, 0), a2, voffA);
            PG8_BAR; PG8_WAIT_L(0); PG8_MMA(1, 0, At, B0); PG8_BAR; PG8_SCHED;
            PG8_STAGE(PG8_SB(0, 1), b2 + hstep, voffB);
            PG8_WAIT_V(6); PG8_BAR; PG8_MMA(1, 1, At, B1); PG8_BAR;
            PG8_LDB(B0, 1, 0); PG8_SCHED; PG8_LDA(At, 1, 0); PG8_STAGE(PG8_SA(0, 1), a2 + hstep, voffA);
            PG8_WAIT_L(8); PG8_BAR; PG8_WAIT_L(0); PG8_MMA(0, 0, At, B0); PG8_BAR; PG8_SCHED;
            PG8_LDB(B1, 1, 1); PG8_STAGE(PG8_SB(1, 0), b3, voffB);
            PG8_BAR; PG8_WAIT_L(0); PG8_MMA(0, 1, At, B1); PG8_BAR;
            PG8_LDA(At, 1, 1); PG8_STAGE(PG8_SA(1, 0), a3, voffA);
            PG8_BAR; PG8_WAIT_L(0); PG8_MMA(1, 0, At, B0); PG8_BAR; PG8_SCHED;
            PG8_STAGE(PG8_SB(1, 1), b3 + hstep, voffB);
            PG8_WAIT_V(6); PG8_BAR; PG8_MMA(1, 1, At, B1); PG8_BAR;
        }
        PG8_STAMP();
        if constexpr (!Epi::AFTER_DRAIN) { E(acc, cur, wr, wc, fr, fq); S.done(cur); }
        PG8_STAMP();
        if (!has_next) break;
#pragma unroll
        for (int a = 0; a < 2; ++a)
#pragma unroll
            for (int b = 0; b < 2; ++b)
#pragma unroll
                for (int m = 0; m < 4; ++m)
#pragma unroll
                    for (int n = 0; n < 2; ++n) acc[a][b][m][n] = (f32x4){0.f, 0.f, 0.f, 0.f};
        cur = nxt; cA = nA; cB = nB; ++ui;
    }
    PG8_WAIT_V(0);
    if (wr == 0) PG8_BAR;
    PG8_BAR;
    if constexpr (Epi::AFTER_DRAIN) { E.fused(acc, cur, wr, wc, fr, fq, lds, wid, lane); S.done(cur); }
    PG8_STAMP();
    if (STAMP && wid == 0) { stamps[lane] = lane < nts ? (((unsigned long long)(unsigned)ts_hi << 32) | (unsigned)ts_lo) : 0ull;
        if (lane == 62) stamps[62] = rt_entry; if (lane == 63) stamps[63] = (unsigned long long)wall_clock64(); }
#undef PG8_STAMP
#undef PG8_SA
#undef PG8_SB
#undef PG8_STAGE
#undef PG8_LDA
#undef PG8_LDB
#undef PG8_MMA
#undef PG8_WAIT_V
#undef PG8_WAIT_L
#undef PG8_BAR
#undef PG8_SCHED
}
}
#define LAS __attribute__((address_space(3)))
typedef pg8::bf16_t bf16_t; typedef pg8::bf16x8 bf16x8; typedef pg8::f32x4 f32x4; typedef pg8::u32x4 u32x4;
typedef float f32x16 __attribute__((ext_vector_type(16)));
typedef unsigned u32x2 __attribute__((ext_vector_type(2)));
typedef float f32x2 __attribute__((ext_vector_type(2)));
using pg8::cvt_pk_bf16;

constexpr int T = 32768, D = 1024, SEQ = 16384, NL = 4, NPROJ = 2048, DFF = 2816, DUP = 5632, DPLE = 256;
constexpr float EPS = 1e-6f;
constexpr size_t WIN = 0, WDT = WIN + (size_t)2048 * 1024, WOUT = WDT + (size_t)16 * 1024, WUP = WOUT + (size_t)1024 * 1024, WDOWN = WUP + (size_t)5632 * 1024,
                 WGATE = WDOWN + (size_t)1024 * 2816, WPLE = WGATE + (size_t)1024 * 1024, WPOOL = WPLE + (size_t)1024 * 256, WLAYER = WPOOL + (size_t)4 * 128 * 128;
constexpr size_t OFF_HB0 = 0, OFF_HB1 = OFF_HB0 + (size_t)T * D * 2, OFF_WT = OFF_HB1 + (size_t)T * D * 2, OFF_R = OFF_WT + WLAYER * 2 * NL,
                 OFF_ST = OFF_R + (size_t)T * NPROJ * 2, OFF_MIX = OFF_R + (size_t)T * DFF * 2, OFF_TAIL = OFF_MIX + (size_t)512 * 2 * DUP * 4,
                 OFF_PB = OFF_MIX + (size_t)T * D * 2, OFF_SS = OFF_PB + (size_t)T * DPLE * 2, OFF_DT = OFF_SS + (size_t)2 * T * 16 * 4,
                 OFF_CD = OFF_DT + (size_t)T * 8 * 4, WS_END = OFF_CD + 8192;
static_assert(OFF_ST + (size_t)2 * 128 * 8 * 64 * 128 * 2 <= OFF_MIX, "states must fit behind proj");
static_assert(WS_END <= (size_t)512 * 1024 * 1024, "workspace");
constexpr int LDS_BYTES = 147456;
constexpr int PIT = 136;

struct Params {
    const float *x, *p, *mix_g, *w_in, *conv_w, *conv_b, *dt_bias, *a_log, *d_skip, *norm_g, *pool_w, *pool_scale, *w_out, *ffn_g, *w_up, *fconv_w, *fconv_b, *w_down,
        *ple_g, *w_gate, *w_ple, *final_g;
    float* out; unsigned char* ws;
};

__device__ __forceinline__ float bf_lo(unsigned u) { return __uint_as_float(u << 16); }
__device__ __forceinline__ float bf_hi(unsigned u) { return __uint_as_float(u & 0xffff0000u); }
__device__ __forceinline__ float bf2f(bf16_t b) { return __uint_as_float(((unsigned)b) << 16); }
__device__ __forceinline__ bf16_t f2bf(float f) { return (bf16_t)(cvt_pk_bf16(f, 0.f) & 0xffffu); }
__device__ __forceinline__ float fast_sigmoid(float v) { return __builtin_amdgcn_rcpf(1.f + __builtin_amdgcn_exp2f(-1.4426950409f * v)); }
__device__ __forceinline__ float silu_f(float v) { return v * fast_sigmoid(v); }
__device__ __forceinline__ float gelu_tanh(float v) { const float t = v * (1.f + 0.044715f * v * v); return v * __builtin_amdgcn_rcpf(1.f + __builtin_amdgcn_exp2f(-2.302208198f * t)); }
__device__ __forceinline__ float softplus_f(float v) { return v > 20.f ? v : log1pf(__expf(v)); }
__device__ __forceinline__ float wave_sum(float v) {
#pragma unroll
    for (int o = 1; o < 64; o <<= 1) v += __shfl_xor(v, o);
    return v;
}
template <int CTRL> __device__ __forceinline__ float dppf(float v) { return __builtin_bit_cast(float, __builtin_amdgcn_update_dpp(0, __builtin_bit_cast(int, v), CTRL, 0xf, 0xf, true)); }
__device__ __forceinline__ float row_rstd(const float* ss, int row) {
    const f32x4* p = (const f32x4*)(ss + (size_t)row * 16);
    const f32x4 a = p[0], b = p[1], c = p[2], d = p[3];
    const float s = ((a.x + a.y) + (a.z + a.w)) + ((b.x + b.y) + (b.z + b.w)) + ((c.x + c.y) + (c.z + c.w)) + ((d.x + d.y) + (d.z + d.w));
    return rsqrtf(s * (1.f / 1024.f) + EPS);
}
__device__ __forceinline__ float row_rstd_coop(const float* ss, int row, int fq) {
    const f32x4 a = *(const f32x4*)(ss + (size_t)row * 16 + 4 * fq);
    float s = (a.x + a.y) + (a.z + a.w);
    s += __shfl_xor(s, 16); s += __shfl_xor(s, 32);
    return rsqrtf(s * (1.f / 1024.f) + EPS);
}
#define LDS_FENCE() asm volatile("s_waitcnt lgkmcnt(0)" ::: "memory")

struct EpiIn {
    static constexpr bool PERM = true, AFTER_DRAIN = false;
    bf16_t* O; const float* ss;
    __device__ __forceinline__ void operator()(const f32x4 (&acc)[2][2][4][2], const pg8::Unit& u, int wr, int wc, int fr, int fq) const {
        const int col0 = u.pn * 256 + wc * 32 + 8 * fq;
#pragma unroll
        for (int ai = 0; ai < 2; ++ai)
#pragma unroll
            for (int m = 0; m < 4; ++m) {
                const int row = u.pm * 256 + ai * 128 + wr * 64 + m * 16 + fr; const float rs = row_rstd_coop(ss, row, fq);
                bf16_t* rowp = O + (size_t)row * NPROJ + col0;
#pragma unroll
                for (int bj = 0; bj < 2; ++bj) { const f32x4 v0 = acc[ai][bj][m][0] * rs, v1 = acc[ai][bj][m][1] * rs;
                    u32x4 w; w.x = cvt_pk_bf16(v0[0], v0[1]); w.y = cvt_pk_bf16(v0[2], v0[3]); w.z = cvt_pk_bf16(v1[0], v1[1]); w.w = cvt_pk_bf16(v1[2], v1[3]);
                    *(u32x4*)(rowp + bj * 128) = w; } }
    }
};
struct EpiQ {
    static constexpr bool PERM = true, AFTER_DRAIN = false;
    bf16_t* O;
    __device__ __forceinline__ void operator()(const f32x4 (&acc)[2][2][4][2], const pg8::Unit& u, int wr, int wc, int fr, int fq) const {
        const int col0 = u.pn * 256 + wc * 32 + 8 * fq;
#pragma unroll
        for (int ai = 0; ai < 2; ++ai)
#pragma unroll
            for (int m = 0; m < 4; ++m) {
                const int row = u.pm * 256 + ai * 128 + wr * 64 + m * 16 + fr; bf16_t* rowp = O + (size_t)row * D + col0;
#pragma unroll
                for (int bj = 0; bj < 2; ++bj) { const f32x4 v0 = acc[ai][bj][m][0], v1 = acc[ai][bj][m][1];
                    u32x4 w; w.x = cvt_pk_bf16(v0[0], v0[1]); w.y = cvt_pk_bf16(v0[2], v0[3]); w.z = cvt_pk_bf16(v1[0], v1[1]); w.w = cvt_pk_bf16(v1[2], v1[3]);
                    *(u32x4*)(rowp + bj * 128) = w; } }
    }
};
template <bool GATE> struct EpiRes {
    static constexpr bool PERM = false, AFTER_DRAIN = false;
    const float* hin; float* hout; bf16_t* hb; float* ssw; const float* ssr; const bf16_t* q;
    __device__ __forceinline__ void operator()(const f32x4 (&acc)[2][2][4][2], const pg8::Unit& u, int wr, int wc, int fr, int fq) const {
        const int col0 = u.pn * 256 + wc * 32 + 4 * fq;
#pragma unroll
        for (int ai = 0; ai < 2; ++ai)
#pragma unroll
            for (int m = 0; m < 4; ++m) {
                const int row = u.pm * 256 + ai * 128 + wr * 64 + m * 16 + fr; float sq = 0.f; float rs = 1.f;
                if (GATE) rs = row_rstd_coop(ssr, row, fq);
#pragma unroll
                for (int bj = 0; bj < 2; ++bj)
#pragma unroll
                    for (int n = 0; n < 2; ++n) {
                        const size_t off = (size_t)row * D + col0 + bj * 128 + n * 16;
                        f32x4 v = *(const f32x4*)(hin + off); const f32x4 a = acc[ai][bj][m][n];
                        if (GATE) { const u32x2 qq = *(const u32x2*)(q + off);
                            v[0] += bf_lo(qq.x) * fast_sigmoid(a[0] * rs); v[1] += bf_hi(qq.x) * fast_sigmoid(a[1] * rs);
                            v[2] += bf_lo(qq.y) * fast_sigmoid(a[2] * rs); v[3] += bf_hi(qq.y) * fast_sigmoid(a[3] * rs); }
                        else v += a;
                        *(f32x4*)(hout + off) = v;
                        u32x2 w; w.x = cvt_pk_bf16(v[0], v[1]); w.y = cvt_pk_bf16(v[2], v[3]); *(u32x2*)(hb + off) = w;
                        sq += (v[0] * v[0] + v[1] * v[1]) + (v[2] * v[2] + v[3] * v[3]); }
                sq += __shfl_xor(sq, 16); sq += __shfl_xor(sq, 32);
                if (fq == 0) ssw[(size_t)row * 16 + u.pn * 4 + wc] = sq; }
    }
};
struct EpiUp {
    static constexpr bool PERM = true, AFTER_DRAIN = false;
    bf16_t* act; const float* ss; const float* cw; const float* cb; float* head; float* tail;
    __device__ __forceinline__ void operator()(const f32x4 (&acc)[2][2][4][2], const pg8::Unit& u, int wr, int wc, int fr, int fq) const {
        const int jg0 = u.pn * 128 + wc * 32 + 8 * fq;
#pragma unroll
        for (int ai = 0; ai < 2; ++ai) {
            const int rbase = u.pm * 256 + ai * 128 + wr * 64 + fr, strip = u.pm * 4 + ai * 2 + wr;
            float rs[4];
#pragma unroll
            for (int m = 0; m < 4; ++m) rs[m] = row_rstd_coop(ss, rbase + 16 * m, fq);
#pragma unroll
            for (int nj = 0; nj < 4; ++nj) {
                const int n = nj >> 1, j0 = 2 * (nj & 1), jg = jg0 + 4 * n + j0;
                const f32x2 w0g = *(const f32x2*)(cw + jg), w1g = *(const f32x2*)(cw + DUP + jg), w2g = *(const f32x2*)(cw + 2 * DUP + jg), bg = *(const f32x2*)(cb + jg);
                const f32x2 w0v = *(const f32x2*)(cw + DFF + jg), w1v = *(const f32x2*)(cw + DUP + DFF + jg), w2v = *(const f32x2*)(cw + 2 * DUP + DFF + jg), bv = *(const f32x2*)(cb + DFF + jg);
                f32x2 pg = {0.f, 0.f}, pv = {0.f, 0.f};
#pragma unroll
                for (int m = 0; m < 4; ++m) {
                    const f32x2 xg = {acc[ai][0][m][n][j0] * rs[m], acc[ai][0][m][n][j0 + 1] * rs[m]}, xv = {acc[ai][1][m][n][j0] * rs[m], acc[ai][1][m][n][j0 + 1] * rs[m]};
                    if (m == 0 && fr < 2) { float* hp = head + ((size_t)(strip * 2 + fr)) * DUP + jg; *(f32x2*)hp = xg; *(f32x2*)(hp + DFF) = xv; }
                    if (m == 3 && fr >= 14) { float* tp = tail + ((size_t)(strip * 2 + fr - 14)) * DUP + jg; *(f32x2*)tp = xg; *(f32x2*)(tp + DFF) = xv; }
                    float o[2];
#pragma unroll
                    for (int j = 0; j < 2; ++j) {
                        const float g1 = dppf<0x111>(xg[j]) + dppf<0x10F>(pg[j]), g2 = dppf<0x112>(xg[j]) + dppf<0x10E>(pg[j]);
                        const float v1 = dppf<0x111>(xv[j]) + dppf<0x10F>(pv[j]), v2 = dppf<0x112>(xv[j]) + dppf<0x10E>(pv[j]);
                        const float cgv = bg[j] + w0g[j] * g2 + w1g[j] * g1 + w2g[j] * xg[j];
                        const float cvv = bv[j] + w0v[j] * v2 + w1v[j] * v1 + w2v[j] * xv[j];
                        o[j] = gelu_tanh(cgv) * cvv; }
                    if (!(m == 0 && fr < 2)) *(unsigned*)(act + (size_t)(rbase + 16 * m) * DFF + jg) = cvt_pk_bf16(o[0], o[1]);
                    pg = xg; pv = xv; } } }
    }
};
__device__ __forceinline__ void tr_item(const float* W, int ldw, bf16_t* WT, int Kd, int k0, int n0, int sc0, const float* kscale, const float* nscale, LAS float* scr, int lane) {
#pragma unroll 8
    for (int i = 0; i < 32; ++i) { const int kk = 2 * i + (lane >> 5); float v = W[(size_t)(k0 + kk) * ldw + sc0 + (lane & 31)]; if (kscale) v *= kscale[k0 + kk]; scr[kk * 33 + (lane & 31)] = v; }
    LDS_FENCE();
    const int c = lane & 7;
#pragma unroll
    for (int j = 0; j < 4; ++j) { const int n = (lane >> 3) + 8 * j; const LAS float* s = scr + (8 * c) * 33 + n; const float ns = nscale ? nscale[sc0 + n] : 1.f;
        u32x4 o; o.x = cvt_pk_bf16(s[0] * ns, s[33] * ns); o.y = cvt_pk_bf16(s[2 * 33] * ns, s[3 * 33] * ns); o.z = cvt_pk_bf16(s[4 * 33] * ns, s[5 * 33] * ns); o.w = cvt_pk_bf16(s[6 * 33] * ns, s[7 * 33] * ns);
        *(u32x4*)(WT + (size_t)(n0 + n) * Kd + k0 + 8 * c) = o; }
    LDS_FENCE();
}
__device__ __forceinline__ void phase0(const Params& P, LAS unsigned char* lds, int G, int bid) {
    int tid_ = threadIdx.x; asm volatile("" : "+v"(tid_)); const int tid = tid_, lane = tid & 63, wave = tid >> 6;
    bf16_t* wt = (bf16_t*)(P.ws + OFF_WT);
    LAS float* scr = (LAS float*)(lds + wave * 8704);
    const int gw = bid * 8 + wave, NGW = G * 8;
    constexpr int IPL = 1024 + 512 + 2816 + 1408 + 512 + 128 + 32;
    for (int it = gw; it < NL * IPL; it += NGW) {
        const int l = it / IPL; int r = it % IPL;
        bf16_t* wl = wt + (size_t)l * WLAYER;
        const float* W; int ldw, Kd, kb, nb, sc0; bf16_t* WT; const float* ks = nullptr; const float* ns = nullptr;
        if (r < 1024) { W = P.w_in + (size_t)l * 1024 * 2056; ldw = 2056; Kd = 1024; WT = wl + WIN; ks = P.mix_g + l * 1024; kb = r / 64; nb = r % 64; sc0 = 32 * nb < 1536 ? 32 * nb : 32 * nb + 8; }
        else if ((r -= 1024) < 512) { W = P.w_out + (size_t)l * 1024 * 1024; ldw = 1024; Kd = 1024; WT = wl + WOUT; kb = r / 32; nb = r % 32; sc0 = 32 * nb; }
        else if ((r -= 512) < 2816) { W = P.w_up + (size_t)l * 1024 * DUP; ldw = DUP; Kd = 1024; WT = wl + WUP; ks = P.ffn_g + l * 1024; kb = r / 176; nb = r % 176;
            const int n0 = 32 * nb, pn = n0 >> 8, rr = n0 & 255; sc0 = rr < 128 ? 128 * pn + rr : DFF + 128 * pn + (rr - 128); }
        else if ((r -= 2816) < 1408) { W = P.w_down + (size_t)l * DFF * 1024; ldw = 1024; Kd = DFF; WT = wl + WDOWN; kb = r / 32; nb = r % 32; sc0 = 32 * nb; }
        else if ((r -= 1408) < 512) { W = P.w_gate + (size_t)l * 1024 * 1024; ldw = 1024; Kd = 1024; WT = wl + WGATE; ks = P.ple_g + l * 1024; kb = r / 32; nb = r % 32; sc0 = 32 * nb; }
        else if ((r -= 512) < 128) { W = P.w_ple + (size_t)l * DPLE * 1024; ldw = 1024; Kd = DPLE; WT = wl + WPLE; kb = r / 32; nb = r % 32; sc0 = 32 * nb; }
        else { r -= 128; const int gi = r >> 3, rr = r & 7; kb = rr >> 2; nb = rr & 3; W = P.pool_w + (size_t)(l * 4 + gi) * 128 * 128; ldw = 128; Kd = 128; WT = wl + WPOOL + gi * 128 * 128;
            ns = P.pool_scale + l * 512 + gi * 128; sc0 = 32 * nb; }
        tr_item(W, ldw, WT, Kd, 64 * kb, 32 * nb, sc0, ks, ns, scr, lane);
    }
    for (int idx = bid * 512 + tid; idx < NL * 16 * 1024; idx += G * 512) {
        const int l = idx >> 14, j = (idx >> 10) & 15, k = idx & 1023;
        const float v = j < 8 ? P.w_in[(size_t)l * 1024 * 2056 + (size_t)k * 2056 + 1536 + j] * P.mix_g[l * 1024 + k] : 0.f;
        wt[(size_t)l * WLAYER + WDT + j * 1024 + k] = f2bf(v);
    }
    bf16_t* hb0 = (bf16_t*)(P.ws + OFF_HB0); float* ss0 = (float*)(P.ws + OFF_SS);
    for (int row = gw; row < T; row += NGW) {
        const f32x4* xr = (const f32x4*)(P.x + (size_t)row * D) + lane; float s = 0.f;
#pragma unroll
        for (int j = 0; j < 4; ++j) { const f32x4 v = xr[64 * j]; s += (v.x * v.x + v.y * v.y) + (v.z * v.z + v.w * v.w);
            u32x2 w; w.x = cvt_pk_bf16(v.x, v.y); w.y = cvt_pk_bf16(v.z, v.w); *(u32x2*)(hb0 + (size_t)row * D + 4 * lane + 256 * j) = w; }
        s = wave_sum(s);
        if (lane < 16) ss0[(size_t)row * 16 + lane] = lane == 0 ? s : 0.f;
    }
}

#define MFMA32(a, b, c) __builtin_amdgcn_mfma_f32_32x32x16_bf16((a), (b), (c), 0, 0, 0)
__device__ __forceinline__ void conv8x2(const bf16_t* proj, long row0, int tl0, bool seqstart, int pcol, const float* cw, const float* cb, int xch, float (&o0)[8], float (&o1)[8]) {
    unsigned v[11];
#pragma unroll
    for (int i = 0; i < 11; ++i) { const int tl = tl0 - 3 + i; v[i] = (tl >= 0 || !seqstart) ? *(const unsigned*)(proj + (size_t)(row0 + tl) * NPROJ + pcol) : 0u; }
    const f32x2 w0 = *(const f32x2*)(cw + xch), w1 = *(const f32x2*)(cw + 1024 + xch), w2 = *(const f32x2*)(cw + 2048 + xch), w3 = *(const f32x2*)(cw + 3072 + xch), bb = *(const f32x2*)(cb + xch);
#pragma unroll
    for (int i = 0; i < 8; ++i) {
        const float a = bb.x + w0.x * bf_lo(v[i]) + w1.x * bf_lo(v[i + 1]) + w2.x * bf_lo(v[i + 2]) + w3.x * bf_lo(v[i + 3]);
        const float b = bb.y + w0.y * bf_hi(v[i]) + w1.y * bf_hi(v[i + 1]) + w2.y * bf_hi(v[i + 2]) + w3.y * bf_hi(v[i + 3]);
        o0[i] = silu_f(a); o1[i] = silu_f(b); }
}
__device__ __forceinline__ float chunk_cumsum(LAS float* dtT, LAS float* acs, int wave, int lane, float Ah) {
    float last = 0.f;
    if (wave < 4) {
        const float a0 = dtT[wave * 128 + 2 * lane] * Ah, a1 = dtT[wave * 128 + 2 * lane + 1] * Ah; float v = a0 + a1;
#pragma unroll
        for (int o = 1; o < 64; o <<= 1) { const float t = __shfl_up(v, o); if (lane >= o) v += t; }
        acs[wave * 128 + 2 * lane] = v - a1; acs[wave * 128 + 2 * lane + 1] = v;
        last = __shfl(v, 63);
    }
    return last;
}
struct SsdCtx { const bf16_t* proj; const bf16_t* hb; const float* ss; const bf16_t* wdt; const float* cw; const float* cb; const float* dt_bias; const float* a_log; const float* d_skip; const float* norm_g;
                bf16_t* states; float* dtbuf; float* cdecay; bf16_t* mix; const bf16_t* pwt; };

__device__ __forceinline__ void ssd_s1_job(const SsdCtx& C, LAS unsigned char* lds, int b, int c, int g) {
    int tid_ = threadIdx.x; asm volatile("" : "+v"(tid_)); const int tid = tid_, lane = tid & 63, wave = tid >> 6;
    LAS bf16_t* XdT = (LAS bf16_t*)lds; LAS bf16_t* BT = (LAS bf16_t*)(lds + 256 * PIT * 2);
    LAS float* dtT = (LAS float*)(lds + 139264); LAS float* acs = dtT + 512;
    const long row0 = (long)b * SEQ + c * 128;
    {
        pg8::f32x4 acc = {0.f, 0.f, 0.f, 0.f};
        const bf16_t* ar = C.hb + (size_t)(row0 + 16 * wave + (lane & 15)) * D + 8 * (lane >> 4);
        const bf16_t* br = C.wdt + (size_t)(lane & 15) * D + 8 * (lane >> 4);
#pragma unroll 8
        for (int ks = 0; ks < 32; ++ks) { const bf16x8 a = *(const bf16x8*)(ar + 32 * ks), bb = *(const bf16x8*)(br + 32 * ks); acc = __builtin_amdgcn_mfma_f32_16x16x32_bf16(a, bb, acc, 0, 0, 0); }
        const int head = lane & 15;
        if (head >= 4 * g && head < 4 * g + 4) {
            const float bias = C.dt_bias[head];
#pragma unroll
            for (int rg = 0; rg < 4; ++rg) { const int tok = 16 * wave + 4 * (lane >> 4) + rg; const float rs = row_rstd(C.ss, (int)(row0 + tok));
                const float dt = softplus_f(acc[rg] * rs + bias); dtT[(head - 4 * g) * 128 + tok] = dt; C.dtbuf[(size_t)(row0 + tok) * 8 + head] = dt; } }
    }
    __syncthreads();
    {
        const float Ah = wave < 4 ? -__expf(C.a_log[4 * g + wave]) : 0.f;
        const float last = chunk_cumsum(dtT, acs, wave, lane, Ah);
        if (wave < 4 && lane == 0) C.cdecay[(size_t)(b * 128 + c) * 8 + 4 * g + wave] = __expf(last);
    }
    __syncthreads();
    for (int idx = tid; idx < 192 * 16; idx += 512) {
        const int cp = idx % 192, r = idx / 192; const bool isx = cp < 128;
        const int xch = isx ? g * 256 + 2 * cp : 512 + g * 128 + 2 * (cp - 128);
        float o0[8], o1[8];
        conv8x2(C.proj, row0, 8 * r, c == 0, 512 + xch, C.cw, C.cb, xch, o0, o1);
        if (isx) { const int hh = cp >> 5; const float al = acs[hh * 128 + 127];
#pragma unroll
            for (int i = 0; i < 8; ++i) { const float sc = dtT[hh * 128 + 8 * r + i] * __expf(al - acs[hh * 128 + 8 * r + i]); o0[i] *= sc; o1[i] *= sc; } }
        LAS bf16_t* dst = isx ? XdT + (2 * cp) * PIT + 8 * r : BT + (2 * (cp - 128)) * PIT + 8 * r;
        u32x4 w0, w1; w0.x = cvt_pk_bf16(o0[0], o0[1]); w0.y = cvt_pk_bf16(o0[2], o0[3]); w0.z = cvt_pk_bf16(o0[4], o0[5]); w0.w = cvt_pk_bf16(o0[6], o0[7]);
        w1.x = cvt_pk_bf16(o1[0], o1[1]); w1.y = cvt_pk_bf16(o1[2], o1[3]); w1.z = cvt_pk_bf16(o1[4], o1[5]); w1.w = cvt_pk_bf16(o1[6], o1[7]);
        *(LAS u32x4*)dst = w0; *(LAS u32x4*)(dst + PIT) = w1;
    }
    __syncthreads();
    {
        const int hh = wave >> 1, nh = wave & 1, r = lane & 31, hq = lane >> 5;
        f32x16 acc[2][2];
#pragma unroll
        for (int i = 0; i < 2; ++i)
#pragma unroll
            for (int j = 0; j < 2; ++j)
#pragma unroll
                for (int e = 0; e < 16; ++e) acc[i][j][e] = 0.f;
#pragma unroll 2
        for (int ks = 0; ks < 8; ++ks) {
            bf16x8 a[2], bb[2];
#pragma unroll
            for (int i = 0; i < 2; ++i) { a[i] = *(const LAS bf16x8*)(XdT + (64 * hh + 32 * i + r) * PIT + 16 * ks + 8 * hq); bb[i] = *(const LAS bf16x8*)(BT + (64 * nh + 32 * i + r) * PIT + 16 * ks + 8 * hq); }
#pragma unroll
            for (int i = 0; i < 2; ++i)
#pragma unroll
                for (int j = 0; j < 2; ++j) acc[i][j] = MFMA32(a[i], bb[j], acc[i][j]);
        }
        bf16_t* st = C.states + ((size_t)(b * 128 + c) * 8 + 4 * g + hh) * 64 * 128;
#pragma unroll
        for (int i = 0; i < 2; ++i)
#pragma unroll
            for (int j = 0; j < 2; ++j)
#pragma unroll
                for (int e = 0; e < 16; ++e) { const int p = 32 * i + (e & 3) + 8 * (e >> 2) + 4 * hq, n = 64 * nh + 32 * j + r; st[p * 128 + n] = f2bf(acc[i][j][e]); }
    }
    __syncthreads();
}

template <int W> __device__ __forceinline__ void pool_fill(const bf16_t* proj, long row0, bool seqstart, int gi, LAS bf16_t* Pl, int tid) {
    const int cp = tid & 63, run = tid >> 6, pcol = 1536 + gi * 128 + 2 * cp;
    float u0[31], u1[31];
#pragma unroll
    for (int i = 0; i < 31; ++i) { const int tl = 16 * run - 15 + i; const unsigned v = (tl >= 0 || !seqstart) ? *(const unsigned*)(proj + (size_t)(row0 + tl) * NPROJ + pcol) : 0u; u0[i] = bf_lo(v); u1[i] = bf_hi(v); }
    float s0 = 0.f, s1 = 0.f;
#pragma unroll
    for (int j = 1; j < W; ++j) { s0 += u0[15 - j]; s1 += u1[15 - j]; }
#pragma unroll
    for (int i = 0; i < 16; ++i) {
        s0 += u0[15 + i]; s1 += u1[15 + i];
        const int tl = 16 * run + i; const float dv = seqstart ? (float)(tl + 1 < W ? tl + 1 : W) : (float)W; const float inv = 1.f / dv;
        *(LAS unsigned*)(Pl + tl * PIT + 2 * cp) = cvt_pk_bf16(s0 * inv - u0[15 + i], s1 * inv - u1[15 + i]);
        s0 -= u0[15 + i - (W - 1)]; s1 -= u1[15 + i - (W - 1)];
    }
}
__device__ __forceinline__ void pool_job(const SsdCtx& C, LAS unsigned char* lds, int tb, int gi) {
    int tid_ = threadIdx.x; asm volatile("" : "+v"(tid_)); const int tid = tid_, lane = tid & 63, wave = tid >> 6;
    LAS bf16_t* Pl = (LAS bf16_t*)lds; LAS bf16_t* Wp = (LAS bf16_t*)(lds + 128 * PIT * 2);
    const long row0 = (long)tb * 128; const bool seqstart = (tb & 127) == 0;
    for (int i = tid; i < 2048; i += 512) { const int d = i >> 4, c8 = i & 15; *(LAS u32x4*)(Wp + d * PIT + 8 * c8) = *(const u32x4*)(C.pwt + (size_t)gi * 16384 + d * 128 + 8 * c8); }
    if (gi == 0) pool_fill<2>(C.proj, row0, seqstart, gi, Pl, tid); else if (gi == 1) pool_fill<4>(C.proj, row0, seqstart, gi, Pl, tid);
    else if (gi == 2) pool_fill<8>(C.proj, row0, seqstart, gi, Pl, tid); else pool_fill<16>(C.proj, row0, seqstart, gi, Pl, tid);
    __syncthreads();
    {
        const int mi = wave >> 1, r = lane & 31, hq = lane >> 5;
        f32x16 acc[2];
#pragma unroll
        for (int j = 0; j < 2; ++j)
#pragma unroll
            for (int e = 0; e < 16; ++e) acc[j][e] = 0.f;
#pragma unroll 2
        for (int ks = 0; ks < 8; ++ks) {
            const bf16x8 a = *(const LAS bf16x8*)(Pl + (32 * mi + r) * PIT + 16 * ks + 8 * hq);
#pragma unroll
            for (int j = 0; j < 2; ++j) { const int ni = 2 * (wave & 1) + j; const bf16x8 bb = *(const LAS bf16x8*)(Wp + (32 * ni + r) * PIT + 16 * ks + 8 * hq); acc[j] = MFMA32(a, bb, acc[j]); }
        }
#pragma unroll
        for (int j = 0; j < 2; ++j) { const int ni = 2 * (wave & 1) + j;
#pragma unroll
            for (int e = 0; e < 16; ++e) { const int tl = 32 * mi + (e & 3) + 8 * (e >> 2) + 4 * hq; C.mix[(size_t)(row0 + tl) * D + 512 + gi * 128 + 32 * ni + r] = f2bf(acc[j][e]); } }
    }
    __syncthreads();
}

__device__ __forceinline__ void scan_phase(bf16_t* states, const float* cdecay, int G, int bid) {
    int tid_ = threadIdx.x; asm volatile("" : "+v"(tid_));
    for (int idx = bid * 512 + tid_; idx < 2 * 8 * 64 * 128; idx += G * 512) {
        const int n = idx & 127, p = (idx >> 7) & 63, h = (idx >> 13) & 7, b = idx >> 16;
        bf16_t* sp = states + ((size_t)b * 128 * 8 + h) * 8192 + p * 128 + n; const float* dp = cdecay + (size_t)b * 128 * 8 + h;
        float s = 0.f;
        for (int c0 = 0; c0 < 128; c0 += 16) {
            float v[16], d[16];
#pragma unroll
            for (int i = 0; i < 16; ++i) { v[i] = bf2f(sp[(size_t)(c0 + i) * 8 * 8192]); d[i] = dp[(c0 + i) * 8]; }
#pragma unroll
            for (int i = 0; i < 16; ++i) { sp[(size_t)(c0 + i) * 8 * 8192] = f2bf(s); s = s * d[i] + v[i]; }
        }
    }
}
__device__ __forceinline__ void ssd_s3_job(const SsdCtx& C, LAS unsigned char* lds, int b, int c, int g) {
    int tid_ = threadIdx.x; asm volatile("" : "+v"(tid_)); const int tid = tid_, lane = tid & 63, wave = tid >> 6;
    LAS bf16_t* Cn = (LAS bf16_t*)lds; LAS bf16_t* CBm = (LAS bf16_t*)(lds + 128 * PIT * 2); LAS bf16_t* Bn = (LAS bf16_t*)(lds + 256 * PIT * 2); LAS bf16_t* XT = Bn;
    LAS float* dtT = (LAS float*)(lds + 139264); LAS float* acs = dtT + 512; LAS float* red = dtT + 1024;
    const long row0 = (long)b * SEQ + c * 128;
    { const int tok = tid >> 2, hh = tid & 3; dtT[hh * 128 + tok] = C.dtbuf[(size_t)(row0 + tok) * 8 + 4 * g + hh]; }
    __syncthreads();
    { const float Ah = wave < 4 ? -__expf(C.a_log[4 * g + wave]) : 0.f; (void)chunk_cumsum(dtT, acs, wave, lane, Ah); }
    for (int idx = tid; idx < 128 * 16; idx += 512) {
        const int cp = idx & 127, r = idx >> 7; const bool isB = cp < 64;
        const int xch = isB ? 512 + g * 128 + 2 * cp : 768 + g * 128 + 2 * (cp - 64);
        float o0[8], o1[8];
        conv8x2(C.proj, row0, 8 * r, c == 0, 512 + xch, C.cw, C.cb, xch, o0, o1);
        LAS bf16_t* dst = (isB ? Bn + 2 * cp : Cn + 2 * (cp - 64)) + (8 * r) * PIT;
#pragma unroll
        for (int i = 0; i < 8; ++i) *(LAS unsigned*)(dst + i * PIT) = cvt_pk_bf16(o0[i], o1[i]);
    }
    __syncthreads();
    {
        const int mi = wave >> 1, r = lane & 31, hq = lane >> 5;
        f32x16 acc[2];
#pragma unroll
        for (int j = 0; j < 2; ++j)
#pragma unroll
            for (int e = 0; e < 16; ++e) acc[j][e] = 0.f;
#pragma unroll 2
        for (int ks = 0; ks < 8; ++ks) {
            const bf16x8 a = *(const LAS bf16x8*)(Cn + (32 * mi + r) * PIT + 16 * ks + 8 * hq);
#pragma unroll
            for (int j = 0; j < 2; ++j) { const int ni = 2 * (wave & 1) + j; const bf16x8 bb = *(const LAS bf16x8*)(Bn + (32 * ni + r) * PIT + 16 * ks + 8 * hq); acc[j] = MFMA32(a, bb, acc[j]); }
        }
#pragma unroll
        for (int j = 0; j < 2; ++j) { const int ni = 2 * (wave & 1) + j;
#pragma unroll
            for (int e = 0; e < 16; ++e) { const int l = 32 * mi + (e & 3) + 8 * (e >> 2) + 4 * hq; CBm[l * PIT + 32 * ni + r] = f2bf(acc[j][e]); } }
    }
    __syncthreads();
    for (int idx = tid; idx < 128 * 16; idx += 512) {
        const int cp = idx & 127, r = idx >> 7; const int xch = g * 256 + 2 * cp;
        float o0[8], o1[8];
        conv8x2(C.proj, row0, 8 * r, c == 0, 512 + xch, C.cw, C.cb, xch, o0, o1);
        LAS bf16_t* dst = XT + (2 * cp) * PIT + 8 * r;
        u32x4 w0, w1; w0.x = cvt_pk_bf16(o0[0], o0[1]); w0.y = cvt_pk_bf16(o0[2], o0[3]); w0.z = cvt_pk_bf16(o0[4], o0[5]); w0.w = cvt_pk_bf16(o0[6], o0[7]);
        w1.x = cvt_pk_bf16(o1[0], o1[1]); w1.y = cvt_pk_bf16(o1[2], o1[3]); w1.z = cvt_pk_bf16(o1[4], o1[5]); w1.w = cvt_pk_bf16(o1[6], o1[7]);
        *(LAS u32x4*)dst = w0; *(LAS u32x4*)(dst + PIT) = w1;
    }
    __syncthreads();
    const int hh = wave >> 1, lh = wave & 1, r = lane & 31, hq = lane >> 5, h = 4 * g + hh;
    f32x16 acc[2][2];
#pragma unroll
    for (int i = 0; i < 2; ++i)
#pragma unroll
        for (int j = 0; j < 2; ++j)
#pragma unroll
            for (int e = 0; e < 16; ++e) acc[i][j][e] = 0.f;
    {
        const bf16_t* pv = C.states + ((size_t)(b * 128 + c) * 8 + h) * 64 * 128;
#pragma unroll 2
        for (int ks = 0; ks < 8; ++ks) {
            bf16x8 a[2], bb[2];
#pragma unroll
            for (int i = 0; i < 2; ++i) { a[i] = *(const bf16x8*)(pv + (32 * i + r) * 128 + 16 * ks + 8 * hq); bb[i] = *(const LAS bf16x8*)(Cn + (64 * lh + 32 * i + r) * PIT + 16 * ks + 8 * hq); }
#pragma unroll
            for (int i = 0; i < 2; ++i)
#pragma unroll
                for (int j = 0; j < 2; ++j) acc[i][j] = MFMA32(a[i], bb[j], acc[i][j]);
        }
#pragma unroll
        for (int j = 0; j < 2; ++j) { const float el = __expf(acs[hh * 128 + 64 * lh + 32 * j + r]);
#pragma unroll
            for (int i = 0; i < 2; ++i)
#pragma unroll
                for (int e = 0; e < 16; ++e) acc[i][j][e] *= el; }
    }
#pragma unroll
    for (int li = 0; li < 2; ++li) {
        const int l = 64 * lh + 32 * li + r; const float al = acs[hh * 128 + l];
        const int nks = 4 * lh + 2 * li + 2;
        for (int ks = 0; ks < nks; ++ks) {
            const int s0 = 16 * ks + 8 * hq;
            const u32x4 cb = *(const LAS u32x4*)(CBm + l * PIT + s0);
            const f32x4 as0 = *(const LAS f32x4*)(acs + hh * 128 + s0), as1 = *(const LAS f32x4*)(acs + hh * 128 + s0 + 4);
            const f32x4 d0 = *(const LAS f32x4*)(dtT + hh * 128 + s0), d1 = *(const LAS f32x4*)(dtT + hh * 128 + s0 + 4);
            float m[8];
            m[0] = bf_lo(cb.x) * __expf(al - as0[0]) * d0[0]; m[1] = bf_hi(cb.x) * __expf(al - as0[1]) * d0[1];
            m[2] = bf_lo(cb.y) * __expf(al - as0[2]) * d0[2]; m[3] = bf_hi(cb.y) * __expf(al - as0[3]) * d0[3];
            m[4] = bf_lo(cb.z) * __expf(al - as1[0]) * d1[0]; m[5] = bf_hi(cb.z) * __expf(al - as1[1]) * d1[1];
            m[6] = bf_lo(cb.w) * __expf(al - as1[2]) * d1[2]; m[7] = bf_hi(cb.w) * __expf(al - as1[3]) * d1[3];
#pragma unroll
            for (int j = 0; j < 8; ++j) m[j] = (s0 + j <= l) ? m[j] : 0.f;
            u32x4 mw; mw.x = cvt_pk_bf16(m[0], m[1]); mw.y = cvt_pk_bf16(m[2], m[3]); mw.z = cvt_pk_bf16(m[4], m[5]); mw.w = cvt_pk_bf16(m[6], m[7]);
            const bf16x8 mf = __builtin_bit_cast(bf16x8, mw);
#pragma unroll
            for (int pi = 0; pi < 2; ++pi) { const bf16x8 a = *(const LAS bf16x8*)(XT + (64 * hh + 32 * pi + r) * PIT + s0); acc[pi][li] = MFMA32(a, mf, acc[pi][li]); }
        }
    }
    const float Dh = C.d_skip[h];
    float sq[2] = {0.f, 0.f};
#pragma unroll
    for (int li = 0; li < 2; ++li) { const int l = 64 * lh + 32 * li + r;
#pragma unroll
        for (int pi = 0; pi < 2; ++pi)
#pragma unroll
            for (int e4 = 0; e4 < 4; ++e4) { const int p0 = 32 * pi + 8 * e4 + 4 * hq;
                const u32x2 zz = *(const u32x2*)(C.proj + (size_t)(row0 + l) * NPROJ + g * 256 + hh * 64 + p0);
                const float zf[4] = {bf_lo(zz.x), bf_hi(zz.x), bf_lo(zz.y), bf_hi(zz.y)};
#pragma unroll
                for (int k = 0; k < 4; ++k) { const float xs = bf2f(XT[(64 * hh + p0 + k) * PIT + l]); float y = acc[pi][li][4 * e4 + k] + xs * Dh; y *= silu_f(zf[k]); acc[pi][li][4 * e4 + k] = y; sq[li] += y * y; } }
        sq[li] += __shfl_xor(sq[li], 32);
        if (hq == 0) red[hh * 128 + l] = sq[li]; }
    __syncthreads();
#pragma unroll
    for (int li = 0; li < 2; ++li) { const int l = 64 * lh + 32 * li + r;
        const float rstd = rsqrtf((red[l] + red[128 + l] + red[256 + l] + red[384 + l]) * (1.f / 256.f) + EPS);
#pragma unroll
        for (int pi = 0; pi < 2; ++pi)
#pragma unroll
            for (int e4 = 0; e4 < 4; ++e4) { const int p0 = 32 * pi + 8 * e4 + 4 * hq, ch = g * 256 + hh * 64 + p0;
                const f32x4 ng = *(const f32x4*)(C.norm_g + ch);
                u32x2 w; w.x = cvt_pk_bf16(acc[pi][li][4 * e4] * rstd * ng[0], acc[pi][li][4 * e4 + 1] * rstd * ng[1]); w.y = cvt_pk_bf16(acc[pi][li][4 * e4 + 2] * rstd * ng[2], acc[pi][li][4 * e4 + 3] * rstd * ng[3]);
                *(u32x2*)(C.mix + (size_t)(row0 + l) * D + ch) = w; } }
    __syncthreads();
}

__device__ __forceinline__ void fixup_phase(const Params& P, int l, bf16_t* act, const float* head, const float* tail, bf16_t* pb, int G, int bid) {
    const float* cw = P.fconv_w + (size_t)l * 3 * DUP; const float* cb = P.fconv_b + (size_t)l * DUP;
    int tid_ = threadIdx.x; asm volatile("" : "+v"(tid_)); const int gt = bid * 512 + tid_, NT = G * 512;
    for (int idx = gt; idx < 512 * DFF; idx += NT) {
        const int s = idx / DFF, j = idx % DFF; const bool first = (s & 255) == 0;
        float o[2];
        float cvals[2][2];
#pragma unroll
        for (int gv = 0; gv < 2; ++gv) { const int col = j + gv * DFF;
            const float tm2 = first ? 0.f : tail[(size_t)((s - 1) * 2) * DUP + col], tm1 = first ? 0.f : tail[(size_t)((s - 1) * 2 + 1) * DUP + col];
            const float h0 = head[(size_t)(s * 2) * DUP + col], h1 = head[(size_t)(s * 2 + 1) * DUP + col];
            const float w0 = cw[col], w1 = cw[DUP + col], w2 = cw[2 * DUP + col], bb = cb[col];
            cvals[gv][0] = bb + w0 * tm2 + w1 * tm1 + w2 * h0; cvals[gv][1] = bb + w0 * tm1 + w1 * h0 + w2 * h1; }
        o[0] = gelu_tanh(cvals[0][0]) * cvals[1][0]; o[1] = gelu_tanh(cvals[0][1]) * cvals[1][1];
        act[(size_t)(64 * s) * DFF + j] = f2bf(o[0]); act[(size_t)(64 * s + 1) * DFF + j] = f2bf(o[1]);
    }
    const f32x4* ps = (const f32x4*)(P.p + (size_t)l * T * DPLE);
    for (int idx = gt; idx < T * DPLE / 4; idx += NT) { const f32x4 v = ps[idx]; u32x2 w; w.x = cvt_pk_bf16(v.x, v.y); w.y = cvt_pk_bf16(v.z, v.w); *(u32x2*)(pb + (size_t)idx * 4) = w; }
}

__global__ __launch_bounds__(512, 2) void hymba_fwd(Params P) {
    extern __shared__ __attribute__((aligned(16))) unsigned char shm[];
    LAS unsigned char* lds = (LAS unsigned char*)shm;
    cg::grid_group grid = cg::this_grid();
    const int G = (int)gridDim.x, bid = (int)blockIdx.x;
    bf16_t* hbuf[2] = {(bf16_t*)(P.ws + OFF_HB0), (bf16_t*)(P.ws + OFF_HB1)};
    float* ssbuf[2] = {(float*)(P.ws + OFF_SS), (float*)(P.ws + OFF_SS) + (size_t)T * 16};
    bf16_t* wt = (bf16_t*)(P.ws + OFF_WT);
    bf16_t* proj = (bf16_t*)(P.ws + OFF_R); bf16_t* act = proj; bf16_t* states = (bf16_t*)(P.ws + OFF_ST);
    bf16_t* mix = (bf16_t*)(P.ws + OFF_MIX); bf16_t* qb = mix; float* head = (float*)(P.ws + OFF_MIX); float* tail = (float*)(P.ws + OFF_TAIL);
    bf16_t* pb = (bf16_t*)(P.ws + OFF_PB); float* dtbuf = (float*)(P.ws + OFF_DT); float* cdecay = (float*)(P.ws + OFF_CD);
    pg8::StaticOrder S;

    phase0(P, lds, G, bid);
    grid.sync();
    int cur = 0;
#pragma unroll 1
    for (int l = 0; l < NL; ++l) {
        const bf16_t* wl = wt + (size_t)l * WLAYER;
        bf16_t* hb = cur ? hbuf[1] : hbuf[0]; bf16_t* hbn = cur ? hbuf[0] : hbuf[1];
        float* ss = cur ? ssbuf[1] : ssbuf[0]; float* ssn = cur ? ssbuf[0] : ssbuf[1];
        { S.init(T, NPROJ, G, bid); EpiIn E{proj, ss}; pg8::gemm_phase<EpiIn, pg8::StaticOrder>(lds, pg8::Gemm{hb, wl + WIN, T, NPROJ, D}, S, E, nullptr); }
        grid.sync();
        SsdCtx C{proj, hb, ss, wl + WDT, P.conv_w + (size_t)l * 4 * 1024, P.conv_b + (size_t)l * 1024, P.dt_bias + l * 8, P.a_log + l * 8, P.d_skip + l * 8, P.norm_g + l * 512,
                 states, dtbuf, cdecay, mix, wl + WPOOL};
        for (int job = bid; job < 512 + 1024; job += G) {
            if (job < 512) ssd_s1_job(C, lds, job >> 8, (job >> 1) & 127, job & 1);
            else { const int j = job - 512; pool_job(C, lds, j >> 2, j & 3); }
        }
        grid.sync();
        scan_phase(states, cdecay, G, bid);
        grid.sync();
        for (int job = bid; job < 512; job += G) ssd_s3_job(C, lds, job >> 8, (job >> 1) & 127, job & 1);
        grid.sync();
        { S.init(T, D, G, bid); EpiRes<false> E{l == 0 ? P.x : P.out, P.out, hb, ss, nullptr, nullptr}; pg8::gemm_phase<EpiRes<false>, pg8::StaticOrder>(lds, pg8::Gemm{mix, wl + WOUT, T, D, D}, S, E, nullptr); }
        grid.sync();
        { S.init(T, DUP, G, bid); EpiUp E{act, ss, P.fconv_w + (size_t)l * 3 * DUP, P.fconv_b + (size_t)l * DUP, head, tail}; pg8::gemm_phase<EpiUp, pg8::StaticOrder>(lds, pg8::Gemm{hb, wl + WUP, T, DUP, D}, S, E, nullptr); }
        grid.sync();
        fixup_phase(P, l, act, head, tail, pb, G, bid);
        grid.sync();
        { S.init(T, D, G, bid); EpiRes<false> E{P.out, P.out, hb, ss, nullptr, nullptr}; pg8::gemm_phase<EpiRes<false>, pg8::StaticOrder>(lds, pg8::Gemm{act, wl + WDOWN, T, D, DFF}, S, E, nullptr); }
        { S.init(T, D, G, bid); EpiQ E{qb}; pg8::gemm_phase<EpiQ, pg8::StaticOrder>(lds, pg8::Gemm{pb, wl + WPLE, T, D, DPLE}, S, E, nullptr); }
        grid.sync();
        { S.init(T, D, G, bid); EpiRes<true> E{P.out, P.out, hbn, ssn, ss, qb}; pg8::gemm_phase<EpiRes<true>, pg8::StaticOrder>(lds, pg8::Gemm{hb, wl + WGATE, T, D, D}, S, E, nullptr); }
        grid.sync();
        cur ^= 1;
    }
    {
        const int lane = threadIdx.x & 63, wave = threadIdx.x >> 6;
        const float* ss = cur ? ssbuf[1] : ssbuf[0];
        for (int row = bid * 8 + wave; row < T; row += G * 8) {
            const float rs = row_rstd(ss, row); f32x4* xr = (f32x4*)(P.out + (size_t)row * D) + lane; const f32x4* gr = (const f32x4*)P.final_g + lane;
#pragma unroll
            for (int j = 0; j < 4; ++j) { f32x4 v = xr[64 * j]; const f32x4 gg = gr[64 * j]; v = v * rs * gg; xr[64 * j] = v; }
        }
    }
}

extern "C" void kernel_launch(void* const* d_in, const int* in_sizes, int n_in, void* d_out, int out_size, void* d_ws, size_t ws_size, hipStream_t stream) {
    static int grid = 0;
    if (grid == 0) {
        if (n_in != 22 || ws_size < WS_END) { fprintf(stderr, "kernel_launch: unexpected inputs (n_in %d, ws %zu, need %zu)\n", n_in, ws_size, (size_t)WS_END); grid = -1; return; }
        int dev = 0, cus = 0, per_cu = 0;
        (void)hipGetDevice(&dev); (void)hipDeviceGetAttribute(&cus, hipDeviceAttributeMultiprocessorCount, dev);
        if (hipFuncSetAttribute((const void*)hymba_fwd, hipFuncAttributeMaxDynamicSharedMemorySize, LDS_BYTES) != hipSuccess) { fprintf(stderr, "kernel_launch: hipFuncSetAttribute failed\n"); grid = -1; return; }
        if (hipOccupancyMaxActiveBlocksPerMultiprocessor(&per_cu, (const void*)hymba_fwd, 512, LDS_BYTES) != hipSuccess || per_cu < 1) { fprintf(stderr, "kernel_launch: occupancy query says %d blocks per CU\n", per_cu); per_cu = 1; }
        (void)hipGetLastError();
        grid = cus;
    }
    if (grid < 0) return;
    Params p{};
    const float** pp = (const float**)&p;
    for (int i = 0; i < 22; ++i) pp[i] = (const float*)d_in[i];
    p.out = (float*)d_out; p.ws = (unsigned char*)d_ws;
    void* args[] = {&p};
    hipError_t e = hipLaunchCooperativeKernel((const void*)hymba_fwd, dim3(grid), dim3(512), args, LDS_BYTES, stream);
    if (e != hipSuccess) fprintf(stderr, "cooperative launch failed: %s (grid %d)\n", hipGetErrorString(e), grid);
}
```

```cpp
#include <hip/hip_runtime.h>
#include <hip/hip_cooperative_groups.h>
#include <cstdio>
#include <cstdint>
namespace cg = cooperative_groups;
namespace pg8 {
#define PG8_LAS __attribute__((address_space(3)))
typedef unsigned short bf16_t;
typedef short bf16x8 __attribute__((ext_vector_type(8)));
typedef float f32x4 __attribute__((ext_vector_type(4)));
typedef unsigned u32x4 __attribute__((ext_vector_type(4)));
constexpr int BM = 256, BK = 64, HALF = 128, HTB = HALF * BK * 2  , STAGE_BYTES = 8 * HTB, NXCD = 8, WGM = 8;

__host__ __device__ __forceinline__ int lds_byte(int r, int c) { const int st = (r >> 4) * 2 + (c >> 5), rr = r & 15, cc = c & 31, ob = rr * 64 + cc * 2; return st * 1024 + (ob ^ (((ob >> 9) & 1) << 5)); }
__host__ __device__ __forceinline__ void stage_rc(int b, int& R, int& C) { const int st = b / 1024, sb = b % 1024, swz = sb ^ (((sb >> 9) & 1) << 5); R = (st >> 1) * 16 + swz / 64; C = (st & 1) * 32 + (swz % 64) / 2; }
__host__ __device__ __forceinline__ int perm32(int rho) { const int n = rho >> 4, i = rho & 15; return 8 * (i >> 2) + 4 * n + (i & 3); }

struct Unit { int pm, pn; };
struct Gemm { const bf16_t* A; const bf16_t* Bt; int M, N, K; };

struct StaticOrder {
    int nM, nN, nwg, G, c;
    __host__ __device__ void init(int M, int N, int G_, int c_) { nM = M / BM; nN = N / BM; nwg = nM * nN; G = G_; c = c_; }
    __host__ __device__ bool next(int i, Unit& u) const {
        const long L = (long)i * G + c; if (L >= nwg) return false;
        int wgid = (int)L; { const int q = nwg / NXCD, r = nwg % NXCD, xcd = wgid % NXCD, off = wgid / NXCD; wgid = (xcd < r ? xcd * (q + 1) : r * (q + 1) + (xcd - r) * q) + off; }
        const int nig = WGM * nN, gid = wgid / nig, fm = gid * WGM, gsz = (nM - fm) < WGM ? (nM - fm) : WGM;
        u.pm = fm + ((wgid % nig) % gsz); u.pn = (wgid % nig) / gsz; return true;
    }
    __device__ __forceinline__ void a_ready(const Unit&) const {}
    __device__ __forceinline__ void done(const Unit&) const {}
};
__device__ __forceinline__ unsigned cvt_pk_bf16(float lo, float hi) { unsigned r; asm volatile("v_cvt_pk_bf16_f32 %0, %1, %2" : "=v"(r) : "v"(lo), "v"(hi)); return r; }
template <class Epi, class Sched, bool STAMP = false>
__device__ __forceinline__ void gemm_phase(PG8_LAS unsigned char* lds, const Gemm g, const Sched& S, const Epi& E, unsigned long long* stamps) {
    int tid_ = threadIdx.x; asm volatile("" : "+v"(tid_));
    const int tid = tid_, wid = __builtin_amdgcn_readfirstlane(tid >> 6), lane = tid & 63, wr = wid >> 2, wc = wid & 3, fr = lane & 15, fq = lane >> 4;
    int K_ = g.K; asm volatile("" : "+s"(K_));
    const int K = K_, nt = K / BK;
    int ts_lo = 0, ts_hi = 0, nts = 0; const unsigned long long rt_entry = STAMP ? (unsigned long long)wall_clock64() : 0ull;
#define PG8_STAMP() do { if (STAMP && wid == 0 && nts < 64) { const unsigned long long _c = (unsigned long long)clock64(); \
        ts_lo = (lane == nts) ? (int)(unsigned)_c : ts_lo; ts_hi = (lane == nts) ? (int)(unsigned)(_c >> 32) : ts_hi; ++nts; } } while (0)
    PG8_STAMP();
    unsigned voffA[2], voffB[2];
#pragma unroll
    for (int i = 0; i < 2; ++i) { int R, C; stage_rc(tid * 16 + i * 8192, R, C); const int Rb = Epi::PERM ? ((R & ~31) + perm32(R & 31)) : R;
        voffA[i] = (unsigned)(R * K + C) * 2u; voffB[i] = (unsigned)(Rb * K + C) * 2u; }
    const size_t kstep = (size_t)(BK * 2);
    const size_t hstep = (size_t)HALF * K * 2;
    const size_t tstep = 2 * hstep;
    const unsigned ldsw = (unsigned)wid * 1024u;
    const int aoff = lds_byte(wr * 64 + fr, fq * 8), boff = lds_byte(wc * 32 + fr, fq * 8);
#define PG8_SA(b, h) (((b) * 2 + (h)) * HTB)
#define PG8_SB(b, h) ((4 + (b) * 2 + (h)) * HTB)
#define PG8_STAGE(bufoff, gbase, voff) do { _Pragma("unroll") for (int _i = 0; _i < 2; ++_i) \
        __builtin_amdgcn_global_load_lds((const unsigned*)((const char*)(gbase) + (voff)[_i]), (PG8_LAS unsigned*)(lds + (bufoff) + ldsw + _i * 8192), 16, 0, 0); } while (0)
#define PG8_LDA(dst, b, h) do { _Pragma("unroll") for (int m = 0; m < 4; ++m) _Pragma("unroll") for (int k = 0; k < 2; ++k) dst[m][k] = *(const PG8_LAS bf16x8*)(lds + PG8_SA(b, h) + aoff + m * 2048 + k * 1024); } while (0)
#define PG8_LDB(dst, b, h) do { _Pragma("unroll") for (int n = 0; n < 2; ++n) _Pragma("unroll") for (int k = 0; k < 2; ++k) dst[n][k] = *(const PG8_LAS bf16x8*)(lds + PG8_SB(b, h) + boff + n * 2048 + k * 1024); } while (0)
#define PG8_MMA(ai, bj, At, Bt) do { __builtin_amdgcn_s_setprio(1); _Pragma("unroll") for (int m = 0; m < 4; ++m) _Pragma("unroll") for (int n = 0; n < 2; ++n) _Pragma("unroll") for (int k = 0; k < 2; ++k) \
        acc[ai][bj][m][n] = __builtin_amdgcn_mfma_f32_16x16x32_bf16(Bt[n][k], At[m][k], acc[ai][bj][m][n], 0, 0, 0); __builtin_amdgcn_s_setprio(0); } while (0)
#define PG8_WAIT_V(n) asm volatile("s_waitcnt vmcnt(" #n ")" ::: "memory")
#define PG8_WAIT_L(n) asm volatile("s_waitcnt lgkmcnt(" #n ")" ::: "memory")
#define PG8_BAR __builtin_amdgcn_s_barrier()
#define PG8_SCHED __builtin_amdgcn_sched_barrier(0)
    Unit cur, nxt; int ui = 0;
    if (!S.next(0, cur)) return;
    f32x4 acc[2][2][4][2];
#pragma unroll
    for (int a = 0; a < 2; ++a)
#pragma unroll
        for (int b = 0; b < 2; ++b)
#pragma unroll
            for (int m = 0; m < 4; ++m)
#pragma unroll
                for (int n = 0; n < 2; ++n) acc[a][b][m][n] = (f32x4){0.f, 0.f, 0.f, 0.f};
    bf16x8 At[4][2], B0[2][2], B1[2][2];
    const char* cA = (const char*)g.A + (size_t)cur.pm * tstep; const char* cB = (const char*)g.Bt + (size_t)cur.pn * tstep;
    S.a_ready(cur);
    PG8_STAGE(PG8_SB(0, 0), cB, voffB); PG8_STAGE(PG8_SA(0, 0), cA, voffA); PG8_STAGE(PG8_SB(0, 1), cB + hstep, voffB); PG8_STAGE(PG8_SA(0, 1), cA + hstep, voffA);
    if (wr == 1) PG8_BAR;
    PG8_WAIT_V(4); PG8_BAR;
    PG8_STAGE(PG8_SB(1, 0), cB + kstep, voffB); PG8_STAGE(PG8_SA(1, 0), cA + kstep, voffA); PG8_STAGE(PG8_SB(1, 1), cB + hstep + kstep, voffB);
    PG8_WAIT_V(6); PG8_BAR;
    PG8_STAMP();
    for (;;) {
        const bool has_next = S.next(ui + 1, nxt);
        const char* nA = has_next ? (const char*)g.A + (size_t)nxt.pm * tstep : cA; const char* nB = has_next ? (const char*)g.Bt + (size_t)nxt.pn * tstep : cB;
        for (int t = 0; t < nt; t += 2) {
            const bool last = (t == nt - 2);
            const char* a1 = cA + (size_t)(t + 1) * kstep;
            const char* a2 = last ? nA : cA + (size_t)(t + 2) * kstep; const char* b2 = last ? nB : cB + (size_t)(t + 2) * kstep;
            const char* a3 = a2 + kstep; const char* b3 = b2 + kstep;
            if (last && has_next) S.a_ready(nxt);
            PG8_LDB(B0, 0, 0); PG8_SCHED; PG8_LDA(At, 0, 0); PG8_STAGE(PG8_SA(1, 1), a1 + hstep, voffA);
            PG8_WAIT_L(8); PG8_BAR; PG8_WAIT_L(0); PG8_MMA(0, 0, At, B0); PG8_BAR; PG8_SCHED;
            PG8_LDB(B1, 0, 1); PG8_STAGE(PG8_SB(0, 0), b2, voffB);
            PG8_BAR; PG8_WAIT_L(0); PG8_MMA(0, 1, At, B1); PG8_BAR;
            PG8_LDA(At, 0, 1); PG8_STAGE(PG8_SA(0, 0), a2, voffA);
            PG8_BAR; PG8_WAIT_L(0); PG8_MMA(1, 0, At, B0); PG8_BAR; PG8_SCHED;
            PG8_STAGE(PG8_SB(0, 1), b2 + hstep, voffB);
            PG8_WAIT_V(6); PG8_BAR; PG8_MMA(1, 1, At, B1); PG8_BAR;
            PG8_LDB(B0, 1, 0); PG8_SCHED; PG8_LDA(At, 1, 0); PG8_STAGE(PG8_SA(0, 1), a2 + hstep, voffA);
            PG8_WAIT_L(8); PG8_BAR; PG8_WAIT_L(0); PG8_MMA(0, 0, At, B0); PG8_BAR; PG8_SCHED;
            PG8_LDB(B1, 1, 1); PG8_STAGE(PG8_SB(1, 0), b3, voffB);
            PG8_BAR; PG8_WAIT_L(0); PG8_MMA(0, 1, At, B1); PG8_BAR;
            PG8_LDA(At, 1, 1); PG8_STAGE(PG8_SA(1, 0), a3, voffA);
            PG8_BAR; PG8_WAIT_L(0); PG8_MMA(1, 0, At, B0); PG8_BAR; PG8_SCHED;
            PG8_STAGE(PG8_SB(1, 1), b3 + hstep, voffB);
            PG8_WAIT_V(6); PG8_BAR; PG8_MMA(1, 1, At, B1); PG8_BAR;
        }
        PG8_STAMP();
        if constexpr (!Epi::AFTER_DRAIN) { E(acc, cur, wr, wc, fr, fq); S.done(cur); }
        PG8_STAMP();
        if (!has_next) break;
#pragma unroll
        for (int a = 0; a < 2; ++a)
#pragma unroll
            for (int b = 0; b < 2; ++b)
#pragma unroll
                for (int m = 0; m < 4; ++m)
#pragma unroll
                    for (int n = 0; n < 2; ++n) acc[a][b][m][n] = (f32x4){0.f, 0.f, 0.f, 0.f};
        cur = nxt; cA = nA; cB = nB; ++ui;
    }
    PG8_WAIT_V(0);
    if (wr == 0) PG8_BAR;
    PG8_BAR;
    if constexpr (Epi::AFTER_DRAIN) { E.fused(acc, cur, wr, wc, fr, fq, lds, wid, lane); S.done(cur); }
    PG8_STAMP();
    if (STAMP && wid == 0) { stamps[lane] = lane < nts ? (((unsigned long long)(unsigned)ts_hi << 32) | (unsigned)ts_lo) : 0ull;
        if (lane == 62) stamps[62] = rt_entry; if (lane == 63) stamps[63] = (unsigned long long)wall_clock64(); }
#undef PG8_STAMP
#undef PG8_SA
#undef PG8_SB
#undef PG8_STAGE
#undef PG8_LDA
#undef PG8_LDB
#undef PG8_MMA
#undef PG8_WAIT_V
#undef PG8_WAIT_L
#undef PG8_BAR
#undef PG8_SCHED
}
}
#define LAS __attribute__((address_space(3)))
typedef pg8::bf16_t bf16_t; typedef pg8::bf16x8 bf16x8; typedef pg8::f32x4 f32x4; typedef pg8::u32x4 u32x4;
typedef float f32x16 __attribute__((ext_vector_type(16)));
typedef unsigned u32x2 __attribute__((ext_vector_type(2)));
typedef float f32x2 __attribute__((ext_vector_type(2)));
using pg8::cvt_pk_bf16;

constexpr int T = 32768, D = 1024, SEQ = 16384, NL = 4, NPROJ = 2048, DFF = 2816, DUP = 5632, DPLE = 256;
constexpr float EPS = 1e-6f;
constexpr size_t WIN = 0, WDT = WIN + (size_t)2048 * 1024, WOUT = WDT + (size_t)16 * 1024, WUP = WOUT + (size_t)1024 * 1024, WDOWN = WUP + (size_t)5632 * 1024,
                 WGATE = WDOWN + (size_t)1024 * 2816, WPLE = WGATE + (size_t)1024 * 1024, WPOOL = WPLE + (size_t)1024 * 256, WLAYER = WPOOL + (size_t)4 * 128 * 128;
constexpr size_t OFF_HB0 = 0, OFF_HB1 = OFF_HB0 + (size_t)T * D * 2, OFF_WT = OFF_HB1 + (size_t)T * D * 2, OFF_R = OFF_WT + WLAYER * 2 * NL,
                 OFF_ST = OFF_R + (size_t)T * NPROJ * 2, OFF_MIX = OFF_R + (size_t)T * DFF * 2, OFF_TAIL = OFF_MIX + (size_t)512 * 2 * DUP * 4,
                 OFF_PB = OFF_MIX + (size_t)T * D * 2, OFF_SS = OFF_PB + (size_t)T * DPLE * 2, OFF_DT = OFF_SS + (size_t)2 * T * 16 * 4,
                 OFF_CD = OFF_DT + (size_t)T * 8 * 4, OFF_BAR = OFF_CD + 8192, WS_END = OFF_BAR + 16384;
static_assert(OFF_ST + (size_t)2 * 128 * 8 * 64 * 128 * 2 <= OFF_MIX, "states must fit behind proj");
static_assert(WS_END <= (size_t)512 * 1024 * 1024, "workspace");
constexpr int LDS_BYTES = 147456;
constexpr int PIT = 136;

struct Params {
    const float *x, *p, *mix_g, *w_in, *conv_w, *conv_b, *dt_bias, *a_log, *d_skip, *norm_g, *pool_w, *pool_scale, *w_out, *ffn_g, *w_up, *fconv_w, *fconv_b, *w_down,
        *ple_g, *w_gate, *w_ple, *final_g;
    float* out; unsigned char* ws;
};

__device__ __forceinline__ float bf_lo(unsigned u) { return __uint_as_float(u << 16); }
__device__ __forceinline__ float bf_hi(unsigned u) { return __uint_as_float(u & 0xffff0000u); }
__device__ __forceinline__ float bf2f(bf16_t b) { return __uint_as_float(((unsigned)b) << 16); }
__device__ __forceinline__ bf16_t f2bf(float f) { return (bf16_t)(cvt_pk_bf16(f, 0.f) & 0xffffu); }
__device__ __forceinline__ float fast_sigmoid(float v) { return __builtin_amdgcn_rcpf(1.f + __builtin_amdgcn_exp2f(-1.4426950409f * v)); }
__device__ __forceinline__ float silu_f(float v) { return v * fast_sigmoid(v); }
__device__ __forceinline__ float gelu_tanh(float v) { const float t = v * (1.f + 0.044715f * v * v); return v * __builtin_amdgcn_rcpf(1.f + __builtin_amdgcn_exp2f(-2.302208198f * t)); }
__device__ __forceinline__ float softplus_f(float v) { return v > 20.f ? v : log1pf(__expf(v)); }
__device__ __forceinline__ float wave_sum(float v) {
#pragma unroll
    for (int o = 1; o < 64; o <<= 1) v += __shfl_xor(v, o);
    return v;
}
template <int CTRL> __device__ __forceinline__ float dppf(float v) { return __builtin_bit_cast(float, __builtin_amdgcn_update_dpp(0, __builtin_bit_cast(int, v), CTRL, 0xf, 0xf, true)); }
__device__ __forceinline__ float row_rstd(const float* ss, int row) {
    const f32x4* p = (const f32x4*)(ss + (size_t)row * 16);
    const f32x4 a = p[0], b = p[1], c = p[2], d = p[3];
    const float s = ((a.x + a.y) + (a.z + a.w)) + ((b.x + b.y) + (b.z + b.w)) + ((c.x + c.y) + (c.z + c.w)) + ((d.x + d.y) + (d.z + d.w));
    return rsqrtf(s * (1.f / 1024.f) + EPS);
}
__device__ __forceinline__ float row_rstd_coop(const float* ss, int row, int fq) {
    const f32x4 a = *(const f32x4*)(ss + (size_t)row * 16 + 4 * fq);
    float s = (a.x + a.y) + (a.z + a.w);
    s += __shfl_xor(s, 16); s += __shfl_xor(s, 32);
    return rsqrtf(s * (1.f / 1024.f) + EPS);
}
#define LDS_FENCE() asm volatile("s_waitcnt lgkmcnt(0)" ::: "memory")

struct EpiIn {
    static constexpr bool PERM = true, AFTER_DRAIN = false;
    bf16_t* O; const float* ss;
    __device__ __forceinline__ void operator()(const f32x4 (&acc)[2][2][4][2], const pg8::Unit& u, int wr, int wc, int fr, int fq) const {
        const int col0 = u.pn * 256 + wc * 32 + 8 * fq;
#pragma unroll
        for (int ai = 0; ai < 2; ++ai)
#pragma unroll
            for (int m = 0; m < 4; ++m) {
                const int row = u.pm * 256 + ai * 128 + wr * 64 + m * 16 + fr; const float rs = row_rstd_coop(ss, row, fq);
                bf16_t* rowp = O + (size_t)row * NPROJ + col0;
#pragma unroll
                for (int bj = 0; bj < 2; ++bj) { const f32x4 v0 = acc[ai][bj][m][0] * rs, v1 = acc[ai][bj][m][1] * rs;
                    u32x4 w; w.x = cvt_pk_bf16(v0[0], v0[1]); w.y = cvt_pk_bf16(v0[2], v0[3]); w.z = cvt_pk_bf16(v1[0], v1[1]); w.w = cvt_pk_bf16(v1[2], v1[3]);
                    *(u32x4*)(rowp + bj * 128) = w; } }
    }
};
struct EpiQ {
    static constexpr bool PERM = true, AFTER_DRAIN = false;
    bf16_t* O;
    __device__ __forceinline__ void operator()(const f32x4 (&acc)[2][2][4][2], const pg8::Unit& u, int wr, int wc, int fr, int fq) const {
        const int col0 = u.pn * 256 + wc * 32 + 8 * fq;
#pragma unroll
        for (int ai = 0; ai < 2; ++ai)
#pragma unroll
            for (int m = 0; m < 4; ++m) {
                const int row = u.pm * 256 + ai * 128 + wr * 64 + m * 16 + fr; bf16_t* rowp = O + (size_t)row * D + col0;
#pragma unroll
                for (int bj = 0; bj < 2; ++bj) { const f32x4 v0 = acc[ai][bj][m][0], v1 = acc[ai][bj][m][1];
                    u32x4 w; w.x = cvt_pk_bf16(v0[0], v0[1]); w.y = cvt_pk_bf16(v0[2], v0[3]); w.z = cvt_pk_bf16(v1[0], v1[1]); w.w = cvt_pk_bf16(v1[2], v1[3]);
                    *(u32x4*)(rowp + bj * 128) = w; } }
    }
};
template <bool GATE> struct EpiRes {
    static constexpr bool PERM = false, AFTER_DRAIN = false;
    const float* hin; float* hout; bf16_t* hb; float* ssw; const float* ssr; const bf16_t* q;
    __device__ __forceinline__ void operator()(const f32x4 (&acc)[2][2][4][2], const pg8::Unit& u, int wr, int wc, int fr, int fq) const {
        const int col0 = u.pn * 256 + wc * 32 + 4 * fq;
#pragma unroll
        for (int ai = 0; ai < 2; ++ai)
#pragma unroll
            for (int m = 0; m < 4; ++m) {
                const int row = u.pm * 256 + ai * 128 + wr * 64 + m * 16 + fr; float sq = 0.f; float rs = 1.f;
                if (GATE) rs = row_rstd_coop(ssr, row, fq);
#pragma unroll
                for (int bj = 0; bj < 2; ++bj)
#pragma unroll
                    for (int n = 0; n < 2; ++n) {
                        const size_t off = (size_t)row * D + col0 + bj * 128 + n * 16;
                        f32x4 v = *(const f32x4*)(hin + off); const f32x4 a = acc[ai][bj][m][n];
                        if (GATE) { const u32x2 qq = *(const u32x2*)(q + off);
                            v[0] += bf_lo(qq.x) * fast_sigmoid(a[0] * rs); v[1] += bf_hi(qq.x) * fast_sigmoid(a[1] * rs);
                            v[2] += bf_lo(qq.y) * fast_sigmoid(a[2] * rs); v[3] += bf_hi(qq.y) * fast_sigmoid(a[3] * rs); }
                        else v += a;
                        *(f32x4*)(hout + off) = v;
                        u32x2 w; w.x = cvt_pk_bf16(v[0], v[1]); w.y = cvt_pk_bf16(v[2], v[3]); *(u32x2*)(hb + off) = w;
                        sq += (v[0] * v[0] + v[1] * v[1]) + (v[2] * v[2] + v[3] * v[3]); }
                sq += __shfl_xor(sq, 16); sq += __shfl_xor(sq, 32);
                if (fq == 0) ssw[(size_t)row * 16 + u.pn * 4 + wc] = sq; }
    }
};
struct EpiUp {
    static constexpr bool PERM = true, AFTER_DRAIN = false;
    bf16_t* act; const float* ss; const float* cw; const float* cb; float* head; float* tail;
    __device__ __forceinline__ void operator()(const f32x4 (&acc)[2][2][4][2], const pg8::Unit& u, int wr, int wc, int fr, int fq) const {
        const int jg0 = u.pn * 128 + wc * 32 + 8 * fq;
#pragma unroll
        for (int ai = 0; ai < 2; ++ai) {
            const int rbase = u.pm * 256 + ai * 128 + wr * 64 + fr, strip = u.pm * 4 + ai * 2 + wr;
            float rs[4];
#pragma unroll
            for (int m = 0; m < 4; ++m) rs[m] = row_rstd_coop(ss, rbase + 16 * m, fq);
#pragma unroll
            for (int nj = 0; nj < 4; ++nj) {
                const int n = nj >> 1, j0 = 2 * (nj & 1), jg = jg0 + 4 * n + j0;
                const f32x2 w0g = *(const f32x2*)(cw + jg), w1g = *(const f32x2*)(cw + DUP + jg), w2g = *(const f32x2*)(cw + 2 * DUP + jg), bg = *(const f32x2*)(cb + jg);
                const f32x2 w0v = *(const f32x2*)(cw + DFF + jg), w1v = *(const f32x2*)(cw + DUP + DFF + jg), w2v = *(const f32x2*)(cw + 2 * DUP + DFF + jg), bv = *(const f32x2*)(cb + DFF + jg);
                f32x2 pg = {0.f, 0.f}, pv = {0.f, 0.f};
#pragma unroll
                for (int m = 0; m < 4; ++m) {
                    const f32x2 xg = {acc[ai][0][m][n][j0] * rs[m], acc[ai][0][m][n][j0 + 1] * rs[m]}, xv = {acc[ai][1][m][n][j0] * rs[m], acc[ai][1][m][n][j0 + 1] * rs[m]};
                    if (m == 0 && fr < 2) { float* hp = head + ((size_t)(strip * 2 + fr)) * DUP + jg; *(f32x2*)hp = xg; *(f32x2*)(hp + DFF) = xv; }
                    if (m == 3 && fr >= 14) { float* tp = tail + ((size_t)(strip * 2 + fr - 14)) * DUP + jg; *(f32x2*)tp = xg; *(f32x2*)(tp + DFF) = xv; }
                    float o[2];
#pragma unroll
                    for (int j = 0; j < 2; ++j) {
                        const float g1 = dppf<0x111>(xg[j]) + dppf<0x10F>(pg[j]), g2 = dppf<0x112>(xg[j]) + dppf<0x10E>(pg[j]);
                        const float v1 = dppf<0x111>(xv[j]) + dppf<0x10F>(pv[j]), v2 = dppf<0x112>(xv[j]) + dppf<0x10E>(pv[j]);
                        const float cgv = bg[j] + w0g[j] * g2 + w1g[j] * g1 + w2g[j] * xg[j];
                        const float cvv = bv[j] + w0v[j] * v2 + w1v[j] * v1 + w2v[j] * xv[j];
                        o[j] = gelu_tanh(cgv) * cvv; }
                    if (!(m == 0 && fr < 2)) *(unsigned*)(act + (size_t)(rbase + 16 * m) * DFF + jg) = cvt_pk_bf16(o[0], o[1]);
                    pg = xg; pv = xv; } } }
    }
};
__device__ __forceinline__ void tr_item(const float* W, int ldw, bf16_t* WT, int Kd, int k0, int n0, int sc0, const float* kscale, const float* nscale, LAS float* scr, int lane) {
#pragma unroll 8
    for (int i = 0; i < 32; ++i) { const int kk = 2 * i + (lane >> 5); float v = W[(size_t)(k0 + kk) * ldw + sc0 + (lane & 31)]; if (kscale) v *= kscale[k0 + kk]; scr[kk * 33 + (lane & 31)] = v; }
    LDS_FENCE();
    const int c = lane & 7;
#pragma unroll
    for (int j = 0; j < 4; ++j) { const int n = (lane >> 3) + 8 * j; const LAS float* s = scr + (8 * c) * 33 + n; const float ns = nscale ? nscale[sc0 + n] : 1.f;
        u32x4 o; o.x = cvt_pk_bf16(s[0] * ns, s[33] * ns); o.y = cvt_pk_bf16(s[2 * 33] * ns, s[3 * 33] * ns); o.z = cvt_pk_bf16(s[4 * 33] * ns, s[5 * 33] * ns); o.w = cvt_pk_bf16(s[6 * 33] * ns, s[7 * 33] * ns);
        *(u32x4*)(WT + (size_t)(n0 + n) * Kd + k0 + 8 * c) = o; }
    LDS_FENCE();
}
__device__ __forceinline__ void phase0(const Params& P, LAS unsigned char* lds, int G, int bid) {
    int tid_ = threadIdx.x; asm volatile("" : "+v"(tid_)); const int tid = tid_, lane = tid & 63, wave = tid >> 6;
    bf16_t* wt = (bf16_t*)(P.ws + OFF_WT);
    LAS float* scr = (LAS float*)(lds + wave * 8704);
    const int gw = bid * 8 + wave, NGW = G * 8;
    constexpr int IPL = 1024 + 512 + 2816 + 1408 + 512 + 128 + 32;
    for (int it = gw; it < NL * IPL; it += NGW) {
        const int l = it / IPL; int r = it % IPL;
        bf16_t* wl = wt + (size_t)l * WLAYER;
        const float* W; int ldw, Kd, kb, nb, sc0; bf16_t* WT; const float* ks = nullptr; const float* ns = nullptr;
        if (r < 1024) { W = P.w_in + (size_t)l * 1024 * 2056; ldw = 2056; Kd = 1024; WT = wl + WIN; ks = P.mix_g + l * 1024; kb = r / 64; nb = r % 64; sc0 = 32 * nb < 1536 ? 32 * nb : 32 * nb + 8; }
        else if ((r -= 1024) < 512) { W = P.w_out + (size_t)l * 1024 * 1024; ldw = 1024; Kd = 1024; WT = wl + WOUT; kb = r / 32; nb = r % 32; sc0 = 32 * nb; }
        else if ((r -= 512) < 2816) { W = P.w_up + (size_t)l * 1024 * DUP; ldw = DUP; Kd = 1024; WT = wl + WUP; ks = P.ffn_g + l * 1024; kb = r / 176; nb = r % 176;
            const int n0 = 32 * nb, pn = n0 >> 8, rr = n0 & 255; sc0 = rr < 128 ? 128 * pn + rr : DFF + 128 * pn + (rr - 128); }
        else if ((r -= 2816) < 1408) { W = P.w_down + (size_t)l * DFF * 1024; ldw = 1024; Kd = DFF; WT = wl + WDOWN; kb = r / 32; nb = r % 32; sc0 = 32 * nb; }
        else if ((r -= 1408) < 512) { W = P.w_gate + (size_t)l * 1024 * 1024; ldw = 1024; Kd = 1024; WT = wl + WGATE; ks = P.ple_g + l * 1024; kb = r / 32; nb = r % 32; sc0 = 32 * nb; }
        else if ((r -= 512) < 128) { W = P.w_ple + (size_t)l * DPLE * 1024; ldw = 1024; Kd = DPLE; WT = wl + WPLE; kb = r / 32; nb = r % 32; sc0 = 32 * nb; }
        else { r -= 128; const int gi = r >> 3, rr = r & 7; kb = rr >> 2; nb = rr & 3; W = P.pool_w + (size_t)(l * 4 + gi) * 128 * 128; ldw = 128; Kd = 128; WT = wl + WPOOL + gi * 128 * 128;
            ns = P.pool_scale + l * 512 + gi * 128; sc0 = 32 * nb; }
        tr_item(W, ldw, WT, Kd, 64 * kb, 32 * nb, sc0, ks, ns, scr, lane);
    }
    for (int idx = bid * 512 + tid; idx < NL * 16 * 1024; idx += G * 512) {
        const int l = idx >> 14, j = (idx >> 10) & 15, k = idx & 1023;
        const float v = j < 8 ? P.w_in[(size_t)l * 1024 * 2056 + (size_t)k * 2056 + 1536 + j] * P.mix_g[l * 1024 + k] : 0.f;
        wt[(size_t)l * WLAYER + WDT + j * 1024 + k] = f2bf(v);
    }
    bf16_t* hb0 = (bf16_t*)(P.ws + OFF_HB0); float* ss0 = (float*)(P.ws + OFF_SS);
    for (int row = gw; row < T; row += NGW) {
        const f32x4* xr = (const f32x4*)(P.x + (size_t)row * D) + lane; float s = 0.f;
#pragma unroll
        for (int j = 0; j < 4; ++j) { const f32x4 v = xr[64 * j]; s += (v.x * v.x + v.y * v.y) + (v.z * v.z + v.w * v.w);
            u32x2 w; w.x = cvt_pk_bf16(v.x, v.y); w.y = cvt_pk_bf16(v.z, v.w); *(u32x2*)(hb0 + (size_t)row * D + 4 * lane + 256 * j) = w; }
        s = wave_sum(s);
        if (lane < 16) ss0[(size_t)row * 16 + lane] = lane == 0 ? s : 0.f;
    }
}

#define MFMA32(a, b, c) __builtin_amdgcn_mfma_f32_32x32x16_bf16((a), (b), (c), 0, 0, 0)
__device__ __forceinline__ void conv8x2(const bf16_t* proj, long row0, int tl0, bool seqstart, int pcol, const float* cw, const float* cb, int xch, float (&o0)[8], float (&o1)[8]) {
    unsigned v[11];
#pragma unroll
    for (int i = 0; i < 11; ++i) { const int tl = tl0 - 3 + i; v[i] = (tl >= 0 || !seqstart) ? *(const unsigned*)(proj + (size_t)(row0 + tl) * NPROJ + pcol) : 0u; }
    const f32x2 w0 = *(const f32x2*)(cw + xch), w1 = *(const f32x2*)(cw + 1024 + xch), w2 = *(const f32x2*)(cw + 2048 + xch), w3 = *(const f32x2*)(cw + 3072 + xch), bb = *(const f32x2*)(cb + xch);
#pragma unroll
    for (int i = 0; i < 8; ++i) {
        const float a = bb.x + w0.x * bf_lo(v[i]) + w1.x * bf_lo(v[i + 1]) + w2.x * bf_lo(v[i + 2]) + w3.x * bf_lo(v[i + 3]);
        const float b = bb.y + w0.y * bf_hi(v[i]) + w1.y * bf_hi(v[i + 1]) + w2.y * bf_hi(v[i + 2]) + w3.y * bf_hi(v[i + 3]);
        o0[i] = silu_f(a); o1[i] = silu_f(b); }
}
__device__ __forceinline__ float chunk_cumsum(LAS float* dtT, LAS float* acs, int wave, int lane, float Ah) {
    float last = 0.f;
    if (wave < 4) {
        const float a0 = dtT[wave * 128 + 2 * lane] * Ah, a1 = dtT[wave * 128 + 2 * lane + 1] * Ah; float v = a0 + a1;
#pragma unroll
        for (int o = 1; o < 64; o <<= 1) { const float t = __shfl_up(v, o); if (lane >= o) v += t; }
        acs[wave * 128 + 2 * lane] = v - a1; acs[wave * 128 + 2 * lane + 1] = v;
        last = __shfl(v, 63);
    }
    return last;
}
struct SsdCtx { const bf16_t* proj; const bf16_t* hb; const float* ss; const bf16_t* wdt; const float* cw; const float* cb; const float* dt_bias; const float* a_log; const float* d_skip; const float* norm_g;
                bf16_t* states; float* dtbuf; float* cdecay; bf16_t* mix; const bf16_t* pwt; };

__device__ __forceinline__ void ssd_s1_job(const SsdCtx& C, LAS unsigned char* lds, int b, int c, int g) {
    int tid_ = threadIdx.x; asm volatile("" : "+v"(tid_)); const int tid = tid_, lane = tid & 63, wave = tid >> 6;
    LAS bf16_t* XdT = (LAS bf16_t*)lds; LAS bf16_t* BT = (LAS bf16_t*)(lds + 256 * PIT * 2);
    LAS float* dtT = (LAS float*)(lds + 139264); LAS float* acs = dtT + 512;
    const long row0 = (long)b * SEQ + c * 128;
    {
        pg8::f32x4 acc = {0.f, 0.f, 0.f, 0.f};
        const bf16_t* ar = C.hb + (size_t)(row0 + 16 * wave + (lane & 15)) * D + 8 * (lane >> 4);
        const bf16_t* br = C.wdt + (size_t)(lane & 15) * D + 8 * (lane >> 4);
#pragma unroll 1
        for (int kb = 0; kb < 4; ++kb) {
            bf16x8 a[8], bb[8];
#pragma unroll
            for (int i = 0; i < 8; ++i) { a[i] = __builtin_nontemporal_load((const bf16x8*)(ar + 256 * kb + 32 * i)); bb[i] = *(const bf16x8*)(br + 256 * kb + 32 * i); }
#pragma unroll
            for (int i = 0; i < 8; ++i) acc = __builtin_amdgcn_mfma_f32_16x16x32_bf16(a[i], bb[i], acc, 0, 0, 0);
        }
        const int head = lane & 15;
        if (head >= 4 * g && head < 4 * g + 4) {
            const float bias = C.dt_bias[head];
#pragma unroll
            for (int rg = 0; rg < 4; ++rg) { const int tok = 16 * wave + 4 * (lane >> 4) + rg; const float rs = row_rstd(C.ss, (int)(row0 + tok));
                const float dt = softplus_f(acc[rg] * rs + bias); dtT[(head - 4 * g) * 128 + tok] = dt; C.dtbuf[(size_t)(row0 + tok) * 8 + head] = dt; } }
    }
    __syncthreads();
    {
        const float Ah = wave < 4 ? -__expf(C.a_log[4 * g + wave]) : 0.f;
        const float last = chunk_cumsum(dtT, acs, wave, lane, Ah);
        if (wave < 4 && lane == 0) C.cdecay[(size_t)(b * 128 + c) * 8 + 4 * g + wave] = __expf(last);
    }
    __syncthreads();
    for (int idx = tid; idx < 192 * 16; idx += 512) {
        const int cp = idx % 192, r = idx / 192; const bool isx = cp < 128;
        const int xch = isx ? g * 256 + 2 * cp : 512 + g * 128 + 2 * (cp - 128);
        float o0[8], o1[8];
        conv8x2(C.proj, row0, 8 * r, c == 0, 512 + xch, C.cw, C.cb, xch, o0, o1);
        if (isx) { const int hh = cp >> 5; const float al = acs[hh * 128 + 127];
#pragma unroll
            for (int i = 0; i < 8; ++i) { const float sc = dtT[hh * 128 + 8 * r + i] * __expf(al - acs[hh * 128 + 8 * r + i]); o0[i] *= sc; o1[i] *= sc; } }
        LAS bf16_t* dst = isx ? XdT + (2 * cp) * PIT + 8 * r : BT + (2 * (cp - 128)) * PIT + 8 * r;
        u32x4 w0, w1; w0.x = cvt_pk_bf16(o0[0], o0[1]); w0.y = cvt_pk_bf16(o0[2], o0[3]); w0.z = cvt_pk_bf16(o0[4], o0[5]); w0.w = cvt_pk_bf16(o0[6], o0[7]);
        w1.x = cvt_pk_bf16(o1[0], o1[1]); w1.y = cvt_pk_bf16(o1[2], o1[3]); w1.z = cvt_pk_bf16(o1[4], o1[5]); w1.w = cvt_pk_bf16(o1[6], o1[7]);
        *(LAS u32x4*)dst = w0; *(LAS u32x4*)(dst + PIT) = w1;
    }
    __syncthreads();
    {
        const int hh = wave >> 1, nh = wave & 1, r = lane & 31, hq = lane >> 5;
        f32x16 acc[2][2];
#pragma unroll
        for (int i = 0; i < 2; ++i)
#pragma unroll
            for (int j = 0; j < 2; ++j)
#pragma unroll
                for (int e = 0; e < 16; ++e) acc[i][j][e] = 0.f;
#pragma unroll 2
        for (int ks = 0; ks < 8; ++ks) {
            bf16x8 a[2], bb[2];
#pragma unroll
            for (int i = 0; i < 2; ++i) { a[i] = *(const LAS bf16x8*)(XdT + (64 * hh + 32 * i + r) * PIT + 16 * ks + 8 * hq); bb[i] = *(const LAS bf16x8*)(BT + (64 * nh + 32 * i + r) * PIT + 16 * ks + 8 * hq); }
#pragma unroll
            for (int i = 0; i < 2; ++i)
#pragma unroll
                for (int j = 0; j < 2; ++j) acc[i][j] = MFMA32(a[i], bb[j], acc[i][j]);
        }
        bf16_t* st = C.states + ((size_t)(b * 128 + c) * 8 + 4 * g + hh) * 64 * 128;
#pragma unroll
        for (int i = 0; i < 2; ++i)
#pragma unroll
            for (int j = 0; j < 2; ++j)
#pragma unroll
                for (int e = 0; e < 16; ++e) { const int p = 32 * i + (e & 3) + 8 * (e >> 2) + 4 * hq, n = 64 * nh + 32 * j + r; st[p * 128 + n] = f2bf(acc[i][j][e]); }
    }
    __syncthreads();
}

template <int W> __device__ __forceinline__ void pool_fill(const bf16_t* proj, long row0, bool seqstart, int gi, LAS bf16_t* Pl, int tid) {
    const int cp = tid & 63, run = tid >> 6, pcol = 1536 + gi * 128 + 2 * cp;
    float u0[31], u1[31];
#pragma unroll
    for (int i = 0; i < 31; ++i) { const int tl = 16 * run - 15 + i; const unsigned v = (tl >= 0 || !seqstart) ? *(const unsigned*)(proj + (size_t)(row0 + tl) * NPROJ + pcol) : 0u; u0[i] = bf_lo(v); u1[i] = bf_hi(v); }
    float s0 = 0.f, s1 = 0.f;
#pragma unroll
    for (int j = 1; j < W; ++j) { s0 += u0[15 - j]; s1 += u1[15 - j]; }
#pragma unroll
    for (int i = 0; i < 16; ++i) {
        s0 += u0[15 + i]; s1 += u1[15 + i];
        const int tl = 16 * run + i; const float dv = seqstart ? (float)(tl + 1 < W ? tl + 1 : W) : (float)W; const float inv = 1.f / dv;
        *(LAS unsigned*)(Pl + tl * PIT + 2 * cp) = cvt_pk_bf16(s0 * inv - u0[15 + i], s1 * inv - u1[15 + i]);
        s0 -= u0[15 + i - (W - 1)]; s1 -= u1[15 + i - (W - 1)];
    }
}
__device__ __forceinline__ void pool_job(const SsdCtx& C, LAS unsigned char* lds, int tb, int gi) {
    int tid_ = threadIdx.x; asm volatile("" : "+v"(tid_)); const int tid = tid_, lane = tid & 63, wave = tid >> 6;
    LAS bf16_t* Pl = (LAS bf16_t*)lds; LAS bf16_t* Wp = (LAS bf16_t*)(lds + 128 * PIT * 2);
    const long row0 = (long)tb * 128; const bool seqstart = (tb & 127) == 0;
    for (int i = tid; i < 2048; i += 512) { const int d = i >> 4, c8 = i & 15; *(LAS u32x4*)(Wp + d * PIT + 8 * c8) = *(const u32x4*)(C.pwt + (size_t)gi * 16384 + d * 128 + 8 * c8); }
    if (gi == 0) pool_fill<2>(C.proj, row0, seqstart, gi, Pl, tid); else if (gi == 1) pool_fill<4>(C.proj, row0, seqstart, gi, Pl, tid);
    else if (gi == 2) pool_fill<8>(C.proj, row0, seqstart, gi, Pl, tid); else pool_fill<16>(C.proj, row0, seqstart, gi, Pl, tid);
    __syncthreads();
    {
        const int mi = wave >> 1, r = lane & 31, hq = lane >> 5;
        f32x16 acc[2];
#pragma unroll
        for (int j = 0; j < 2; ++j)
#pragma unroll
            for (int e = 0; e < 16; ++e) acc[j][e] = 0.f;
#pragma unroll 2
        for (int ks = 0; ks < 8; ++ks) {
            const bf16x8 a = *(const LAS bf16x8*)(Pl + (32 * mi + r) * PIT + 16 * ks + 8 * hq);
#pragma unroll
            for (int j = 0; j < 2; ++j) { const int ni = 2 * (wave & 1) + j; const bf16x8 bb = *(const LAS bf16x8*)(Wp + (32 * ni + r) * PIT + 16 * ks + 8 * hq); acc[j] = MFMA32(a, bb, acc[j]); }
        }
#pragma unroll
        for (int j = 0; j < 2; ++j) { const int ni = 2 * (wave & 1) + j;
#pragma unroll
            for (int e = 0; e < 16; ++e) { const int tl = 32 * mi + (e & 3) + 8 * (e >> 2) + 4 * hq; C.mix[(size_t)(row0 + tl) * D + 512 + gi * 128 + 32 * ni + r] = f2bf(acc[j][e]); } }
    }
    __syncthreads();
}

__device__ __forceinline__ void scan_phase(bf16_t* states, const float* cdecay, int G, int bid) {
    int tid_ = threadIdx.x; asm volatile("" : "+v"(tid_));
    for (int idx = bid * 512 + tid_; idx < 2 * 8 * 64 * 128; idx += G * 512) {
        const int n = idx & 127, p = (idx >> 7) & 63, h = (idx >> 13) & 7, b = idx >> 16;
        bf16_t* sp = states + ((size_t)b * 128 * 8 + h) * 8192 + p * 128 + n; const float* dp = cdecay + (size_t)b * 128 * 8 + h;
        float s = 0.f;
        for (int c0 = 0; c0 < 128; c0 += 16) {
            float v[16], d[16];
#pragma unroll
            for (int i = 0; i < 16; ++i) { v[i] = bf2f(sp[(size_t)(c0 + i) * 8 * 8192]); d[i] = dp[(c0 + i) * 8]; }
#pragma unroll
            for (int i = 0; i < 16; ++i) { sp[(size_t)(c0 + i) * 8 * 8192] = f2bf(s); s = s * d[i] + v[i]; }
        }
    }
}
__device__ __forceinline__ void ssd_s3_job(const SsdCtx& C, LAS unsigned char* lds, int b, int c, int g) {
    int tid_ = threadIdx.x; asm volatile("" : "+v"(tid_)); const int tid = tid_, lane = tid & 63, wave = tid >> 6;
    LAS bf16_t* Cn = (LAS bf16_t*)lds; LAS bf16_t* CBm = (LAS bf16_t*)(lds + 128 * PIT * 2); LAS bf16_t* Bn = (LAS bf16_t*)(lds + 256 * PIT * 2); LAS bf16_t* XT = Bn;
    LAS float* dtT = (LAS float*)(lds + 139264); LAS float* acs = dtT + 512; LAS float* red = dtT + 1024;
    const long row0 = (long)b * SEQ + c * 128;
    { const int tok = tid >> 2, hh = tid & 3; dtT[hh * 128 + tok] = C.dtbuf[(size_t)(row0 + tok) * 8 + 4 * g + hh]; }
    __syncthreads();
    { const float Ah = wave < 4 ? -__expf(C.a_log[4 * g + wave]) : 0.f; (void)chunk_cumsum(dtT, acs, wave, lane, Ah); }
    for (int idx = tid; idx < 128 * 16; idx += 512) {
        const int cp = idx & 127, r = idx >> 7; const bool isB = cp < 64;
        const int xch = isB ? 512 + g * 128 + 2 * cp : 768 + g * 128 + 2 * (cp - 64);
        float o0[8], o1[8];
        conv8x2(C.proj, row0, 8 * r, c == 0, 512 + xch, C.cw, C.cb, xch, o0, o1);
        LAS bf16_t* dst = (isB ? Bn + 2 * cp : Cn + 2 * (cp - 64)) + (8 * r) * PIT;
#pragma unroll
        for (int i = 0; i < 8; ++i) *(LAS unsigned*)(dst + i * PIT) = cvt_pk_bf16(o0[i], o1[i]);
    }
    __syncthreads();
    {
        const int mi = wave >> 1, r = lane & 31, hq = lane >> 5;
        f32x16 acc[2];
#pragma unroll
        for (int j = 0; j < 2; ++j)
#pragma unroll
            for (int e = 0; e < 16; ++e) acc[j][e] = 0.f;
#pragma unroll 2
        for (int ks = 0; ks < 8; ++ks) {
            const bf16x8 a = *(const LAS bf16x8*)(Cn + (32 * mi + r) * PIT + 16 * ks + 8 * hq);
#pragma unroll
            for (int j = 0; j < 2; ++j) { const int ni = 2 * (wave & 1) + j; const bf16x8 bb = *(const LAS bf16x8*)(Bn + (32 * ni + r) * PIT + 16 * ks + 8 * hq); acc[j] = MFMA32(a, bb, acc[j]); }
        }
#pragma unroll
        for (int j = 0; j < 2; ++j) { const int ni = 2 * (wave & 1) + j;
#pragma unroll
            for (int e = 0; e < 16; ++e) { const int l = 32 * mi + (e & 3) + 8 * (e >> 2) + 4 * hq; CBm[l * PIT + 32 * ni + r] = f2bf(acc[j][e]); } }
    }
    __syncthreads();
    for (int idx = tid; idx < 128 * 16; idx += 512) {
        const int cp = idx & 127, r = idx >> 7; const int xch = g * 256 + 2 * cp;
        float o0[8], o1[8];
        conv8x2(C.proj, row0, 8 * r, c == 0, 512 + xch, C.cw, C.cb, xch, o0, o1);
        LAS bf16_t* dst = XT + (2 * cp) * PIT + 8 * r;
        u32x4 w0, w1; w0.x = cvt_pk_bf16(o0[0], o0[1]); w0.y = cvt_pk_bf16(o0[2], o0[3]); w0.z = cvt_pk_bf16(o0[4], o0[5]); w0.w = cvt_pk_bf16(o0[6], o0[7]);
        w1.x = cvt_pk_bf16(o1[0], o1[1]); w1.y = cvt_pk_bf16(o1[2], o1[3]); w1.z = cvt_pk_bf16(o1[4], o1[5]); w1.w = cvt_pk_bf16(o1[6], o1[7]);
        *(LAS u32x4*)dst = w0; *(LAS u32x4*)(dst + PIT) = w1;
    }
    __syncthreads();
    const int hh = wave >> 1, lh = wave & 1, r = lane & 31, hq = lane >> 5, h = 4 * g + hh;
    f32x16 acc[2][2];
#pragma unroll
    for (int i = 0; i < 2; ++i)
#pragma unroll
        for (int j = 0; j < 2; ++j)
#pragma unroll
            for (int e = 0; e < 16; ++e) acc[i][j][e] = 0.f;
    {
        const bf16_t* pv = C.states + ((size_t)(b * 128 + c) * 8 + h) * 64 * 128;
#pragma unroll 2
        for (int ks = 0; ks < 8; ++ks) {
            bf16x8 a[2], bb[2];
#pragma unroll
            for (int i = 0; i < 2; ++i) { a[i] = *(const bf16x8*)(pv + (32 * i + r) * 128 + 16 * ks + 8 * hq); bb[i] = *(const LAS bf16x8*)(Cn + (64 * lh + 32 * i + r) * PIT + 16 * ks + 8 * hq); }
#pragma unroll
            for (int i = 0; i < 2; ++i)
#pragma unroll
                for (int j = 0; j < 2; ++j) acc[i][j] = MFMA32(a[i], bb[j], acc[i][j]);
        }
#pragma unroll
        for (int j = 0; j < 2; ++j) { const float el = __expf(acs[hh * 128 + 64 * lh + 32 * j + r]);
#pragma unroll
            for (int i = 0; i < 2; ++i)
#pragma unroll
                for (int e = 0; e < 16; ++e) acc[i][j][e] *= el; }
    }
#pragma unroll
    for (int li = 0; li < 2; ++li) {
        const int l = 64 * lh + 32 * li + r; const float al = acs[hh * 128 + l];
        const int nks = 4 * lh + 2 * li + 2;
        for (int ks = 0; ks < nks; ++ks) {
            const int s0 = 16 * ks + 8 * hq;
            const u32x4 cb = *(const LAS u32x4*)(CBm + l * PIT + s0);
            const f32x4 as0 = *(const LAS f32x4*)(acs + hh * 128 + s0), as1 = *(const LAS f32x4*)(acs + hh * 128 + s0 + 4);
            const f32x4 d0 = *(const LAS f32x4*)(dtT + hh * 128 + s0), d1 = *(const LAS f32x4*)(dtT + hh * 128 + s0 + 4);
            float m[8];
            m[0] = bf_lo(cb.x) * __expf(al - as0[0]) * d0[0]; m[1] = bf_hi(cb.x) * __expf(al - as0[1]) * d0[1];
            m[2] = bf_lo(cb.y) * __expf(al - as0[2]) * d0[2]; m[3] = bf_hi(cb.y) * __expf(al - as0[3]) * d0[3];
            m[4] = bf_lo(cb.z) * __expf(al - as1[0]) * d1[0]; m[5] = bf_hi(cb.z) * __expf(al - as1[1]) * d1[1];
            m[6] = bf_lo(cb.w) * __expf(al - as1[2]) * d1[2]; m[7] = bf_hi(cb.w) * __expf(al - as1[3]) * d1[3];
#pragma unroll
            for (int j = 0; j < 8; ++j) m[j] = (s0 + j <= l) ? m[j] : 0.f;
            u32x4 mw; mw.x = cvt_pk_bf16(m[0], m[1]); mw.y = cvt_pk_bf16(m[2], m[3]); mw.z = cvt_pk_bf16(m[4], m[5]); mw.w = cvt_pk_bf16(m[6], m[7]);
            const bf16x8 mf = __builtin_bit_cast(bf16x8, mw);
#pragma unroll
            for (int pi = 0; pi < 2; ++pi) { const bf16x8 a = *(const LAS bf16x8*)(XT + (64 * hh + 32 * pi + r) * PIT + s0); acc[pi][li] = MFMA32(a, mf, acc[pi][li]); }
        }
    }
    const float Dh = C.d_skip[h];
    float sq[2] = {0.f, 0.f};
#pragma unroll
    for (int li = 0; li < 2; ++li) { const int l = 64 * lh + 32 * li + r;
#pragma unroll
        for (int pi = 0; pi < 2; ++pi)
#pragma unroll
            for (int e4 = 0; e4 < 4; ++e4) { const int p0 = 32 * pi + 8 * e4 + 4 * hq;
                const u32x2 zz = *(const u32x2*)(C.proj + (size_t)(row0 + l) * NPROJ + g * 256 + hh * 64 + p0);
                const float zf[4] = {bf_lo(zz.x), bf_hi(zz.x), bf_lo(zz.y), bf_hi(zz.y)};
#pragma unroll
                for (int k = 0; k < 4; ++k) { const float xs = bf2f(XT[(64 * hh + p0 + k) * PIT + l]); float y = acc[pi][li][4 * e4 + k] + xs * Dh; y *= silu_f(zf[k]); acc[pi][li][4 * e4 + k] = y; sq[li] += y * y; } }
        sq[li] += __shfl_xor(sq[li], 32);
        if (hq == 0) red[hh * 128 + l] = sq[li]; }
    __syncthreads();
#pragma unroll
    for (int li = 0; li < 2; ++li) { const int l = 64 * lh + 32 * li + r;
        const float rstd = rsqrtf((red[l] + red[128 + l] + red[256 + l] + red[384 + l]) * (1.f / 256.f) + EPS);
#pragma unroll
        for (int pi = 0; pi < 2; ++pi)
#pragma unroll
            for (int e4 = 0; e4 < 4; ++e4) { const int p0 = 32 * pi + 8 * e4 + 4 * hq, ch = g * 256 + hh * 64 + p0;
                const f32x4 ng = *(const f32x4*)(C.norm_g + ch);
                u32x2 w; w.x = cvt_pk_bf16(acc[pi][li][4 * e4] * rstd * ng[0], acc[pi][li][4 * e4 + 1] * rstd * ng[1]); w.y = cvt_pk_bf16(acc[pi][li][4 * e4 + 2] * rstd * ng[2], acc[pi][li][4 * e4 + 3] * rstd * ng[3]);
                *(u32x2*)(C.mix + (size_t)(row0 + l) * D + ch) = w; } }
    __syncthreads();
}

__device__ __forceinline__ void fixup_phase(const Params& P, int l, bf16_t* act, const float* head, const float* tail, bf16_t* pb, int G, int bid) {
    const float* cw = P.fconv_w + (size_t)l * 3 * DUP; const float* cb = P.fconv_b + (size_t)l * DUP;
    int tid_ = threadIdx.x; asm volatile("" : "+v"(tid_)); const int gt = bid * 512 + tid_, NT = G * 512;
    for (int idx = gt; idx < 512 * DFF; idx += NT) {
        const int s = idx / DFF, j = idx % DFF; const bool first = (s & 255) == 0;
        float o[2];
        float cvals[2][2];
#pragma unroll
        for (int gv = 0; gv < 2; ++gv) { const int col = j + gv * DFF;
            const float tm2 = first ? 0.f : tail[(size_t)((s - 1) * 2) * DUP + col], tm1 = first ? 0.f : tail[(size_t)((s - 1) * 2 + 1) * DUP + col];
            const float h0 = head[(size_t)(s * 2) * DUP + col], h1 = head[(size_t)(s * 2 + 1) * DUP + col];
            const float w0 = cw[col], w1 = cw[DUP + col], w2 = cw[2 * DUP + col], bb = cb[col];
            cvals[gv][0] = bb + w0 * tm2 + w1 * tm1 + w2 * h0; cvals[gv][1] = bb + w0 * tm1 + w1 * h0 + w2 * h1; }
        o[0] = gelu_tanh(cvals[0][0]) * cvals[1][0]; o[1] = gelu_tanh(cvals[0][1]) * cvals[1][1];
        act[(size_t)(64 * s) * DFF + j] = f2bf(o[0]); act[(size_t)(64 * s + 1) * DFF + j] = f2bf(o[1]);
    }
    const f32x4* ps = (const f32x4*)(P.p + (size_t)l * T * DPLE);
    for (int idx = gt; idx < T * DPLE / 4; idx += NT) { const f32x4 v = ps[idx]; u32x2 w; w.x = cvt_pk_bf16(v.x, v.y); w.y = cvt_pk_bf16(v.z, v.w); *(u32x2*)(pb + (size_t)idx * 4) = w; }
}

#define XB_TMO      128
#define XB_XCNT(j)  (256  + 64 * (j))
#define XB_XSUB(j)  (1280 + 64 * (j))
#define XB_XGEN(j)  (2304 + 64 * (j))
#define XB_TOP      3328
#define XB_TOPGEN   3392
#define XCD_BAR_WORDS 3456
#define XB_SPIN_CAP (1u << 18)

__device__ __forceinline__ unsigned xb_ld(unsigned* p)              { return __hip_atomic_load(p, __ATOMIC_RELAXED, __HIP_MEMORY_SCOPE_AGENT); }
__device__ __forceinline__ unsigned xb_add(unsigned* p, unsigned v) { return __hip_atomic_fetch_add(p, v, __ATOMIC_RELAXED, __HIP_MEMORY_SCOPE_AGENT); }
__device__ __forceinline__ unsigned xb_xcc_id() { return (unsigned)__builtin_amdgcn_s_getreg((3 << 11) | 20) & 0xFu; }
#define XB_SPIN(cond, bar) do { unsigned _sp = 0; while (cond) { __builtin_amdgcn_s_sleep(1); \
    if ((++_sp & 255u) == 0u) { if (xb_ld(&(bar)[XB_TMO])) break; if (_sp > XB_SPIN_CAP) { atomicAdd(&(bar)[XB_TMO], 1u); break; } } } } while (0)

struct XcdBarrier {
    unsigned* bar; unsigned x;
    volatile LAS unsigned* st;
};

__device__ __forceinline__ XcdBarrier xcd_barrier_post(unsigned* bar, volatile LAS unsigned* st) {
    XcdBarrier b; b.bar = bar; b.x = xb_xcc_id(); b.st = st;
    if (threadIdx.x == 0) (void)xb_add(&bar[XB_XCNT(b.x)], 1u);
    return b;
}
__device__ __forceinline__ void xcd_barrier_complete(unsigned* bar, unsigned x, unsigned& nloc, unsigned& nx) {
    const unsigned G = gridDim.x * gridDim.y * gridDim.z;
    unsigned sum, cnt, mine, sp = 0u;
    for (;;) {
        sum = 0u; cnt = 0u; mine = 0u;
#pragma unroll
        for (unsigned j = 0; j < 16; ++j) { const unsigned c = xb_ld(&bar[XB_XCNT(j)]); sum += c; cnt += (c > 0u) ? 1u : 0u; mine = (j == x) ? c : mine; }
        if (sum == G) break;
        __builtin_amdgcn_s_sleep(1);
        if ((++sp & 255u) == 0u) { if (xb_ld(&bar[XB_TMO])) break; if (sp > XB_SPIN_CAP) { atomicAdd(&bar[XB_TMO], 1u); break; } }
    }
    nloc = mine > 0u ? mine : 1u; nx = cnt > 0u ? cnt : 1u;
}

__device__ __forceinline__ void xcd_barrier(const XcdBarrier& b) {
    asm volatile("s_waitcnt vmcnt(0)" ::: "memory");
    __syncthreads();
    if (threadIdx.x == 0) {
        unsigned* bar = b.bar;
        __builtin_amdgcn_s_waitcnt(0);
        unsigned nloc = b.st[0], nx = b.st[1];
        if (nloc == 0u) { xcd_barrier_complete(bar, b.x, nloc, nx); b.st[0] = nloc; b.st[1] = nx; }
        const unsigned old = xb_add(&bar[XB_XSUB(b.x)], 1u);
        const unsigned gen = old / nloc;
        if (old + 1u == (gen + 1u) * nloc) {
            __builtin_amdgcn_fence(__ATOMIC_RELEASE, "agent");
            asm volatile("s_waitcnt vmcnt(0)" ::: "memory");
            const unsigned og = xb_add(&bar[XB_TOP], 1u);
            const unsigned tg = og / nx;
            if (og + 1u == (tg + 1u) * nx) xb_add(&bar[XB_TOPGEN], 1u);
            else XB_SPIN(xb_ld(&bar[XB_TOPGEN]) == tg, bar);
            __builtin_amdgcn_fence(__ATOMIC_ACQUIRE, "agent");
            xb_add(&bar[XB_XGEN(b.x)], 1u);
            asm volatile("s_waitcnt vmcnt(0)" ::: "memory");
        } else {
            XB_SPIN(xb_ld(&bar[XB_XGEN(b.x)]) == gen, bar);
            __builtin_amdgcn_fence(__ATOMIC_ACQUIRE, "agent");
            asm volatile("s_waitcnt vmcnt(0)" ::: "memory");
        }
    }
    __syncthreads();
}


__global__ __launch_bounds__(512, 2) void hymba_fwd(Params P) {
    extern __shared__ __attribute__((aligned(16))) unsigned char shm[];
    LAS unsigned char* lds = (LAS unsigned char*)shm;
    cg::grid_group grid = cg::this_grid();
    const int G = (int)gridDim.x, bid = (int)blockIdx.x;
    bf16_t* hbuf[2] = {(bf16_t*)(P.ws + OFF_HB0), (bf16_t*)(P.ws + OFF_HB1)};
    float* ssbuf[2] = {(float*)(P.ws + OFF_SS), (float*)(P.ws + OFF_SS) + (size_t)T * 16};
    bf16_t* wt = (bf16_t*)(P.ws + OFF_WT);
    bf16_t* proj = (bf16_t*)(P.ws + OFF_R); bf16_t* act = proj; bf16_t* states = (bf16_t*)(P.ws + OFF_ST);
    bf16_t* mix = (bf16_t*)(P.ws + OFF_MIX); bf16_t* qb = mix; float* head = (float*)(P.ws + OFF_MIX); float* tail = (float*)(P.ws + OFF_TAIL);
    bf16_t* pb = (bf16_t*)(P.ws + OFF_PB); float* dtbuf = (float*)(P.ws + OFF_DT); float* cdecay = (float*)(P.ws + OFF_CD);
    pg8::StaticOrder S;
    volatile LAS unsigned* xst = (volatile LAS unsigned*)(lds + LDS_BYTES - 16);
    if (threadIdx.x == 0) { xst[0] = 0u; xst[1] = 0u; }
    __syncthreads();
    const XcdBarrier xb = xcd_barrier_post((unsigned*)(P.ws + OFF_BAR), xst);

    phase0(P, lds, G, bid);
    grid.sync();
    int cur = 0;
#pragma unroll 1
    for (int l = 0; l < NL; ++l) {
        const bf16_t* wl = wt + (size_t)l * WLAYER;
        bf16_t* hb = cur ? hbuf[1] : hbuf[0]; bf16_t* hbn = cur ? hbuf[0] : hbuf[1];
        float* ss = cur ? ssbuf[1] : ssbuf[0]; float* ssn = cur ? ssbuf[0] : ssbuf[1];
        { S.init(T, NPROJ, G, bid); EpiIn E{proj, ss}; pg8::gemm_phase<EpiIn, pg8::StaticOrder>(lds, pg8::Gemm{hb, wl + WIN, T, NPROJ, D}, S, E, nullptr); }
        xcd_barrier(xb);
        SsdCtx C{proj, hb, ss, wl + WDT, P.conv_w + (size_t)l * 4 * 1024, P.conv_b + (size_t)l * 1024, P.dt_bias + l * 8, P.a_log + l * 8, P.d_skip + l * 8, P.norm_g + l * 512,
                 states, dtbuf, cdecay, mix, wl + WPOOL};
        for (int job = bid; job < 512 + 1024; job += G) {
            if (job < 512) ssd_s1_job(C, lds, job >> 8, (job >> 1) & 127, job & 1);
            else { const int j = job - 512; pool_job(C, lds, j >> 2, j & 3); }
        }
        xcd_barrier(xb);
        scan_phase(states, cdecay, G, bid);
        xcd_barrier(xb);
        for (int job = bid; job < 512; job += G) ssd_s3_job(C, lds, job >> 8, (job >> 1) & 127, job & 1);
        xcd_barrier(xb);
        { S.init(T, D, G, bid); EpiRes<false> E{l == 0 ? P.x : P.out, P.out, hb, ss, nullptr, nullptr}; pg8::gemm_phase<EpiRes<false>, pg8::StaticOrder>(lds, pg8::Gemm{mix, wl + WOUT, T, D, D}, S, E, nullptr); }
        xcd_barrier(xb);
        { S.init(T, DUP, G, bid); EpiUp E{act, ss, P.fconv_w + (size_t)l * 3 * DUP, P.fconv_b + (size_t)l * DUP, head, tail}; pg8::gemm_phase<EpiUp, pg8::StaticOrder>(lds, pg8::Gemm{hb, wl + WUP, T, DUP, D}, S, E, nullptr); }
        xcd_barrier(xb);
        fixup_phase(P, l, act, head, tail, pb, G, bid);
        xcd_barrier(xb);
        { S.init(T, D, G, bid); EpiRes<false> E{P.out, P.out, hb, ss, nullptr, nullptr}; pg8::gemm_phase<EpiRes<false>, pg8::StaticOrder>(lds, pg8::Gemm{act, wl + WDOWN, T, D, DFF}, S, E, nullptr); }
        { S.init(T, D, G, bid); EpiQ E{qb}; pg8::gemm_phase<EpiQ, pg8::StaticOrder>(lds, pg8::Gemm{pb, wl + WPLE, T, D, DPLE}, S, E, nullptr); }
        xcd_barrier(xb);
        { S.init(T, D, G, bid); EpiRes<true> E{P.out, P.out, hbn, ssn, ss, qb}; pg8::gemm_phase<EpiRes<true>, pg8::StaticOrder>(lds, pg8::Gemm{hb, wl + WGATE, T, D, D}, S, E, nullptr); }
        xcd_barrier(xb);
        cur ^= 1;
    }
    {
        const int lane = threadIdx.x & 63, wave = threadIdx.x >> 6;
        const float* ss = cur ? ssbuf[1] : ssbuf[0];
        for (int row = bid * 8 + wave; row < T; row += G * 8) {
            const float rs = row_rstd(ss, row); f32x4* xr = (f32x4*)(P.out + (size_t)row * D) + lane; const f32x4* gr = (const f32x4*)P.final_g + lane;
#pragma unroll
            for (int j = 0; j < 4; ++j) { f32x4 v = xr[64 * j]; const f32x4 gg = gr[64 * j]; v = v * rs * gg; xr[64 * j] = v; }
        }
    }
}

extern "C" void kernel_launch(void* const* d_in, const int* in_sizes, int n_in, void* d_out, int out_size, void* d_ws, size_t ws_size, hipStream_t stream) {
    static int grid = 0;
    if (grid == 0) {
        if (n_in != 22 || ws_size < WS_END) { fprintf(stderr, "kernel_launch: unexpected inputs (n_in %d, ws %zu, need %zu)\n", n_in, ws_size, (size_t)WS_END); grid = -1; return; }
        int dev = 0, cus = 0, per_cu = 0;
        (void)hipGetDevice(&dev); (void)hipDeviceGetAttribute(&cus, hipDeviceAttributeMultiprocessorCount, dev);
        if (hipFuncSetAttribute((const void*)hymba_fwd, hipFuncAttributeMaxDynamicSharedMemorySize, LDS_BYTES) != hipSuccess) { fprintf(stderr, "kernel_launch: hipFuncSetAttribute failed\n"); grid = -1; return; }
        if (hipOccupancyMaxActiveBlocksPerMultiprocessor(&per_cu, (const void*)hymba_fwd, 512, LDS_BYTES) != hipSuccess || per_cu < 1) { fprintf(stderr, "kernel_launch: occupancy query says %d blocks per CU\n", per_cu); per_cu = 1; }
        (void)hipGetLastError();
        grid = cus;
    }
    if (grid < 0) return;
    Params p{};
    const float** pp = (const float**)&p;
    for (int i = 0; i < 22; ++i) pp[i] = (const float*)d_in[i];
    p.out = (float*)d_out; p.ws = (unsigned char*)d_ws;
    if (hipMemsetAsync((char*)d_ws + OFF_BAR, 0, 16384, stream) != hipSuccess) { fprintf(stderr, "kernel_launch: memset failed\n"); return; }
    void* args[] = {&p};
    hipError_t e = hipLaunchCooperativeKernel((const void*)hymba_fwd, dim3(grid), dim3(512), args, LDS_BYTES, stream);
    if (e != hipSuccess) fprintf(stderr, "cooperative launch failed: %s (grid %d)\n", hipGetErrorString(e), grid);
}
```

```cpp
#include <hip/hip_runtime.h>
#include <hip/hip_cooperative_groups.h>
#include <cstdio>
#include <cstdint>
namespace cg = cooperative_groups;
namespace pg8 {
#define PG8_LAS __attribute__((address_space(3)))
typedef unsigned short bf16_t;
typedef short bf16x8 __attribute__((ext_vector_type(8)));
typedef float f32x4 __attribute__((ext_vector_type(4)));
typedef unsigned u32x4 __attribute__((ext_vector_type(4)));
constexpr int BM = 256, BK = 64, HALF = 128, HTB = HALF * BK * 2  , STAGE_BYTES = 8 * HTB, NXCD = 8, WGM = 8;

__host__ __device__ __forceinline__ int lds_byte(int r, int c) { const int st = (r >> 4) * 2 + (c >> 5), rr = r & 15, cc = c & 31, ob = rr * 64 + cc * 2; return st * 1024 + (ob ^ (((ob >> 9) & 1) << 5)); }
__host__ __device__ __forceinline__ void stage_rc(int b, int& R, int& C) { const int st = b / 1024, sb = b % 1024, swz = sb ^ (((sb >> 9) & 1) << 5); R = (st >> 1) * 16 + swz / 64; C = (st & 1) * 32 + (swz % 64) / 2; }
__host__ __device__ __forceinline__ int perm32(int rho) { const int n = rho >> 4, i = rho & 15; return 8 * (i >> 2) + 4 * n + (i & 3); }

struct Unit { int pm, pn; };
struct Gemm { const bf16_t* A; const bf16_t* Bt; int M, N, K; };

struct StaticOrder {
    int nM, nN, nwg, G, c;
    __host__ __device__ void init(int M, int N, int G_, int c_) { nM = M / BM; nN = N / BM; nwg = nM * nN; G = G_; c = c_; }
    __host__ __device__ bool next(int i, Unit& u) const {
        const long L = (long)i * G + c; if (L >= nwg) return false;
        int wgid = (int)L; { const int q = nwg / NXCD, r = nwg % NXCD, xcd = wgid % NXCD, off = wgid / NXCD; wgid = (xcd < r ? xcd * (q + 1) : r * (q + 1) + (xcd - r) * q) + off; }
        const int nig = WGM * nN, gid = wgid / nig, fm = gid * WGM, gsz = (nM - fm) < WGM ? (nM - fm) : WGM;
        u.pm = fm + ((wgid % nig) % gsz); u.pn = (wgid % nig) / gsz; return true;
    }
    __device__ __forceinline__ void a_ready(const Unit&) const {}
    __device__ __forceinline__ void done(const Unit&) const {}
};
__device__ __forceinline__ unsigned cvt_pk_bf16(float lo, float hi) { unsigned r; asm volatile("v_cvt_pk_bf16_f32 %0, %1, %2" : "=v"(r) : "v"(lo), "v"(hi)); return r; }
template <class Epi, class Sched, bool STAMP = false>
__device__ __forceinline__ void gemm_phase(PG8_LAS unsigned char* lds, const Gemm g, const Sched& S, const Epi& E, unsigned long long* stamps) {
    int tid_ = threadIdx.x; asm volatile("" : "+v"(tid_));
    const int tid = tid_, wid = __builtin_amdgcn_readfirstlane(tid >> 6), lane = tid & 63, wr = wid >> 2, wc = wid & 3, fr = lane & 15, fq = lane >> 4;
    int K_ = g.K; asm volatile("" : "+s"(K_));
    const int K = K_, nt = K / BK;
    int ts_lo = 0, ts_hi = 0, nts = 0; const unsigned long long rt_entry = STAMP ? (unsigned long long)wall_clock64() : 0ull;
#define PG8_STAMP() do { if (STAMP && wid == 0 && nts < 64) { const unsigned long long _c = (unsigned long long)clock64(); \
        ts_lo = (lane == nts) ? (int)(unsigned)_c : ts_lo; ts_hi = (lane == nts) ? (int)(unsigned)(_c >> 32) : ts_hi; ++nts; } } while (0)
    PG8_STAMP();
    unsigned voffA[2], voffB[2];
#pragma unroll
    for (int i = 0; i < 2; ++i) { int R, C; stage_rc(tid * 16 + i * 8192, R, C); const int Rb = Epi::PERM ? ((R & ~31) + perm32(R & 31)) : R;
        voffA[i] = (unsigned)(R * K + C) * 2u; voffB[i] = (unsigned)(Rb * K + C) * 2u; }
    const size_t kstep = (size_t)(BK * 2);
    const size_t hstep = (size_t)HALF * K * 2;
    const size_t tstep = 2 * hstep;
    const unsigned ldsw = (unsigned)wid * 1024u;
    const int aoff = lds_byte(wr * 64 + fr, fq * 8), boff = lds_byte(wc * 32 + fr, fq * 8);
#define PG8_SA(b, h) (((b) * 2 + (h)) * HTB)
#define PG8_SB(b, h) ((4 + (b) * 2 + (h)) * HTB)
#define PG8_STAGE(bufoff, gbase, voff) do { _Pragma("unroll") for (int _i = 0; _i < 2; ++_i) \
        __builtin_amdgcn_global_load_lds((const unsigned*)((const char*)(gbase) + (voff)[_i]), (PG8_LAS unsigned*)(lds + (bufoff) + ldsw + _i * 8192), 16, 0, 0); } while (0)
#define PG8_LDA(dst, b, h) do { _Pragma("unroll") for (int m = 0; m < 4; ++m) _Pragma("unroll") for (int k = 0; k < 2; ++k) dst[m][k] = *(const PG8_LAS bf16x8*)(lds + PG8_SA(b, h) + aoff + m * 2048 + k * 1024); } while (0)
#define PG8_LDB(dst, b, h) do { _Pragma("unroll") for (int n = 0; n < 2; ++n) _Pragma("unroll") for (int k = 0; k < 2; ++k) dst[n][k] = *(const PG8_LAS bf16x8*)(lds + PG8_SB(b, h) + boff + n * 2048 + k * 1024); } while (0)
#define PG8_MMA(ai, bj, At, Bt) do { __builtin_amdgcn_s_setprio(1); _Pragma("unroll") for (int m = 0; m < 4; ++m) _Pragma("unroll") for (int n = 0; n < 2; ++n) _Pragma("unroll") for (int k = 0; k < 2; ++k) \
        acc[ai][bj][m][n] = __builtin_amdgcn_mfma_f32_16x16x32_bf16(Bt[n][k], At[m][k], acc[ai][bj][m][n], 0, 0, 0); __builtin_amdgcn_s_setprio(0); } while (0)
#define PG8_WAIT_V(n) asm volatile("s_waitcnt vmcnt(" #n ")" ::: "memory")
#define PG8_WAIT_L(n) asm volatile("s_waitcnt lgkmcnt(" #n ")" ::: "memory")
#define PG8_BAR __builtin_amdgcn_s_barrier()
#define PG8_SCHED __builtin_amdgcn_sched_barrier(0)
    Unit cur, nxt; int ui = 0;
    if (!S.next(0, cur)) return;
    f32x4 acc[2][2][4][2];
#pragma unroll
    for (int a = 0; a < 2; ++a)
#pragma unroll
        for (int b = 0; b < 2; ++b)
#pragma unroll
            for (int m = 0; m < 4; ++m)
#pragma unroll
                for (int n = 0; n < 2; ++n) acc[a][b][m][n] = (f32x4){0.f, 0.f, 0.f, 0.f};
    bf16x8 At[4][2], B0[2][2], B1[2][2];
    const char* cA = (const char*)g.A + (size_t)cur.pm * tstep; const char* cB = (const char*)g.Bt + (size_t)cur.pn * tstep;
    S.a_ready(cur);
    PG8_STAGE(PG8_SB(0, 0), cB, voffB); PG8_STAGE(PG8_SA(0, 0), cA, voffA); PG8_STAGE(PG8_SB(0, 1), cB + hstep, voffB); PG8_STAGE(PG8_SA(0, 1), cA + hstep, voffA);
    if (wr == 1) PG8_BAR;
    PG8_WAIT_V(4); PG8_BAR;
    PG8_STAGE(PG8_SB(1, 0), cB + kstep, voffB); PG8_STAGE(PG8_SA(1, 0), cA + kstep, voffA); PG8_STAGE(PG8_SB(1, 1), cB + hstep + kstep, voffB);
    PG8_WAIT_V(6); PG8_BAR;
    PG8_STAMP();
    for (;;) {
        const bool has_next = S.next(ui + 1, nxt);
        const char* nA = has_next ? (const char*)g.A + (size_t)nxt.pm * tstep : cA; const char* nB = has_next ? (const char*)g.Bt + (size_t)nxt.pn * tstep : cB;
        for (int t = 0; t < nt; t += 2) {
            const bool last = (t == nt - 2);
            const char* a1 = cA + (size_t)(t + 1) * kstep;
            const char* a2 = last ? nA : cA + (size_t)(t + 2) * kstep; const char* b2 = last ? nB : cB + (size_t)(t + 2) * kstep;
            const char* a3 = a2 + kstep; const char* b3 = b2 + kstep;
            if (last && has_next) S.a_ready(nxt);
            PG8_LDB(B0, 0, 0); PG8_SCHED; PG8_LDA(At, 0, 0); PG8_STAGE(PG8_SA(1, 1), a1 + hstep, voffA);
            PG8_WAIT_L(8); PG8_BAR; PG8_WAIT_L(0); PG8_MMA(0, 0, At, B0); PG8_BAR; PG8_SCHED;
            PG8_LDB(B1, 0, 1); PG8_STAGE(PG8_SB(0, 0), b2, voffB);
            PG8_BAR; PG8_WAIT_L(0); PG8_MMA(0, 1, At, B1); PG8_BAR;
            PG8_LDA(At, 0, 1); PG8_STAGE(PG8_SA(0, 0), a2, voffA);
            PG8_BAR; PG8_WAIT_L(0); PG8_MMA(1, 0, At, B0); PG8_BAR; PG8_SCHED;
            PG8_STAGE(PG8_SB(0, 1), b2 + hstep, voffB);
            PG8_WAIT_V(6); PG8_BAR; PG8_MMA(1, 1, At, B1); PG8_BAR;
            PG8_LDB(B0, 1, 0); PG8_SCHED; PG8_LDA(At, 1, 0); PG8_STAGE(PG8_SA(0, 1), a2 + hstep, voffA);
            PG8_WAIT_L(8); PG8_BAR; PG8_WAIT_L(0); PG8_MMA(0, 0, At, B0); PG8_BAR; PG8_SCHED;
            PG8_LDB(B1, 1, 1); PG8_STAGE(PG8_SB(1, 0), b3, voffB);
            PG8_BAR; PG8_WAIT_L(0); PG8_MMA(0, 1, At, B1); PG8_BAR;
            PG8_LDA(At, 1, 1); PG8_STAGE(PG8_SA(1, 0), a3, voffA);
            PG8_BAR; PG8_WAIT_L(0); PG8_MMA(1, 0, At, B0); PG8_BAR; PG8_SCHED;
            PG8_STAGE(PG8_SB(1, 1), b3 + hstep, voffB);
            PG8_WAIT_V(6); PG8_BAR; PG8_MMA(1, 1, At, B1); PG8_BAR;
        }
        PG8_STAMP();
        if constexpr (!Epi::AFTER_DRAIN) { E(acc, cur, wr, wc, fr, fq); S.done(cur); }
        PG8_STAMP();
        if (!has_next) break;
#pragma unroll
        for (int a = 0; a < 2; ++a)
#pragma unroll
            for (int b = 0; b < 2; ++b)
#pragma unroll
                for (int m = 0; m < 4; ++m)
#pragma unroll
                    for (int n = 0; n < 2; ++n) acc[a][b][m][n] = (f32x4){0.f, 0.f, 0.f, 0.f};
        cur = nxt; cA = nA; cB = nB; ++ui;
    }
    PG8_WAIT_V(0);
    if (wr == 0) PG8_BAR;
    PG8_BAR;
    if constexpr (Epi::AFTER_DRAIN) { E.fused(acc, cur, wr, wc, fr, fq, lds, wid, lane); S.done(cur); }
    PG8_STAMP();
    if (STAMP && wid == 0) { stamps[lane] = lane < nts ? (((unsigned long long)(unsigned)ts_hi << 32) | (unsigned)ts_lo) : 0ull;
        if (lane == 62) stamps[62] = rt_entry; if (lane == 63) stamps[63] = (unsigned long long)wall_clock64(); }
#undef PG8_STAMP
#undef PG8_SA
#undef PG8_SB
#undef PG8_STAGE
#undef PG8_LDA
#undef PG8_LDB
#undef PG8_MMA
#undef PG8_WAIT_V
#undef PG8_WAIT_L
#undef PG8_BAR
#undef PG8_SCHED
}
}
#define LAS __attribute__((address_space(3)))
typedef pg8::bf16_t bf16_t; typedef pg8::bf16x8 bf16x8; typedef pg8::f32x4 f32x4; typedef pg8::u32x4 u32x4;
typedef float f32x16 __attribute__((ext_vector_type(16)));
typedef unsigned u32x2 __attribute__((ext_vector_type(2)));
typedef float f32x2 __attribute__((ext_vector_type(2)));
using pg8::cvt_pk_bf16;

constexpr int T = 32768, D = 1024, SEQ = 16384, NL = 4, NPROJ = 2048, DFF = 2816, DUP = 5632, DPLE = 256;
constexpr float EPS = 1e-6f;
constexpr size_t WIN = 0, WDT = WIN + (size_t)2048 * 1024, WOUT = WDT + (size_t)16 * 1024, WUP = WOUT + (size_t)1024 * 1024, WDOWN = WUP + (size_t)5632 * 1024,
                 WGATE = WDOWN + (size_t)1024 * 2816, WPLE = WGATE + (size_t)1024 * 1024, WPOOL = WPLE + (size_t)1024 * 256, WLAYER = WPOOL + (size_t)4 * 128 * 128;
constexpr size_t OFF_HB0 = 0, OFF_HB1 = OFF_HB0 + (size_t)T * D * 2, OFF_WT = OFF_HB1 + (size_t)T * D * 2, OFF_R = OFF_WT + WLAYER * 2 * NL,
                 OFF_ST = OFF_R + (size_t)T * NPROJ * 2, OFF_MIX = OFF_R + (size_t)T * DFF * 2, OFF_TAIL = OFF_MIX + (size_t)512 * 2 * DUP * 4,
                 OFF_PB = OFF_MIX + (size_t)T * D * 2, OFF_SS = OFF_PB + (size_t)T * DPLE * 2, OFF_DT = OFF_SS + (size_t)2 * T * 16 * 4,
                 OFF_CD = OFF_DT + (size_t)T * 8 * 4, OFF_BAR = OFF_CD + 8192, WS_END = OFF_BAR + 16384;
static_assert(OFF_ST + (size_t)2 * 128 * 8 * 64 * 128 * 2 <= OFF_MIX, "states must fit behind proj");
static_assert(WS_END <= (size_t)512 * 1024 * 1024, "workspace");
constexpr int LDS_BYTES = 147456;
constexpr int PIT = 136;

struct Params {
    const float *x, *p, *mix_g, *w_in, *conv_w, *conv_b, *dt_bias, *a_log, *d_skip, *norm_g, *pool_w, *pool_scale, *w_out, *ffn_g, *w_up, *fconv_w, *fconv_b, *w_down,
        *ple_g, *w_gate, *w_ple, *final_g;
    float* out; unsigned char* ws;
};

__device__ __forceinline__ float bf_lo(unsigned u) { return __uint_as_float(u << 16); }
__device__ __forceinline__ float bf_hi(unsigned u) { return __uint_as_float(u & 0xffff0000u); }
__device__ __forceinline__ float bf2f(bf16_t b) { return __uint_as_float(((unsigned)b) << 16); }
__device__ __forceinline__ bf16_t f2bf(float f) { return (bf16_t)(cvt_pk_bf16(f, 0.f) & 0xffffu); }
__device__ __forceinline__ float fast_sigmoid(float v) { return __builtin_amdgcn_rcpf(1.f + __builtin_amdgcn_exp2f(-1.4426950409f * v)); }
__device__ __forceinline__ float silu_f(float v) { return v * fast_sigmoid(v); }
__device__ __forceinline__ float gelu_tanh(float v) { const float t = v * (1.f + 0.044715f * v * v); return v * __builtin_amdgcn_rcpf(1.f + __builtin_amdgcn_exp2f(-2.302208198f * t)); }
__device__ __forceinline__ float softplus_f(float v) { return v > 20.f ? v : log1pf(__expf(v)); }
__device__ __forceinline__ float wave_sum(float v) {
#pragma unroll
    for (int o = 1; o < 64; o <<= 1) v += __shfl_xor(v, o);
    return v;
}
template <int CTRL> __device__ __forceinline__ float dppf(float v) { return __builtin_bit_cast(float, __builtin_amdgcn_update_dpp(0, __builtin_bit_cast(int, v), CTRL, 0xf, 0xf, true)); }
__device__ __forceinline__ float row_rstd(const float* ss, int row) {
    const f32x4* p = (const f32x4*)(ss + (size_t)row * 16);
    const f32x4 a = p[0], b = p[1], c = p[2], d = p[3];
    const float s = ((a.x + a.y) + (a.z + a.w)) + ((b.x + b.y) + (b.z + b.w)) + ((c.x + c.y) + (c.z + c.w)) + ((d.x + d.y) + (d.z + d.w));
    return rsqrtf(s * (1.f / 1024.f) + EPS);
}
__device__ __forceinline__ float row_rstd_coop(const float* ss, int row, int fq) {
    const f32x4 a = *(const f32x4*)(ss + (size_t)row * 16 + 4 * fq);
    float s = (a.x + a.y) + (a.z + a.w);
    s += __shfl_xor(s, 16); s += __shfl_xor(s, 32);
    return rsqrtf(s * (1.f / 1024.f) + EPS);
}
__device__ __forceinline__ void rstd8(const float* ss, int rbase, int fq, float (&rs)[2][4]) {
    f32x4 a[2][4];
#pragma unroll
    for (int ai = 0; ai < 2; ++ai)
#pragma unroll
        for (int m = 0; m < 4; ++m) a[ai][m] = *(const f32x4*)(ss + (size_t)(rbase + ai * 128 + m * 16) * 16 + 4 * fq);
#pragma unroll
    for (int ai = 0; ai < 2; ++ai)
#pragma unroll
        for (int m = 0; m < 4; ++m) { float s = (a[ai][m].x + a[ai][m].y) + (a[ai][m].z + a[ai][m].w); s += __shfl_xor(s, 16); s += __shfl_xor(s, 32); rs[ai][m] = rsqrtf(s * (1.f / 1024.f) + EPS); }
}
#define LDS_FENCE() asm volatile("s_waitcnt lgkmcnt(0)" ::: "memory")

struct EpiIn {
    static constexpr bool PERM = true, AFTER_DRAIN = false;
    bf16_t* O; const float* ss;
    __device__ __forceinline__ void operator()(const f32x4 (&acc)[2][2][4][2], const pg8::Unit& u, int wr, int wc, int fr, int fq) const {
        const int col0 = u.pn * 256 + wc * 32 + 8 * fq, rbase = u.pm * 256 + wr * 64 + fr;
        float rs[2][4]; rstd8(ss, rbase, fq, rs);
#pragma unroll
        for (int ai = 0; ai < 2; ++ai)
#pragma unroll
            for (int m = 0; m < 4; ++m) {
                const int row = rbase + ai * 128 + m * 16; const float r1 = rs[ai][m];
                bf16_t* rowp = O + (size_t)row * NPROJ + col0;
#pragma unroll
                for (int bj = 0; bj < 2; ++bj) { const f32x4 v0 = acc[ai][bj][m][0] * r1, v1 = acc[ai][bj][m][1] * r1;
                    u32x4 w; w.x = cvt_pk_bf16(v0[0], v0[1]); w.y = cvt_pk_bf16(v0[2], v0[3]); w.z = cvt_pk_bf16(v1[0], v1[1]); w.w = cvt_pk_bf16(v1[2], v1[3]);
                    *(u32x4*)(rowp + bj * 128) = w; } }
    }
};
struct EpiQ {
    static constexpr bool PERM = true, AFTER_DRAIN = false;
    bf16_t* O;
    __device__ __forceinline__ void operator()(const f32x4 (&acc)[2][2][4][2], const pg8::Unit& u, int wr, int wc, int fr, int fq) const {
        const int col0 = u.pn * 256 + wc * 32 + 8 * fq;
#pragma unroll
        for (int ai = 0; ai < 2; ++ai)
#pragma unroll
            for (int m = 0; m < 4; ++m) {
                const int row = u.pm * 256 + ai * 128 + wr * 64 + m * 16 + fr; bf16_t* rowp = O + (size_t)row * D + col0;
#pragma unroll
                for (int bj = 0; bj < 2; ++bj) { const f32x4 v0 = acc[ai][bj][m][0], v1 = acc[ai][bj][m][1];
                    u32x4 w; w.x = cvt_pk_bf16(v0[0], v0[1]); w.y = cvt_pk_bf16(v0[2], v0[3]); w.z = cvt_pk_bf16(v1[0], v1[1]); w.w = cvt_pk_bf16(v1[2], v1[3]);
                    *(u32x4*)(rowp + bj * 128) = w; } }
    }
};
template <bool GATE> struct EpiRes {
    static constexpr bool PERM = false, AFTER_DRAIN = false;
    const float* hin; float* hout; bf16_t* hb; float* ssw; const float* ssr; const bf16_t* q;
    __device__ __forceinline__ void operator()(const f32x4 (&acc)[2][2][4][2], const pg8::Unit& u, int wr, int wc, int fr, int fq) const {
        constexpr int MB = GATE ? 1 : 4;
        const int col0 = u.pn * 256 + wc * 32 + 4 * fq, rbase = u.pm * 256 + wr * 64 + fr;
        float rs[2][4];
        if (GATE) rstd8(ssr, rbase, fq, rs);
#pragma unroll
        for (int ai = 0; ai < 2; ++ai)
#pragma unroll
            for (int mb = 0; mb < 4; mb += MB) {
                f32x4 hv[MB][4]; u32x2 qv[MB][4];
#pragma unroll
                for (int mm = 0; mm < MB; ++mm)
#pragma unroll
                    for (int c = 0; c < 4; ++c) { const size_t off = (size_t)(rbase + ai * 128 + (mb + mm) * 16) * D + col0 + (c >> 1) * 128 + (c & 1) * 16;
                        hv[mm][c] = *(const f32x4*)(hin + off); if (GATE) qv[mm][c] = *(const u32x2*)(q + off); }
#pragma unroll
                for (int mm = 0; mm < MB; ++mm) { const int m = mb + mm, row = rbase + ai * 128 + m * 16; float sq = 0.f;
#pragma unroll
                    for (int c = 0; c < 4; ++c) { const size_t off = (size_t)row * D + col0 + (c >> 1) * 128 + (c & 1) * 16;
                        f32x4 v = hv[mm][c]; const f32x4 a = acc[ai][c >> 1][m][c & 1];
                        if (GATE) { const float r1 = rs[ai][m]; const u32x2 qq = qv[mm][c];
                            v[0] += bf_lo(qq.x) * fast_sigmoid(a[0] * r1); v[1] += bf_hi(qq.x) * fast_sigmoid(a[1] * r1);
                            v[2] += bf_lo(qq.y) * fast_sigmoid(a[2] * r1); v[3] += bf_hi(qq.y) * fast_sigmoid(a[3] * r1); }
                        else v += a;
                        *(f32x4*)(hout + off) = v;
                        u32x2 w; w.x = cvt_pk_bf16(v[0], v[1]); w.y = cvt_pk_bf16(v[2], v[3]); *(u32x2*)(hb + off) = w;
                        sq += (v[0] * v[0] + v[1] * v[1]) + (v[2] * v[2] + v[3] * v[3]); }
                    sq += __shfl_xor(sq, 16); sq += __shfl_xor(sq, 32);
                    if (fq == 0) ssw[(size_t)row * 16 + u.pn * 4 + wc] = sq; } }
    }
};
struct UpOrder : pg8::StaticOrder {
    const float* cw; const float* cb; LAS float* pbuf; mutable int na;
    __device__ __forceinline__ void a_ready(const pg8::Unit& u) const {
        const int t = threadIdx.x, qd = t >> 6, c = 2 * (t & 63);
        const float* src = ((qd & 3) == 3 ? cb : cw + (size_t)(qd & 3) * DUP) + (qd >> 2) * DFF + u.pn * 128 + c;
        const f32x2 v = *(const f32x2*)src;
        *(LAS f32x2*)(pbuf + (na & 1) * 1024 + qd * 128 + c) = v;
        ++na;
    }
};
struct EpiUp {
    static constexpr bool PERM = true, AFTER_DRAIN = false;
    bf16_t* act; const float* ss; const LAS float* pbuf; float* head; float* tail; mutable int ne;
    __device__ __forceinline__ void operator()(const f32x4 (&acc)[2][2][4][2], const pg8::Unit& u, int wr, int wc, int fr, int fq) const {
        const LAS float* pp = pbuf + (ne & 1) * 1024 + wc * 32 + 8 * fq; ++ne;
        const int jg0 = u.pn * 128 + wc * 32 + 8 * fq, rb0 = u.pm * 256 + wr * 64 + fr;
        float rs[2][4]; rstd8(ss, rb0, fq, rs);
#pragma unroll
        for (int ai = 0; ai < 2; ++ai) {
            const int rbase = rb0 + ai * 128, strip = u.pm * 4 + ai * 2 + wr;
            unsigned ow[4][4];
#pragma unroll
            for (int nj = 0; nj < 4; ++nj) {
                const int n = nj >> 1, j0 = 2 * (nj & 1), cl = 4 * n + j0, jg = jg0 + cl;
                const f32x2 w0g = *(const LAS f32x2*)(pp + cl), w1g = *(const LAS f32x2*)(pp + 128 + cl), w2g = *(const LAS f32x2*)(pp + 256 + cl), bg = *(const LAS f32x2*)(pp + 384 + cl);
                const f32x2 w0v = *(const LAS f32x2*)(pp + 512 + cl), w1v = *(const LAS f32x2*)(pp + 640 + cl), w2v = *(const LAS f32x2*)(pp + 768 + cl), bv = *(const LAS f32x2*)(pp + 896 + cl);
                f32x2 pg = {0.f, 0.f}, pv = {0.f, 0.f};
#pragma unroll
                for (int m = 0; m < 4; ++m) {
                    const float r1 = rs[ai][m];
                    const f32x2 xg = {acc[ai][0][m][n][j0] * r1, acc[ai][0][m][n][j0 + 1] * r1}, xv = {acc[ai][1][m][n][j0] * r1, acc[ai][1][m][n][j0 + 1] * r1};
                    if (m == 0 && fr < 2) { float* hp = head + ((size_t)(strip * 2 + fr)) * DUP + jg; *(f32x2*)hp = xg; *(f32x2*)(hp + DFF) = xv; }
                    if (m == 3 && fr >= 14) { float* tp = tail + ((size_t)(strip * 2 + fr - 14)) * DUP + jg; *(f32x2*)tp = xg; *(f32x2*)(tp + DFF) = xv; }
                    float o[2];
#pragma unroll
                    for (int j = 0; j < 2; ++j) {
                        const float g1 = dppf<0x111>(xg[j]) + dppf<0x10F>(pg[j]), g2 = dppf<0x112>(xg[j]) + dppf<0x10E>(pg[j]);
                        const float v1 = dppf<0x111>(xv[j]) + dppf<0x10F>(pv[j]), v2 = dppf<0x112>(xv[j]) + dppf<0x10E>(pv[j]);
                        const float cgv = bg[j] + w0g[j] * g2 + w1g[j] * g1 + w2g[j] * xg[j];
                        const float cvv = bv[j] + w0v[j] * v2 + w1v[j] * v1 + w2v[j] * xv[j];
                        o[j] = gelu_tanh(cgv) * cvv; }
                    ow[m][nj] = cvt_pk_bf16(o[0], o[1]);
                    pg = xg; pv = xv; } }
#pragma unroll
            for (int m = 0; m < 4; ++m)
                if (!(m == 0 && fr < 2)) { u32x4 w; w.x = ow[m][0]; w.y = ow[m][1]; w.z = ow[m][2]; w.w = ow[m][3]; *(u32x4*)(act + (size_t)(rbase + 16 * m) * DFF + jg0) = w; } }
    }
};
__device__ __forceinline__ void tr_item(const float* W, int ldw, bf16_t* WT, int Kd, int k0, int n0, int sc0, const float* kscale, const float* nscale, LAS float* scr, int lane) {
#pragma unroll 8
    for (int i = 0; i < 32; ++i) { const int kk = 2 * i + (lane >> 5); float v = W[(size_t)(k0 + kk) * ldw + sc0 + (lane & 31)]; if (kscale) v *= kscale[k0 + kk]; scr[kk * 33 + (lane & 31)] = v; }
    LDS_FENCE();
    const int c = lane & 7;
#pragma unroll
    for (int j = 0; j < 4; ++j) { const int n = (lane >> 3) + 8 * j; const LAS float* s = scr + (8 * c) * 33 + n; const float ns = nscale ? nscale[sc0 + n] : 1.f;
        u32x4 o; o.x = cvt_pk_bf16(s[0] * ns, s[33] * ns); o.y = cvt_pk_bf16(s[2 * 33] * ns, s[3 * 33] * ns); o.z = cvt_pk_bf16(s[4 * 33] * ns, s[5 * 33] * ns); o.w = cvt_pk_bf16(s[6 * 33] * ns, s[7 * 33] * ns);
        *(u32x4*)(WT + (size_t)(n0 + n) * Kd + k0 + 8 * c) = o; }
    LDS_FENCE();
}
__device__ __forceinline__ void phase0(const Params& P, LAS unsigned char* lds, int G, int bid) {
    int tid_ = threadIdx.x; asm volatile("" : "+v"(tid_)); const int tid = tid_, lane = tid & 63, wave = tid >> 6;
    bf16_t* wt = (bf16_t*)(P.ws + OFF_WT);
    LAS float* scr = (LAS float*)(lds + wave * 8704);
    const int gw = bid * 8 + wave, NGW = G * 8;
    constexpr int IPL = 1024 + 512 + 2816 + 1408 + 512 + 128 + 32;
    for (int it = gw; it < NL * IPL; it += NGW) {
        const int l = it / IPL; int r = it % IPL;
        bf16_t* wl = wt + (size_t)l * WLAYER;
        const float* W; int ldw, Kd, kb, nb, sc0; bf16_t* WT; const float* ks = nullptr; const float* ns = nullptr;
        if (r < 1024) { W = P.w_in + (size_t)l * 1024 * 2056; ldw = 2056; Kd = 1024; WT = wl + WIN; ks = P.mix_g + l * 1024; kb = r / 64; nb = r % 64; sc0 = 32 * nb < 1536 ? 32 * nb : 32 * nb + 8; }
        else if ((r -= 1024) < 512) { W = P.w_out + (size_t)l * 1024 * 1024; ldw = 1024; Kd = 1024; WT = wl + WOUT; kb = r / 32; nb = r % 32; sc0 = 32 * nb; }
        else if ((r -= 512) < 2816) { W = P.w_up + (size_t)l * 1024 * DUP; ldw = DUP; Kd = 1024; WT = wl + WUP; ks = P.ffn_g + l * 1024; kb = r / 176; nb = r % 176;
            const int n0 = 32 * nb, pn = n0 >> 8, rr = n0 & 255; sc0 = rr < 128 ? 128 * pn + rr : DFF + 128 * pn + (rr - 128); }
        else if ((r -= 2816) < 1408) { W = P.w_down + (size_t)l * DFF * 1024; ldw = 1024; Kd = DFF; WT = wl + WDOWN; kb = r / 32; nb = r % 32; sc0 = 32 * nb; }
        else if ((r -= 1408) < 512) { W = P.w_gate + (size_t)l * 1024 * 1024; ldw = 1024; Kd = 1024; WT = wl + WGATE; ks = P.ple_g + l * 1024; kb = r / 32; nb = r % 32; sc0 = 32 * nb; }
        else if ((r -= 512) < 128) { W = P.w_ple + (size_t)l * DPLE * 1024; ldw = 1024; Kd = DPLE; WT = wl + WPLE; kb = r / 32; nb = r % 32; sc0 = 32 * nb; }
        else { r -= 128; const int gi = r >> 3, rr = r & 7; kb = rr >> 2; nb = rr & 3; W = P.pool_w + (size_t)(l * 4 + gi) * 128 * 128; ldw = 128; Kd = 128; WT = wl + WPOOL + gi * 128 * 128;
            ns = P.pool_scale + l * 512 + gi * 128; sc0 = 32 * nb; }
        tr_item(W, ldw, WT, Kd, 64 * kb, 32 * nb, sc0, ks, ns, scr, lane);
    }
    for (int idx = bid * 512 + tid; idx < NL * 16 * 1024; idx += G * 512) {
        const int l = idx >> 14, j = (idx >> 10) & 15, k = idx & 1023;
        const float v = j < 8 ? P.w_in[(size_t)l * 1024 * 2056 + (size_t)k * 2056 + 1536 + j] * P.mix_g[l * 1024 + k] : 0.f;
        wt[(size_t)l * WLAYER + WDT + j * 1024 + k] = f2bf(v);
    }
    bf16_t* hb0 = (bf16_t*)(P.ws + OFF_HB0); float* ss0 = (float*)(P.ws + OFF_SS);
    for (int row = gw; row < T; row += NGW) {
        const f32x4* xr = (const f32x4*)(P.x + (size_t)row * D) + lane; float s = 0.f;
#pragma unroll
        for (int j = 0; j < 4; ++j) { const f32x4 v = xr[64 * j]; s += (v.x * v.x + v.y * v.y) + (v.z * v.z + v.w * v.w);
            u32x2 w; w.x = cvt_pk_bf16(v.x, v.y); w.y = cvt_pk_bf16(v.z, v.w); *(u32x2*)(hb0 + (size_t)row * D + 4 * lane + 256 * j) = w; }
        s = wave_sum(s);
        if (lane < 16) ss0[(size_t)row * 16 + lane] = lane == 0 ? s : 0.f;
    }
}

#define MFMA32(a, b, c) __builtin_amdgcn_mfma_f32_32x32x16_bf16((a), (b), (c), 0, 0, 0)
__device__ __forceinline__ void conv8x2(const bf16_t* proj, long row0, int tl0, bool seqstart, int pcol, const float* cw, const float* cb, int xch, float (&o0)[8], float (&o1)[8]) {
    unsigned v[11];
#pragma unroll
    for (int i = 0; i < 11; ++i) { const int tl = tl0 - 3 + i; v[i] = (tl >= 0 || !seqstart) ? *(const unsigned*)(proj + (size_t)(row0 + tl) * NPROJ + pcol) : 0u; }
    const f32x2 w0 = *(const f32x2*)(cw + xch), w1 = *(const f32x2*)(cw + 1024 + xch), w2 = *(const f32x2*)(cw + 2048 + xch), w3 = *(const f32x2*)(cw + 3072 + xch), bb = *(const f32x2*)(cb + xch);
#pragma unroll
    for (int i = 0; i < 8; ++i) {
        const float a = bb.x + w0.x * bf_lo(v[i]) + w1.x * bf_lo(v[i + 1]) + w2.x * bf_lo(v[i + 2]) + w3.x * bf_lo(v[i + 3]);
        const float b = bb.y + w0.y * bf_hi(v[i]) + w1.y * bf_hi(v[i + 1]) + w2.y * bf_hi(v[i + 2]) + w3.y * bf_hi(v[i + 3]);
        o0[i] = silu_f(a); o1[i] = silu_f(b); }
}
__device__ __forceinline__ float chunk_cumsum(LAS float* dtT, LAS float* acs, int wave, int lane, float Ah) {
    float last = 0.f;
    if (wave < 4) {
        const float a0 = dtT[wave * 128 + 2 * lane] * Ah, a1 = dtT[wave * 128 + 2 * lane + 1] * Ah; float v = a0 + a1;
#pragma unroll
        for (int o = 1; o < 64; o <<= 1) { const float t = __shfl_up(v, o); if (lane >= o) v += t; }
        acs[wave * 128 + 2 * lane] = v - a1; acs[wave * 128 + 2 * lane + 1] = v;
        last = __shfl(v, 63);
    }
    return last;
}
struct SsdCtx { const bf16_t* proj; const bf16_t* hb; const float* ss; const bf16_t* wdt; const float* cw; const float* cb; const float* dt_bias; const float* a_log; const float* d_skip; const float* norm_g;
                bf16_t* states; float* dtbuf; float* cdecay; bf16_t* mix; const bf16_t* pwt; };

__device__ __forceinline__ void ssd_s1_job(const SsdCtx& C, LAS unsigned char* lds, int b, int c, int g) {
    int tid_ = threadIdx.x; asm volatile("" : "+v"(tid_)); const int tid = tid_, lane = tid & 63, wave = tid >> 6;
    LAS bf16_t* XdT = (LAS bf16_t*)lds; LAS bf16_t* BT = (LAS bf16_t*)(lds + 256 * PIT * 2);
    LAS float* dtT = (LAS float*)(lds + 139264); LAS float* acs = dtT + 512;
    const long row0 = (long)b * SEQ + c * 128;
    {
        pg8::f32x4 acc = {0.f, 0.f, 0.f, 0.f};
        const bf16_t* ar = C.hb + (size_t)(row0 + 16 * wave + (lane & 15)) * D + 8 * (lane >> 4);
        const bf16_t* br = C.wdt + (size_t)(lane & 15) * D + 8 * (lane >> 4);
#pragma unroll 1
        for (int kb = 0; kb < 4; ++kb) {
            bf16x8 a[8], bb[8];
#pragma unroll
            for (int i = 0; i < 8; ++i) { a[i] = __builtin_nontemporal_load((const bf16x8*)(ar + 256 * kb + 32 * i)); bb[i] = *(const bf16x8*)(br + 256 * kb + 32 * i); }
#pragma unroll
            for (int i = 0; i < 8; ++i) acc = __builtin_amdgcn_mfma_f32_16x16x32_bf16(a[i], bb[i], acc, 0, 0, 0);
        }
        const int head = lane & 15;
        if (head >= 4 * g && head < 4 * g + 4) {
            const float bias = C.dt_bias[head];
#pragma unroll
            for (int rg = 0; rg < 4; ++rg) { const int tok = 16 * wave + 4 * (lane >> 4) + rg; const float rs = row_rstd(C.ss, (int)(row0 + tok));
                const float dt = softplus_f(acc[rg] * rs + bias); dtT[(head - 4 * g) * 128 + tok] = dt; C.dtbuf[(size_t)(row0 + tok) * 8 + head] = dt; } }
    }
    __syncthreads();
    {
        const float Ah = wave < 4 ? -__expf(C.a_log[4 * g + wave]) : 0.f;
        const float last = chunk_cumsum(dtT, acs, wave, lane, Ah);
        if (wave < 4 && lane == 0) C.cdecay[(size_t)(b * 128 + c) * 8 + 4 * g + wave] = __expf(last);
    }
    __syncthreads();
    for (int idx = tid; idx < 192 * 16; idx += 512) {
        const int cp = idx % 192, r = idx / 192; const bool isx = cp < 128;
        const int xch = isx ? g * 256 + 2 * cp : 512 + g * 128 + 2 * (cp - 128);
        float o0[8], o1[8];
        conv8x2(C.proj, row0, 8 * r, c == 0, 512 + xch, C.cw, C.cb, xch, o0, o1);
        if (isx) { const int hh = cp >> 5; const float al = acs[hh * 128 + 127];
#pragma unroll
            for (int i = 0; i < 8; ++i) { const float sc = dtT[hh * 128 + 8 * r + i] * __expf(al - acs[hh * 128 + 8 * r + i]); o0[i] *= sc; o1[i] *= sc; } }
        LAS bf16_t* dst = isx ? XdT + (2 * cp) * PIT + 8 * r : BT + (2 * (cp - 128)) * PIT + 8 * r;
        u32x4 w0, w1; w0.x = cvt_pk_bf16(o0[0], o0[1]); w0.y = cvt_pk_bf16(o0[2], o0[3]); w0.z = cvt_pk_bf16(o0[4], o0[5]); w0.w = cvt_pk_bf16(o0[6], o0[7]);
        w1.x = cvt_pk_bf16(o1[0], o1[1]); w1.y = cvt_pk_bf16(o1[2], o1[3]); w1.z = cvt_pk_bf16(o1[4], o1[5]); w1.w = cvt_pk_bf16(o1[6], o1[7]);
        *(LAS u32x4*)dst = w0; *(LAS u32x4*)(dst + PIT) = w1;
    }
    __syncthreads();
    {
        const int hh = wave >> 1, nh = wave & 1, r = lane & 31, hq = lane >> 5;
        f32x16 acc[2][2];
#pragma unroll
        for (int i = 0; i < 2; ++i)
#pragma unroll
            for (int j = 0; j < 2; ++j)
#pragma unroll
                for (int e = 0; e < 16; ++e) acc[i][j][e] = 0.f;
#pragma unroll 2
        for (int ks = 0; ks < 8; ++ks) {
            bf16x8 a[2], bb[2];
#pragma unroll
            for (int i = 0; i < 2; ++i) { a[i] = *(const LAS bf16x8*)(XdT + (64 * hh + 32 * i + r) * PIT + 16 * ks + 8 * hq); bb[i] = *(const LAS bf16x8*)(BT + (64 * nh + 32 * i + r) * PIT + 16 * ks + 8 * hq); }
#pragma unroll
            for (int i = 0; i < 2; ++i)
#pragma unroll
                for (int j = 0; j < 2; ++j) acc[i][j] = MFMA32(a[i], bb[j], acc[i][j]);
        }
        bf16_t* st = C.states + ((size_t)(b * 128 + c) * 8 + 4 * g + hh) * 64 * 128;
#pragma unroll
        for (int i = 0; i < 2; ++i)
#pragma unroll
            for (int j = 0; j < 2; ++j)
#pragma unroll
                for (int e = 0; e < 16; ++e) { const int p = 32 * i + (e & 3) + 8 * (e >> 2) + 4 * hq, n = 64 * nh + 32 * j + r; st[p * 128 + n] = f2bf(acc[i][j][e]); }
    }
    __syncthreads();
}

template <int W> __device__ __forceinline__ void pool_fill(const bf16_t* proj, long row0, bool seqstart, int gi, LAS bf16_t* Pl, int tid) {
    const int cp = tid & 63, run = tid >> 6, pcol = 1536 + gi * 128 + 2 * cp;
    float u0[31], u1[31];
#pragma unroll
    for (int i = 0; i < 31; ++i) { const int tl = 16 * run - 15 + i; const unsigned v = (tl >= 0 || !seqstart) ? *(const unsigned*)(proj + (size_t)(row0 + tl) * NPROJ + pcol) : 0u; u0[i] = bf_lo(v); u1[i] = bf_hi(v); }
    float s0 = 0.f, s1 = 0.f;
#pragma unroll
    for (int j = 1; j < W; ++j) { s0 += u0[15 - j]; s1 += u1[15 - j]; }
#pragma unroll
    for (int i = 0; i < 16; ++i) {
        s0 += u0[15 + i]; s1 += u1[15 + i];
        const int tl = 16 * run + i; const float dv = seqstart ? (float)(tl + 1 < W ? tl + 1 : W) : (float)W; const float inv = 1.f / dv;
        *(LAS unsigned*)(Pl + tl * PIT + 2 * cp) = cvt_pk_bf16(s0 * inv - u0[15 + i], s1 * inv - u1[15 + i]);
        s0 -= u0[15 + i - (W - 1)]; s1 -= u1[15 + i - (W - 1)];
    }
}
__device__ __forceinline__ void pool_job(const SsdCtx& C, LAS unsigned char* lds, int tb, int gi) {
    int tid_ = threadIdx.x; asm volatile("" : "+v"(tid_)); const int tid = tid_, lane = tid & 63, wave = tid >> 6;
    LAS bf16_t* Pl = (LAS bf16_t*)lds; LAS bf16_t* Wp = (LAS bf16_t*)(lds + 128 * PIT * 2);
    const long row0 = (long)tb * 128; const bool seqstart = (tb & 127) == 0;
    for (int i = tid; i < 2048; i += 512) { const int d = i >> 4, c8 = i & 15; *(LAS u32x4*)(Wp + d * PIT + 8 * c8) = *(const u32x4*)(C.pwt + (size_t)gi * 16384 + d * 128 + 8 * c8); }
    if (gi == 0) pool_fill<2>(C.proj, row0, seqstart, gi, Pl, tid); else if (gi == 1) pool_fill<4>(C.proj, row0, seqstart, gi, Pl, tid);
    else if (gi == 2) pool_fill<8>(C.proj, row0, seqstart, gi, Pl, tid); else pool_fill<16>(C.proj, row0, seqstart, gi, Pl, tid);
    __syncthreads();
    {
        const int mi = wave >> 1, r = lane & 31, hq = lane >> 5;
        f32x16 acc[2];
#pragma unroll
        for (int j = 0; j < 2; ++j)
#pragma unroll
            for (int e = 0; e < 16; ++e) acc[j][e] = 0.f;
#pragma unroll 2
        for (int ks = 0; ks < 8; ++ks) {
            const bf16x8 a = *(const LAS bf16x8*)(Pl + (32 * mi + r) * PIT + 16 * ks + 8 * hq);
#pragma unroll
            for (int j = 0; j < 2; ++j) { const int ni = 2 * (wave & 1) + j; const bf16x8 bb = *(const LAS bf16x8*)(Wp + (32 * ni + r) * PIT + 16 * ks + 8 * hq); acc[j] = MFMA32(a, bb, acc[j]); }
        }
#pragma unroll
        for (int j = 0; j < 2; ++j) { const int ni = 2 * (wave & 1) + j;
#pragma unroll
            for (int e = 0; e < 16; ++e) { const int tl = 32 * mi + (e & 3) + 8 * (e >> 2) + 4 * hq; C.mix[(size_t)(row0 + tl) * D + 512 + gi * 128 + 32 * ni + r] = f2bf(acc[j][e]); } }
    }
    __syncthreads();
}

__device__ __forceinline__ void scan_phase(bf16_t* states, const float* cdecay, int G, int bid) {
    int tid_ = threadIdx.x; asm volatile("" : "+v"(tid_));
    for (int idx = bid * 512 + tid_; idx < 2 * 8 * 64 * 128; idx += G * 512) {
        const int n = idx & 127, p = (idx >> 7) & 63, h = (idx >> 13) & 7, b = idx >> 16;
        bf16_t* sp = states + ((size_t)b * 128 * 8 + h) * 8192 + p * 128 + n; const float* dp = cdecay + (size_t)b * 128 * 8 + h;
        float s = 0.f;
        for (int c0 = 0; c0 < 128; c0 += 16) {
            float v[16], d[16];
#pragma unroll
            for (int i = 0; i < 16; ++i) { v[i] = bf2f(sp[(size_t)(c0 + i) * 8 * 8192]); d[i] = dp[(c0 + i) * 8]; }
#pragma unroll
            for (int i = 0; i < 16; ++i) { sp[(size_t)(c0 + i) * 8 * 8192] = f2bf(s); s = s * d[i] + v[i]; }
        }
    }
}
__device__ __forceinline__ void ssd_s3_job(const SsdCtx& C, LAS unsigned char* lds, int b, int c, int g) {
    int tid_ = threadIdx.x; asm volatile("" : "+v"(tid_)); const int tid = tid_, lane = tid & 63, wave = tid >> 6;
    LAS bf16_t* Cn = (LAS bf16_t*)lds; LAS bf16_t* CBm = (LAS bf16_t*)(lds + 128 * PIT * 2); LAS bf16_t* Bn = (LAS bf16_t*)(lds + 256 * PIT * 2); LAS bf16_t* XT = Bn;
    LAS float* dtT = (LAS float*)(lds + 139264); LAS float* acs = dtT + 512; LAS float* red = dtT + 1024;
    const long row0 = (long)b * SEQ + c * 128;
    { const int tok = tid >> 2, hh = tid & 3; dtT[hh * 128 + tok] = C.dtbuf[(size_t)(row0 + tok) * 8 + 4 * g + hh]; }
    __syncthreads();
    { const float Ah = wave < 4 ? -__expf(C.a_log[4 * g + wave]) : 0.f; (void)chunk_cumsum(dtT, acs, wave, lane, Ah); }
    for (int idx = tid; idx < 128 * 16; idx += 512) {
        const int cp = idx & 127, r = idx >> 7; const bool isB = cp < 64;
        const int xch = isB ? 512 + g * 128 + 2 * cp : 768 + g * 128 + 2 * (cp - 64);
        float o0[8], o1[8];
        conv8x2(C.proj, row0, 8 * r, c == 0, 512 + xch, C.cw, C.cb, xch, o0, o1);
        LAS bf16_t* dst = (isB ? Bn + 2 * cp : Cn + 2 * (cp - 64)) + (8 * r) * PIT;
#pragma unroll
        for (int i = 0; i < 8; ++i) *(LAS unsigned*)(dst + i * PIT) = cvt_pk_bf16(o0[i], o1[i]);
    }
    __syncthreads();
    {
        const int mi = wave >> 1, r = lane & 31, hq = lane >> 5;
        f32x16 acc[2];
#pragma unroll
        for (int j = 0; j < 2; ++j)
#pragma unroll
            for (int e = 0; e < 16; ++e) acc[j][e] = 0.f;
#pragma unroll 2
        for (int ks = 0; ks < 8; ++ks) {
            const bf16x8 a = *(const LAS bf16x8*)(Cn + (32 * mi + r) * PIT + 16 * ks + 8 * hq);
#pragma unroll
            for (int j = 0; j < 2; ++j) { const int ni = 2 * (wave & 1) + j; const bf16x8 bb = *(const LAS bf16x8*)(Bn + (32 * ni + r) * PIT + 16 * ks + 8 * hq); acc[j] = MFMA32(a, bb, acc[j]); }
        }
#pragma unroll
        for (int j = 0; j < 2; ++j) { const int ni = 2 * (wave & 1) + j;
#pragma unroll
            for (int e = 0; e < 16; ++e) { const int l = 32 * mi + (e & 3) + 8 * (e >> 2) + 4 * hq; CBm[l * PIT + 32 * ni + r] = f2bf(acc[j][e]); } }
    }
    __syncthreads();
    for (int idx = tid; idx < 128 * 16; idx += 512) {
        const int cp = idx & 127, r = idx >> 7; const int xch = g * 256 + 2 * cp;
        float o0[8], o1[8];
        conv8x2(C.proj, row0, 8 * r, c == 0, 512 + xch, C.cw, C.cb, xch, o0, o1);
        LAS bf16_t* dst = XT + (2 * cp) * PIT + 8 * r;
        u32x4 w0, w1; w0.x = cvt_pk_bf16(o0[0], o0[1]); w0.y = cvt_pk_bf16(o0[2], o0[3]); w0.z = cvt_pk_bf16(o0[4], o0[5]); w0.w = cvt_pk_bf16(o0[6], o0[7]);
        w1.x = cvt_pk_bf16(o1[0], o1[1]); w1.y = cvt_pk_bf16(o1[2], o1[3]); w1.z = cvt_pk_bf16(o1[4], o1[5]); w1.w = cvt_pk_bf16(o1[6], o1[7]);
        *(LAS u32x4*)dst = w0; *(LAS u32x4*)(dst + PIT) = w1;
    }
    __syncthreads();
    const int hh = wave >> 1, lh = wave & 1, r = lane & 31, hq = lane >> 5, h = 4 * g + hh;
    f32x16 acc[2][2];
#pragma unroll
    for (int i = 0; i < 2; ++i)
#pragma unroll
        for (int j = 0; j < 2; ++j)
#pragma unroll
            for (int e = 0; e < 16; ++e) acc[i][j][e] = 0.f;
    {
        const bf16_t* pv = C.states + ((size_t)(b * 128 + c) * 8 + h) * 64 * 128;
#pragma unroll 2
        for (int ks = 0; ks < 8; ++ks) {
            bf16x8 a[2], bb[2];
#pragma unroll
            for (int i = 0; i < 2; ++i) { a[i] = *(const bf16x8*)(pv + (32 * i + r) * 128 + 16 * ks + 8 * hq); bb[i] = *(const LAS bf16x8*)(Cn + (64 * lh + 32 * i + r) * PIT + 16 * ks + 8 * hq); }
#pragma unroll
            for (int i = 0; i < 2; ++i)
#pragma unroll
                for (int j = 0; j < 2; ++j) acc[i][j] = MFMA32(a[i], bb[j], acc[i][j]);
        }
#pragma unroll
        for (int j = 0; j < 2; ++j) { const float el = __expf(acs[hh * 128 + 64 * lh + 32 * j + r]);
#pragma unroll
            for (int i = 0; i < 2; ++i)
#pragma unroll
                for (int e = 0; e < 16; ++e) acc[i][j][e] *= el; }
    }
#pragma unroll
    for (int li = 0; li < 2; ++li) {
        const int l = 64 * lh + 32 * li + r; const float al = acs[hh * 128 + l];
        const int nks = 4 * lh + 2 * li + 2;
        for (int ks = 0; ks < nks; ++ks) {
            const int s0 = 16 * ks + 8 * hq;
            const u32x4 cb = *(const LAS u32x4*)(CBm + l * PIT + s0);
            const f32x4 as0 = *(const LAS f32x4*)(acs + hh * 128 + s0), as1 = *(const LAS f32x4*)(acs + hh * 128 + s0 + 4);
            const f32x4 d0 = *(const LAS f32x4*)(dtT + hh * 128 + s0), d1 = *(const LAS f32x4*)(dtT + hh * 128 + s0 + 4);
            float m[8];
            m[0] = bf_lo(cb.x) * __expf(al - as0[0]) * d0[0]; m[1] = bf_hi(cb.x) * __expf(al - as0[1]) * d0[1];
            m[2] = bf_lo(cb.y) * __expf(al - as0[2]) * d0[2]; m[3] = bf_hi(cb.y) * __expf(al - as0[3]) * d0[3];
            m[4] = bf_lo(cb.z) * __expf(al - as1[0]) * d1[0]; m[5] = bf_hi(cb.z) * __expf(al - as1[1]) * d1[1];
            m[6] = bf_lo(cb.w) * __expf(al - as1[2]) * d1[2]; m[7] = bf_hi(cb.w) * __expf(al - as1[3]) * d1[3];
#pragma unroll
            for (int j = 0; j < 8; ++j) m[j] = (s0 + j <= l) ? m[j] : 0.f;
            u32x4 mw; mw.x = cvt_pk_bf16(m[0], m[1]); mw.y = cvt_pk_bf16(m[2], m[3]); mw.z = cvt_pk_bf16(m[4], m[5]); mw.w = cvt_pk_bf16(m[6], m[7]);
            const bf16x8 mf = __builtin_bit_cast(bf16x8, mw);
#pragma unroll
            for (int pi = 0; pi < 2; ++pi) { const bf16x8 a = *(const LAS bf16x8*)(XT + (64 * hh + 32 * pi + r) * PIT + s0); acc[pi][li] = MFMA32(a, mf, acc[pi][li]); }
        }
    }
    const float Dh = C.d_skip[h];
    float sq[2] = {0.f, 0.f};
#pragma unroll
    for (int li = 0; li < 2; ++li) { const int l = 64 * lh + 32 * li + r;
#pragma unroll
        for (int pi = 0; pi < 2; ++pi)
#pragma unroll
            for (int e4 = 0; e4 < 4; ++e4) { const int p0 = 32 * pi + 8 * e4 + 4 * hq;
                const u32x2 zz = *(const u32x2*)(C.proj + (size_t)(row0 + l) * NPROJ + g * 256 + hh * 64 + p0);
                const float zf[4] = {bf_lo(zz.x), bf_hi(zz.x), bf_lo(zz.y), bf_hi(zz.y)};
#pragma unroll
                for (int k = 0; k < 4; ++k) { const float xs = bf2f(XT[(64 * hh + p0 + k) * PIT + l]); float y = acc[pi][li][4 * e4 + k] + xs * Dh; y *= silu_f(zf[k]); acc[pi][li][4 * e4 + k] = y; sq[li] += y * y; } }
        sq[li] += __shfl_xor(sq[li], 32);
        if (hq == 0) red[hh * 128 + l] = sq[li]; }
    __syncthreads();
#pragma unroll
    for (int li = 0; li < 2; ++li) { const int l = 64 * lh + 32 * li + r;
        const float rstd = rsqrtf((red[l] + red[128 + l] + red[256 + l] + red[384 + l]) * (1.f / 256.f) + EPS);
#pragma unroll
        for (int pi = 0; pi < 2; ++pi)
#pragma unroll
            for (int e4 = 0; e4 < 4; ++e4) { const int p0 = 32 * pi + 8 * e4 + 4 * hq, ch = g * 256 + hh * 64 + p0;
                const f32x4 ng = *(const f32x4*)(C.norm_g + ch);
                u32x2 w; w.x = cvt_pk_bf16(acc[pi][li][4 * e4] * rstd * ng[0], acc[pi][li][4 * e4 + 1] * rstd * ng[1]); w.y = cvt_pk_bf16(acc[pi][li][4 * e4 + 2] * rstd * ng[2], acc[pi][li][4 * e4 + 3] * rstd * ng[3]);
                *(u32x2*)(C.mix + (size_t)(row0 + l) * D + ch) = w; } }
    __syncthreads();
}

__device__ __forceinline__ void fixup_phase(const Params& P, int l, bf16_t* act, const float* head, const float* tail, bf16_t* pb, int G, int bid) {
    const float* cw = P.fconv_w + (size_t)l * 3 * DUP; const float* cb = P.fconv_b + (size_t)l * DUP;
    int tid_ = threadIdx.x; asm volatile("" : "+v"(tid_)); const int gt = bid * 512 + tid_, NT = G * 512;
    for (int idx = gt; idx < 512 * DFF; idx += NT) {
        const int s = idx / DFF, j = idx % DFF; const bool first = (s & 255) == 0;
        float o[2];
        float cvals[2][2];
#pragma unroll
        for (int gv = 0; gv < 2; ++gv) { const int col = j + gv * DFF;
            const float tm2 = first ? 0.f : tail[(size_t)((s - 1) * 2) * DUP + col], tm1 = first ? 0.f : tail[(size_t)((s - 1) * 2 + 1) * DUP + col];
            const float h0 = head[(size_t)(s * 2) * DUP + col], h1 = head[(size_t)(s * 2 + 1) * DUP + col];
            const float w0 = cw[col], w1 = cw[DUP + col], w2 = cw[2 * DUP + col], bb = cb[col];
            cvals[gv][0] = bb + w0 * tm2 + w1 * tm1 + w2 * h0; cvals[gv][1] = bb + w0 * tm1 + w1 * h0 + w2 * h1; }
        o[0] = gelu_tanh(cvals[0][0]) * cvals[1][0]; o[1] = gelu_tanh(cvals[0][1]) * cvals[1][1];
        act[(size_t)(64 * s) * DFF + j] = f2bf(o[0]); act[(size_t)(64 * s + 1) * DFF + j] = f2bf(o[1]);
    }
    const f32x4* ps = (const f32x4*)(P.p + (size_t)l * T * DPLE);
    for (int idx = gt; idx < T * DPLE / 4; idx += NT) { const f32x4 v = ps[idx]; u32x2 w; w.x = cvt_pk_bf16(v.x, v.y); w.y = cvt_pk_bf16(v.z, v.w); *(u32x2*)(pb + (size_t)idx * 4) = w; }
}

#define XB_TMO      128
#define XB_XCNT(j)  (256  + 64 * (j))
#define XB_XSUB(j)  (1280 + 64 * (j))
#define XB_XGEN(j)  (2304 + 64 * (j))
#define XB_TOP      3328
#define XB_TOPGEN   3392
#define XCD_BAR_WORDS 3456
#define XB_SPIN_CAP (1u << 18)

__device__ __forceinline__ unsigned xb_ld(unsigned* p)              { return __hip_atomic_load(p, __ATOMIC_RELAXED, __HIP_MEMORY_SCOPE_AGENT); }
__device__ __forceinline__ unsigned xb_add(unsigned* p, unsigned v) { return __hip_atomic_fetch_add(p, v, __ATOMIC_RELAXED, __HIP_MEMORY_SCOPE_AGENT); }
__device__ __forceinline__ unsigned xb_xcc_id() { return (unsigned)__builtin_amdgcn_s_getreg((3 << 11) | 20) & 0xFu; }
#define XB_SPIN(cond, bar) do { unsigned _sp = 0; while (cond) { __builtin_amdgcn_s_sleep(1); \
    if ((++_sp & 255u) == 0u) { if (xb_ld(&(bar)[XB_TMO])) break; if (_sp > XB_SPIN_CAP) { atomicAdd(&(bar)[XB_TMO], 1u); break; } } } } while (0)

struct XcdBarrier {
    unsigned* bar; unsigned x;
    volatile LAS unsigned* st;
};

__device__ __forceinline__ XcdBarrier xcd_barrier_post(unsigned* bar, volatile LAS unsigned* st) {
    XcdBarrier b; b.bar = bar; b.x = xb_xcc_id(); b.st = st;
    if (threadIdx.x == 0) (void)xb_add(&bar[XB_XCNT(b.x)], 1u);
    return b;
}
__device__ __forceinline__ void xcd_barrier_complete(unsigned* bar, unsigned x, unsigned& nloc, unsigned& nx) {
    const unsigned G = gridDim.x * gridDim.y * gridDim.z;
    unsigned sum, cnt, mine, sp = 0u;
    for (;;) {
        sum = 0u; cnt = 0u; mine = 0u;
#pragma unroll
        for (unsigned j = 0; j < 16; ++j) { const unsigned c = xb_ld(&bar[XB_XCNT(j)]); sum += c; cnt += (c > 0u) ? 1u : 0u; mine = (j == x) ? c : mine; }
        if (sum == G) break;
        __builtin_amdgcn_s_sleep(1);
        if ((++sp & 255u) == 0u) { if (xb_ld(&bar[XB_TMO])) break; if (sp > XB_SPIN_CAP) { atomicAdd(&bar[XB_TMO], 1u); break; } }
    }
    nloc = mine > 0u ? mine : 1u; nx = cnt > 0u ? cnt : 1u;
}

__device__ __forceinline__ void xcd_barrier(const XcdBarrier& b) {
    asm volatile("s_waitcnt vmcnt(0)" ::: "memory");
    __syncthreads();
    if (threadIdx.x == 0) {
        unsigned* bar = b.bar;
        __builtin_amdgcn_s_waitcnt(0);
        unsigned nloc = b.st[0], nx = b.st[1];
        if (nloc == 0u) { xcd_barrier_complete(bar, b.x, nloc, nx); b.st[0] = nloc; b.st[1] = nx; }
        const unsigned old = xb_add(&bar[XB_XSUB(b.x)], 1u);
        const unsigned gen = old / nloc;
        if (old + 1u == (gen + 1u) * nloc) {
            __builtin_amdgcn_fence(__ATOMIC_RELEASE, "agent");
            asm volatile("s_waitcnt vmcnt(0)" ::: "memory");
            const unsigned og = xb_add(&bar[XB_TOP], 1u);
            const unsigned tg = og / nx;
            if (og + 1u == (tg + 1u) * nx) xb_add(&bar[XB_TOPGEN], 1u);
            else XB_SPIN(xb_ld(&bar[XB_TOPGEN]) == tg, bar);
            __builtin_amdgcn_fence(__ATOMIC_ACQUIRE, "agent");
            xb_add(&bar[XB_XGEN(b.x)], 1u);
            asm volatile("s_waitcnt vmcnt(0)" ::: "memory");
        } else {
            XB_SPIN(xb_ld(&bar[XB_XGEN(b.x)]) == gen, bar);
            __builtin_amdgcn_fence(__ATOMIC_ACQUIRE, "agent");
            asm volatile("s_waitcnt vmcnt(0)" ::: "memory");
        }
    }
    __syncthreads();
}


__global__ __launch_bounds__(512, 2) void hymba_fwd(Params P) {
    extern __shared__ __attribute__((aligned(16))) unsigned char shm[];
    LAS unsigned char* lds = (LAS unsigned char*)shm;
    cg::grid_group grid = cg::this_grid();
    const int G = (int)gridDim.x, bid = (int)blockIdx.x;
    bf16_t* hbuf[2] = {(bf16_t*)(P.ws + OFF_HB0), (bf16_t*)(P.ws + OFF_HB1)};
    float* ssbuf[2] = {(float*)(P.ws + OFF_SS), (float*)(P.ws + OFF_SS) + (size_t)T * 16};
    bf16_t* wt = (bf16_t*)(P.ws + OFF_WT);
    bf16_t* proj = (bf16_t*)(P.ws + OFF_R); bf16_t* act = proj; bf16_t* states = (bf16_t*)(P.ws + OFF_ST);
    bf16_t* mix = (bf16_t*)(P.ws + OFF_MIX); bf16_t* qb = mix; float* head = (float*)(P.ws + OFF_MIX); float* tail = (float*)(P.ws + OFF_TAIL);
    bf16_t* pb = (bf16_t*)(P.ws + OFF_PB); float* dtbuf = (float*)(P.ws + OFF_DT); float* cdecay = (float*)(P.ws + OFF_CD);
    pg8::StaticOrder S;
    volatile LAS unsigned* xst = (volatile LAS unsigned*)(lds + LDS_BYTES - 16);
    if (threadIdx.x == 0) { xst[0] = 0u; xst[1] = 0u; }
    __syncthreads();
    const XcdBarrier xb = xcd_barrier_post((unsigned*)(P.ws + OFF_BAR), xst);

    phase0(P, lds, G, bid);
    grid.sync();
    int cur = 0;
#pragma unroll 1
    for (int l = 0; l < NL; ++l) {
        const bf16_t* wl = wt + (size_t)l * WLAYER;
        bf16_t* hb = cur ? hbuf[1] : hbuf[0]; bf16_t* hbn = cur ? hbuf[0] : hbuf[1];
        float* ss = cur ? ssbuf[1] : ssbuf[0]; float* ssn = cur ? ssbuf[0] : ssbuf[1];
        { S.init(T, NPROJ, G, bid); EpiIn E{proj, ss}; pg8::gemm_phase<EpiIn, pg8::StaticOrder>(lds, pg8::Gemm{hb, wl + WIN, T, NPROJ, D}, S, E, nullptr); }
        xcd_barrier(xb);
        SsdCtx C{proj, hb, ss, wl + WDT, P.conv_w + (size_t)l * 4 * 1024, P.conv_b + (size_t)l * 1024, P.dt_bias + l * 8, P.a_log + l * 8, P.d_skip + l * 8, P.norm_g + l * 512,
                 states, dtbuf, cdecay, mix, wl + WPOOL};
        for (int job = bid; job < 512 + 1024; job += G) {
            if (job < 512) ssd_s1_job(C, lds, job >> 8, (job >> 1) & 127, job & 1);
            else { const int j = job - 512; pool_job(C, lds, j >> 2, j & 3); }
        }
        xcd_barrier(xb);
        scan_phase(states, cdecay, G, bid);
        xcd_barrier(xb);
        for (int job = bid; job < 512; job += G) ssd_s3_job(C, lds, job >> 8, (job >> 1) & 127, job & 1);
        xcd_barrier(xb);
        { S.init(T, D, G, bid); EpiRes<false> E{l == 0 ? P.x : P.out, P.out, hb, ss, nullptr, nullptr}; pg8::gemm_phase<EpiRes<false>, pg8::StaticOrder>(lds, pg8::Gemm{mix, wl + WOUT, T, D, D}, S, E, nullptr); }
        xcd_barrier(xb);
        { UpOrder SU; SU.init(T, DUP, G, bid); SU.cw = P.fconv_w + (size_t)l * 3 * DUP; SU.cb = P.fconv_b + (size_t)l * DUP; SU.pbuf = (LAS float*)(lds + 131072); SU.na = 0;
          EpiUp E{act, ss, (const LAS float*)(lds + 131072), head, tail, 0}; pg8::gemm_phase<EpiUp, UpOrder>(lds, pg8::Gemm{hb, wl + WUP, T, DUP, D}, SU, E, nullptr); }
        xcd_barrier(xb);
        fixup_phase(P, l, act, head, tail, pb, G, bid);
        xcd_barrier(xb);
        { S.init(T, D, G, bid); EpiRes<false> E{P.out, P.out, hb, ss, nullptr, nullptr}; pg8::gemm_phase<EpiRes<false>, pg8::StaticOrder>(lds, pg8::Gemm{act, wl + WDOWN, T, D, DFF}, S, E, nullptr); }
        { S.init(T, D, G, bid); EpiQ E{qb}; pg8::gemm_phase<EpiQ, pg8::StaticOrder>(lds, pg8::Gemm{pb, wl + WPLE, T, D, DPLE}, S, E, nullptr); }
        xcd_barrier(xb);
        { S.init(T, D, G, bid); EpiRes<true> E{P.out, P.out, hbn, ssn, ss, qb}; pg8::gemm_phase<EpiRes<true>, pg8::StaticOrder>(lds, pg8::Gemm{hb, wl + WGATE, T, D, D}, S, E, nullptr); }
        xcd_barrier(xb);
        cur ^= 1;
    }
    {
        const int lane = threadIdx.x & 63, wave = threadIdx.x >> 6;
        const float* ss = cur ? ssbuf[1] : ssbuf[0];
        for (int row = bid * 8 + wave; row < T; row += G * 8) {
            const float rs = row_rstd(ss, row); f32x4* xr = (f32x4*)(P.out + (size_t)row * D) + lane; const f32x4* gr = (const f32x4*)P.final_g + lane;
#pragma unroll
            for (int j = 0; j < 4; ++j) { f32x4 v = xr[64 * j]; const f32x4 gg = gr[64 * j]; v = v * rs * gg; xr[64 * j] = v; }
        }
    }
}

extern "C" void kernel_launch(void* const* d_in, const int* in_sizes, int n_in, void* d_out, int out_size, void* d_ws, size_t ws_size, hipStream_t stream) {
    static int grid = 0;
    if (grid == 0) {
        if (n_in != 22 || ws_size < WS_END) { fprintf(stderr, "kernel_launch: unexpected inputs (n_in %d, ws %zu, need %zu)\n", n_in, ws_size, (size_t)WS_END); grid = -1; return; }
        int dev = 0, cus = 0, per_cu = 0;
        (void)hipGetDevice(&dev); (void)hipDeviceGetAttribute(&cus, hipDeviceAttributeMultiprocessorCount, dev);
        if (hipFuncSetAttribute((const void*)hymba_fwd, hipFuncAttributeMaxDynamicSharedMemorySize, LDS_BYTES) != hipSuccess) { fprintf(stderr, "kernel_launch: hipFuncSetAttribute failed\n"); grid = -1; return; }
        if (hipOccupancyMaxActiveBlocksPerMultiprocessor(&per_cu, (const void*)hymba_fwd, 512, LDS_BYTES) != hipSuccess || per_cu < 1) { fprintf(stderr, "kernel_launch: occupancy query says %d blocks per CU\n", per_cu); per_cu = 1; }
        (void)hipGetLastError();
        grid = cus;
    }
    if (grid < 0) return;
    Params p{};
    const float** pp = (const float**)&p;
    for (int i = 0; i < 22; ++i) pp[i] = (const float*)d_in[i];
    p.out = (float*)d_out; p.ws = (unsigned char*)d_ws;
    if (hipMemsetAsync((char*)d_ws + OFF_BAR, 0, 16384, stream) != hipSuccess) { fprintf(stderr, "kernel_launch: memset failed\n"); return; }
    void* args[] = {&p};
    hipError_t e = hipLaunchCooperativeKernel((const void*)hymba_fwd, dim3(grid), dim3(512), args, LDS_BYTES, stream);
    if (e != hipSuccess) fprintf(stderr, "cooperative launch failed: %s (grid %d)\n", hipGetErrorString(e), grid);
}
```

```cpp
#include <hip/hip_runtime.h>
#include <hip/hip_cooperative_groups.h>
#include <cstdio>
#include <cstdint>
namespace cg = cooperative_groups;
namespace pg8 {
#define PG8_LAS __attribute__((address_space(3)))
typedef unsigned short bf16_t;
typedef short bf16x8 __attribute__((ext_vector_type(8)));
typedef float f32x4 __attribute__((ext_vector_type(4)));
typedef unsigned u32x4 __attribute__((ext_vector_type(4)));
constexpr int BM = 256, BK = 64, HALF = 128, HTB = HALF * BK * 2  , STAGE_BYTES = 8 * HTB, NXCD = 8, WGM = 8;

__host__ __device__ __forceinline__ int lds_byte(int r, int c) { const int st = (r >> 4) * 2 + (c >> 5), rr = r & 15, cc = c & 31, ob = rr * 64 + cc * 2; return st * 1024 + (ob ^ (((ob >> 9) & 1) << 5)); }
__host__ __device__ __forceinline__ void stage_rc(int b, int& R, int& C) { const int st = b / 1024, sb = b % 1024, swz = sb ^ (((sb >> 9) & 1) << 5); R = (st >> 1) * 16 + swz / 64; C = (st & 1) * 32 + (swz % 64) / 2; }
__host__ __device__ __forceinline__ int perm32(int rho) { const int n = rho >> 4, i = rho & 15; return 8 * (i >> 2) + 4 * n + (i & 3); }

struct Unit { int pm, pn; };
struct Gemm { const bf16_t* A; const bf16_t* Bt; int M, N, K; };

struct StaticOrder {
    int nM, nN, nwg, G, c;
    __host__ __device__ void init(int M, int N, int G_, int c_) { nM = M / BM; nN = N / BM; nwg = nM * nN; G = G_; c = c_; }
    __host__ __device__ bool next(int i, Unit& u) const {
        const long L = (long)i * G + c; if (L >= nwg) return false;
        int wgid = (int)L; { const int q = nwg / NXCD, r = nwg % NXCD, xcd = wgid % NXCD, off = wgid / NXCD; wgid = (xcd < r ? xcd * (q + 1) : r * (q + 1) + (xcd - r) * q) + off; }
        const int nig = WGM * nN, gid = wgid / nig, fm = gid * WGM, gsz = (nM - fm) < WGM ? (nM - fm) : WGM;
        u.pm = fm + ((wgid % nig) % gsz); u.pn = (wgid % nig) / gsz; return true;
    }
    __device__ __forceinline__ void a_ready(const Unit&) const {}
    __device__ __forceinline__ void done(const Unit&) const {}
};
__device__ __forceinline__ unsigned cvt_pk_bf16(float lo, float hi) { unsigned r; asm volatile("v_cvt_pk_bf16_f32 %0, %1, %2" : "=v"(r) : "v"(lo), "v"(hi)); return r; }
template <class Epi, class Sched, bool STAMP = false>
__device__ __forceinline__ void gemm_phase(PG8_LAS unsigned char* lds, const Gemm g, const Sched& S, const Epi& E, unsigned long long* stamps) {
    int tid_ = threadIdx.x; asm volatile("" : "+v"(tid_));
    const int tid = tid_, wid = __builtin_amdgcn_readfirstlane(tid >> 6), lane = tid & 63, wr = wid >> 2, wc = wid & 3, fr = lane & 15, fq = lane >> 4;
    int K_ = g.K; asm volatile("" : "+s"(K_));
    const int K = K_, nt = K / BK;
    int ts_lo = 0, ts_hi = 0, nts = 0; const unsigned long long rt_entry = STAMP ? (unsigned long long)wall_clock64() : 0ull;
#define PG8_STAMP() do { if (STAMP && wid == 0 && nts < 64) { const unsigned long long _c = (unsigned long long)clock64(); \
        ts_lo = (lane == nts) ? (int)(unsigned)_c : ts_lo; ts_hi = (lane == nts) ? (int)(unsigned)(_c >> 32) : ts_hi; ++nts; } } while (0)
    PG8_STAMP();
    unsigned voffA[2], voffB[2];
#pragma unroll
    for (int i = 0; i < 2; ++i) { int R, C; stage_rc(tid * 16 + i * 8192, R, C); const int Rb = Epi::PERM ? ((R & ~31) + perm32(R & 31)) : R;
        voffA[i] = (unsigned)(R * K + C) * 2u; voffB[i] = (unsigned)(Rb * K + C) * 2u; }
    const size_t kstep = (size_t)(BK * 2);
    const size_t hstep = (size_t)HALF * K * 2;
    const size_t tstep = 2 * hstep;
    const unsigned ldsw = (unsigned)wid * 1024u;
    const int aoff = lds_byte(wr * 64 + fr, fq * 8), boff = lds_byte(wc * 32 + fr, fq * 8);
#define PG8_SA(b, h) (((b) * 2 + (h)) * HTB)
#define PG8_SB(b, h) ((4 + (b) * 2 + (h)) * HTB)
#define PG8_STAGE(bufoff, gbase, voff) do { _Pragma("unroll") for (int _i = 0; _i < 2; ++_i) \
        __builtin_amdgcn_global_load_lds((const unsigned*)((const char*)(gbase) + (voff)[_i]), (PG8_LAS unsigned*)(lds + (bufoff) + ldsw + _i * 8192), 16, 0, 0); } while (0)
#define PG8_LDA(dst, b, h) do { _Pragma("unroll") for (int m = 0; m < 4; ++m) _Pragma("unroll") for (int k = 0; k < 2; ++k) dst[m][k] = *(const PG8_LAS bf16x8*)(lds + PG8_SA(b, h) + aoff + m * 2048 + k * 1024); } while (0)
#define PG8_LDB(dst, b, h) do { _Pragma("unroll") for (int n = 0; n < 2; ++n) _Pragma("unroll") for (int k = 0; k < 2; ++k) dst[n][k] = *(const PG8_LAS bf16x8*)(lds + PG8_SB(b, h) + boff + n * 2048 + k * 1024); } while (0)
#define PG8_MMA(ai, bj, At, Bt) do { __builtin_amdgcn_s_setprio(1); _Pragma("unroll") for (int m = 0; m < 4; ++m) _Pragma("unroll") for (int n = 0; n < 2; ++n) _Pragma("unroll") for (int k = 0; k < 2; ++k) \
        acc[ai][bj][m][n] = __builtin_amdgcn_mfma_f32_16x16x32_bf16(Bt[n][k], At[m][k], acc[ai][bj][m][n], 0, 0, 0); __builtin_amdgcn_s_setprio(0); } while (0)
#define PG8_WAIT_V(n) asm volatile("s_waitcnt vmcnt(" #n ")" ::: "memory")
#define PG8_WAIT_L(n) asm volatile("s_waitcnt lgkmcnt(" #n ")" ::: "memory")
#define PG8_BAR __builtin_amdgcn_s_barrier()
#define PG8_SCHED __builtin_amdgcn_sched_barrier(0)
    Unit cur, nxt; int ui = 0;
    if (!S.next(0, cur)) return;
    f32x4 acc[2][2][4][2];
#pragma unroll
    for (int a = 0; a < 2; ++a)
#pragma unroll
        for (int b = 0; b < 2; ++b)
#pragma unroll
            for (int m = 0; m < 4; ++m)
#pragma unroll
                for (int n = 0; n < 2; ++n) acc[a][b][m][n] = (f32x4){0.f, 0.f, 0.f, 0.f};
    bf16x8 At[4][2], B0[2][2], B1[2][2];
    const char* cA = (const char*)g.A + (size_t)cur.pm * tstep; const char* cB = (const char*)g.Bt + (size_t)cur.pn * tstep;
    S.a_ready(cur);
    PG8_STAGE(PG8_SB(0, 0), cB, voffB); PG8_STAGE(PG8_SA(0, 0), cA, voffA); PG8_STAGE(PG8_SB(0, 1), cB + hstep, voffB); PG8_STAGE(PG8_SA(0, 1), cA + hstep, voffA);
    if (wr == 1) PG8_BAR;
    PG8_WAIT_V(4); PG8_BAR;
    PG8_STAGE(PG8_SB(1, 0), cB + kstep, voffB); PG8_STAGE(PG8_SA(1, 0), cA + kstep, voffA); PG8_STAGE(PG8_SB(1, 1), cB + hstep + kstep, voffB);
    PG8_WAIT_V(6); PG8_BAR;
    PG8_STAMP();
    for (;;) {
        const bool has_next = S.next(ui + 1, nxt);
        const char* nA = has_next ? (const char*)g.A + (size_t)nxt.pm * tstep : cA; const char* nB = has_next ? (const char*)g.Bt + (size_t)nxt.pn * tstep : cB;
        for (int t = 0; t < nt; t += 2) {
            const bool last = (t == nt - 2);
            const char* a1 = cA + (size_t)(t + 1) * kstep;
            const char* a2 = last ? nA : cA + (size_t)(t + 2) * kstep; const char* b2 = last ? nB : cB + (size_t)(t + 2) * kstep;
            const char* a3 = a2 + kstep; const char* b3 = b2 + kstep;
            if (last && has_next) S.a_ready(nxt);
            PG8_LDB(B0, 0, 0); PG8_SCHED; PG8_LDA(At, 0, 0); PG8_STAGE(PG8_SA(1, 1), a1 + hstep, voffA);
            PG8_WAIT_L(8); PG8_BAR; PG8_WAIT_L(0); PG8_MMA(0, 0, At, B0); PG8_BAR; PG8_SCHED;
            PG8_LDB(B1, 0, 1); PG8_STAGE(PG8_SB(0, 0), b2, voffB);
            PG8_BAR; PG8_WAIT_L(0); PG8_MMA(0, 1, At, B1); PG8_BAR;
            PG8_LDA(At, 0, 1); PG8_STAGE(PG8_SA(0, 0), a2, voffA);
            PG8_BAR; PG8_WAIT_L(0); PG8_MMA(1, 0, At, B0); PG8_BAR; PG8_SCHED;
            PG8_STAGE(PG8_SB(0, 1), b2 + hstep, voffB);
            PG8_WAIT_V(6); PG8_BAR; PG8_MMA(1, 1, At, B1); PG8_BAR;
            PG8_LDB(B0, 1, 0); PG8_SCHED; PG8_LDA(At, 1, 0); PG8_STAGE(PG8_SA(0, 1), a2 + hstep, voffA);
            PG8_WAIT_L(8); PG8_BAR; PG8_WAIT_L(0); PG8_MMA(0, 0, At, B0); PG8_BAR; PG8_SCHED;
            PG8_LDB(B1, 1, 1); PG8_STAGE(PG8_SB(1, 0), b3, voffB);
            PG8_BAR; PG8_WAIT_L(0); PG8_MMA(0, 1, At, B1); PG8_BAR;
            PG8_LDA(At, 1, 1); PG8_STAGE(PG8_SA(1, 0), a3, voffA);
            PG8_BAR; PG8_WAIT_L(0); PG8_MMA(1, 0, At, B0); PG8_BAR; PG8_SCHED;
            PG8_STAGE(PG8_SB(1, 1), b3 + hstep, voffB);
            PG8_WAIT_V(6); PG8_BAR; PG8_MMA(1, 1, At, B1); PG8_BAR;
        }
        PG8_STAMP();
        if constexpr (!Epi::AFTER_DRAIN) { E(acc, cur, wr, wc, fr, fq); S.done(cur); }
        PG8_STAMP();
        if (!has_next) break;
#pragma unroll
        for (int a = 0; a < 2; ++a)
#pragma unroll
            for (int b = 0; b < 2; ++b)
#pragma unroll
                for (int m = 0; m < 4; ++m)
#pragma unroll
                    for (int n = 0; n < 2; ++n) acc[a][b][m][n] = (f32x4){0.f, 0.f, 0.f, 0.f};
        cur = nxt; cA = nA; cB = nB; ++ui;
    }
    PG8_WAIT_V(0);
    if (wr == 0) PG8_BAR;
    PG8_BAR;
    if constexpr (Epi::AFTER_DRAIN) { E.fused(acc, cur, wr, wc, fr, fq, lds, wid, lane); S.done(cur); }
    PG8_STAMP();
    if (STAMP && wid == 0) { stamps[lane] = lane < nts ? (((unsigned long long)(unsigned)ts_hi << 32) | (unsigned)ts_lo) : 0ull;
        if (lane == 62) stamps[62] = rt_entry; if (lane == 63) stamps[63] = (unsigned long long)wall_clock64(); }
#undef PG8_STAMP
#undef PG8_SA
#undef PG8_SB
#undef PG8_STAGE
#undef PG8_LDA
#undef PG8_LDB
#undef PG8_MMA
#undef PG8_WAIT_V
#undef PG8_WAIT_L
#undef PG8_BAR
#undef PG8_SCHED
}
}
#define LAS __attribute__((address_space(3)))
typedef pg8::bf16_t bf16_t; typedef pg8::bf16x8 bf16x8; typedef pg8::f32x4 f32x4; typedef pg8::u32x4 u32x4;
typedef float f32x16 __attribute__((ext_vector_type(16)));
typedef unsigned u32x2 __attribute__((ext_vector_type(2)));
typedef float f32x2 __attribute__((ext_vector_type(2)));
using pg8::cvt_pk_bf16;

constexpr int T = 32768, D = 1024, SEQ = 16384, NL = 4, NPROJ = 2048, DFF = 2816, DUP = 5632, DPLE = 256;
constexpr float EPS = 1e-6f;
constexpr size_t WIN = 0, WDT = WIN + (size_t)2048 * 1024, WOUT = WDT + (size_t)16 * 1024, WUP = WOUT + (size_t)1024 * 1024, WDOWN = WUP + (size_t)5632 * 1024,
                 WGATE = WDOWN + (size_t)1024 * 2816, WPLE = WGATE + (size_t)1024 * 1024, WPOOL = WPLE + (size_t)1024 * 256, WLAYER = WPOOL + (size_t)4 * 128 * 128;
constexpr size_t OFF_HB0 = 0, OFF_HB1 = OFF_HB0 + (size_t)T * D * 2, OFF_WT = OFF_HB1 + (size_t)T * D * 2, OFF_R = OFF_WT + WLAYER * 2 * NL,
                 OFF_ST = OFF_R + (size_t)T * NPROJ * 2, OFF_MIX = OFF_R + (size_t)T * DFF * 2, OFF_TAIL = OFF_MIX + (size_t)512 * 2 * DUP * 4,
                 OFF_PB = OFF_MIX + (size_t)T * D * 2, OFF_SS = OFF_PB + (size_t)T * DPLE * 2, OFF_DT = OFF_SS + (size_t)2 * T * 16 * 4,
                 OFF_CD = OFF_DT + (size_t)T * 8 * 4, OFF_BAR = OFF_CD + 8192, WS_END = OFF_BAR + 16384;
static_assert(OFF_ST + (size_t)2 * 128 * 8 * 64 * 128 * 2 <= OFF_MIX, "states must fit behind proj");
static_assert(WS_END <= (size_t)512 * 1024 * 1024, "workspace");
constexpr int LDS_BYTES = 147456;
constexpr int PIT = 136;

struct Params {
    const float *x, *p, *mix_g, *w_in, *conv_w, *conv_b, *dt_bias, *a_log, *d_skip, *norm_g, *pool_w, *pool_scale, *w_out, *ffn_g, *w_up, *fconv_w, *fconv_b, *w_down,
        *ple_g, *w_gate, *w_ple, *final_g;
    float* out; unsigned char* ws;
};

__device__ __forceinline__ float bf_lo(unsigned u) { return __uint_as_float(u << 16); }
__device__ __forceinline__ float bf_hi(unsigned u) { return __uint_as_float(u & 0xffff0000u); }
__device__ __forceinline__ float bf2f(bf16_t b) { return __uint_as_float(((unsigned)b) << 16); }
__device__ __forceinline__ bf16_t f2bf(float f) { return (bf16_t)(cvt_pk_bf16(f, 0.f) & 0xffffu); }
__device__ __forceinline__ float fast_sigmoid(float v) { return __builtin_amdgcn_rcpf(1.f + __builtin_amdgcn_exp2f(-1.4426950409f * v)); }
__device__ __forceinline__ float silu_f(float v) { return v * fast_sigmoid(v); }
__device__ __forceinline__ float gelu_tanh(float v) { const float t = v * (1.f + 0.044715f * v * v); return v * __builtin_amdgcn_rcpf(1.f + __builtin_amdgcn_exp2f(-2.302208198f * t)); }
__device__ __forceinline__ float softplus_f(float v) { return v > 20.f ? v : log1pf(__expf(v)); }
__device__ __forceinline__ float wave_sum(float v) {
#pragma unroll
    for (int o = 1; o < 64; o <<= 1) v += __shfl_xor(v, o);
    return v;
}
template <int CTRL> __device__ __forceinline__ float dppf(float v) { return __builtin_bit_cast(float, __builtin_amdgcn_update_dpp(0, __builtin_bit_cast(int, v), CTRL, 0xf, 0xf, true)); }
__device__ __forceinline__ float row_rstd(const float* ss, int row) {
    const f32x4* p = (const f32x4*)(ss + (size_t)row * 16);
    const f32x4 a = p[0], b = p[1], c = p[2], d = p[3];
    const float s = ((a.x + a.y) + (a.z + a.w)) + ((b.x + b.y) + (b.z + b.w)) + ((c.x + c.y) + (c.z + c.w)) + ((d.x + d.y) + (d.z + d.w));
    return rsqrtf(s * (1.f / 1024.f) + EPS);
}
__device__ __forceinline__ float row_rstd_coop(const float* ss, int row, int fq) {
    const f32x4 a = *(const f32x4*)(ss + (size_t)row * 16 + 4 * fq);
    float s = (a.x + a.y) + (a.z + a.w);
    s += __shfl_xor(s, 16); s += __shfl_xor(s, 32);
    return rsqrtf(s * (1.f / 1024.f) + EPS);
}
__device__ __forceinline__ void rstd8(const float* ss, int rbase, int fq, float (&rs)[2][4]) {
    f32x4 a[2][4];
#pragma unroll
    for (int ai = 0; ai < 2; ++ai)
#pragma unroll
        for (int m = 0; m < 4; ++m) a[ai][m] = *(const f32x4*)(ss + (size_t)(rbase + ai * 128 + m * 16) * 16 + 4 * fq);
#pragma unroll
    for (int ai = 0; ai < 2; ++ai)
#pragma unroll
        for (int m = 0; m < 4; ++m) { float s = (a[ai][m].x + a[ai][m].y) + (a[ai][m].z + a[ai][m].w); s += __shfl_xor(s, 16); s += __shfl_xor(s, 32); rs[ai][m] = rsqrtf(s * (1.f / 1024.f) + EPS); }
}
#define LDS_FENCE() asm volatile("s_waitcnt lgkmcnt(0)" ::: "memory")

struct EpiIn {
    static constexpr bool PERM = true, AFTER_DRAIN = false;
    bf16_t* O; const float* ss;
    __device__ __forceinline__ void operator()(const f32x4 (&acc)[2][2][4][2], const pg8::Unit& u, int wr, int wc, int fr, int fq) const {
        const int col0 = u.pn * 256 + wc * 32 + 8 * fq, rbase = u.pm * 256 + wr * 64 + fr;
        float rs[2][4]; rstd8(ss, rbase, fq, rs);
#pragma unroll
        for (int ai = 0; ai < 2; ++ai)
#pragma unroll
            for (int m = 0; m < 4; ++m) {
                const int row = rbase + ai * 128 + m * 16; const float r1 = rs[ai][m];
                bf16_t* rowp = O + (size_t)row * NPROJ + col0;
#pragma unroll
                for (int bj = 0; bj < 2; ++bj) { const f32x4 v0 = acc[ai][bj][m][0] * r1, v1 = acc[ai][bj][m][1] * r1;
                    u32x4 w; w.x = cvt_pk_bf16(v0[0], v0[1]); w.y = cvt_pk_bf16(v0[2], v0[3]); w.z = cvt_pk_bf16(v1[0], v1[1]); w.w = cvt_pk_bf16(v1[2], v1[3]);
                    *(u32x4*)(rowp + bj * 128) = w; } }
    }
};
struct EpiQ {
    static constexpr bool PERM = true, AFTER_DRAIN = false;
    bf16_t* O;
    __device__ __forceinline__ void operator()(const f32x4 (&acc)[2][2][4][2], const pg8::Unit& u, int wr, int wc, int fr, int fq) const {
        const int col0 = u.pn * 256 + wc * 32 + 8 * fq;
#pragma unroll
        for (int ai = 0; ai < 2; ++ai)
#pragma unroll
            for (int m = 0; m < 4; ++m) {
                const int row = u.pm * 256 + ai * 128 + wr * 64 + m * 16 + fr; bf16_t* rowp = O + (size_t)row * D + col0;
#pragma unroll
                for (int bj = 0; bj < 2; ++bj) { const f32x4 v0 = acc[ai][bj][m][0], v1 = acc[ai][bj][m][1];
                    u32x4 w; w.x = cvt_pk_bf16(v0[0], v0[1]); w.y = cvt_pk_bf16(v0[2], v0[3]); w.z = cvt_pk_bf16(v1[0], v1[1]); w.w = cvt_pk_bf16(v1[2], v1[3]);
                    *(u32x4*)(rowp + bj * 128) = w; } }
    }
};
template <bool GATE> struct EpiRes {
    static constexpr bool PERM = false, AFTER_DRAIN = false;
    const bf16_t* rin; bf16_t* hb; float* ssw; const float* ssr; const bf16_t* q;
    __device__ __forceinline__ void operator()(const f32x4 (&acc)[2][2][4][2], const pg8::Unit& u, int wr, int wc, int fr, int fq) const {
        constexpr int MB = GATE ? 2 : 4;
        const int col0 = u.pn * 256 + wc * 32 + 4 * fq, rbase = u.pm * 256 + wr * 64 + fr;
        float rs[2][4];
        if (GATE) rstd8(ssr, rbase, fq, rs);
#pragma unroll
        for (int ai = 0; ai < 2; ++ai)
#pragma unroll
            for (int mb = 0; mb < 4; mb += MB) {
                u32x2 hv[MB][4], qv[MB][4];
#pragma unroll
                for (int mm = 0; mm < MB; ++mm)
#pragma unroll
                    for (int c = 0; c < 4; ++c) { const size_t off = (size_t)(rbase + ai * 128 + (mb + mm) * 16) * D + col0 + (c >> 1) * 128 + (c & 1) * 16;
                        hv[mm][c] = *(const u32x2*)(rin + off); if (GATE) qv[mm][c] = *(const u32x2*)(q + off); }
#pragma unroll
                for (int mm = 0; mm < MB; ++mm) { const int m = mb + mm, row = rbase + ai * 128 + m * 16; float sq = 0.f;
#pragma unroll
                    for (int c = 0; c < 4; ++c) { const size_t off = (size_t)row * D + col0 + (c >> 1) * 128 + (c & 1) * 16;
                        const u32x2 hh = hv[mm][c]; f32x4 v = {bf_lo(hh.x), bf_hi(hh.x), bf_lo(hh.y), bf_hi(hh.y)}; const f32x4 a = acc[ai][c >> 1][m][c & 1];
                        if (GATE) { const float r1 = rs[ai][m]; const u32x2 qq = qv[mm][c];
                            v[0] += bf_lo(qq.x) * fast_sigmoid(a[0] * r1); v[1] += bf_hi(qq.x) * fast_sigmoid(a[1] * r1);
                            v[2] += bf_lo(qq.y) * fast_sigmoid(a[2] * r1); v[3] += bf_hi(qq.y) * fast_sigmoid(a[3] * r1); }
                        else v += a;
                        u32x2 w; w.x = cvt_pk_bf16(v[0], v[1]); w.y = cvt_pk_bf16(v[2], v[3]); *(u32x2*)(hb + off) = w;
                        const float r0 = bf_lo(w.x), r1v = bf_hi(w.x), r2 = bf_lo(w.y), r3 = bf_hi(w.y);
                        sq += (r0 * r0 + r1v * r1v) + (r2 * r2 + r3 * r3); }
                    sq += __shfl_xor(sq, 16); sq += __shfl_xor(sq, 32);
                    if (fq == 0) ssw[(size_t)row * 16 + u.pn * 4 + wc] = sq; } }
    }
};
struct UpOrder : pg8::StaticOrder {
    const float* cw; const float* cb; LAS float* pbuf; mutable int na;
    __device__ __forceinline__ void a_ready(const pg8::Unit& u) const {
        const int t = threadIdx.x, qd = t >> 6, c = 2 * (t & 63);
        const float* src = ((qd & 3) == 3 ? cb : cw + (size_t)(qd & 3) * DUP) + (qd >> 2) * DFF + u.pn * 128 + c;
        const f32x2 v = *(const f32x2*)src;
        *(LAS f32x2*)(pbuf + (na & 1) * 1024 + qd * 128 + c) = v;
        ++na;
    }
};
struct EpiUp {
    static constexpr bool PERM = true, AFTER_DRAIN = false;
    bf16_t* act; const float* ss; const LAS float* pbuf; float* head; float* tail; mutable int ne;
    __device__ __forceinline__ void operator()(const f32x4 (&acc)[2][2][4][2], const pg8::Unit& u, int wr, int wc, int fr, int fq) const {
        const LAS float* pp = pbuf + (ne & 1) * 1024 + wc * 32 + 8 * fq; ++ne;
        const int jg0 = u.pn * 128 + wc * 32 + 8 * fq, rb0 = u.pm * 256 + wr * 64 + fr;
        float rs[2][4]; rstd8(ss, rb0, fq, rs);
#pragma unroll
        for (int ai = 0; ai < 2; ++ai) {
            const int rbase = rb0 + ai * 128, strip = u.pm * 4 + ai * 2 + wr;
            unsigned ow[4][4];
#pragma unroll
            for (int nj = 0; nj < 4; ++nj) {
                const int n = nj >> 1, j0 = 2 * (nj & 1), cl = 4 * n + j0, jg = jg0 + cl;
                const f32x2 w0g = *(const LAS f32x2*)(pp + cl), w1g = *(const LAS f32x2*)(pp + 128 + cl), w2g = *(const LAS f32x2*)(pp + 256 + cl), bg = *(const LAS f32x2*)(pp + 384 + cl);
                const f32x2 w0v = *(const LAS f32x2*)(pp + 512 + cl), w1v = *(const LAS f32x2*)(pp + 640 + cl), w2v = *(const LAS f32x2*)(pp + 768 + cl), bv = *(const LAS f32x2*)(pp + 896 + cl);
                f32x2 pg = {0.f, 0.f}, pv = {0.f, 0.f};
#pragma unroll
                for (int m = 0; m < 4; ++m) {
                    const float r1 = rs[ai][m];
                    const f32x2 xg = {acc[ai][0][m][n][j0] * r1, acc[ai][0][m][n][j0 + 1] * r1}, xv = {acc[ai][1][m][n][j0] * r1, acc[ai][1][m][n][j0 + 1] * r1};
                    if (m == 0 && fr < 2) { float* hp = head + ((size_t)(strip * 2 + fr)) * DUP + jg; *(f32x2*)hp = xg; *(f32x2*)(hp + DFF) = xv; }
                    if (m == 3 && fr >= 14) { float* tp = tail + ((size_t)(strip * 2 + fr - 14)) * DUP + jg; *(f32x2*)tp = xg; *(f32x2*)(tp + DFF) = xv; }
                    float o[2];
#pragma unroll
                    for (int j = 0; j < 2; ++j) {
                        const float g1 = dppf<0x111>(xg[j]) + dppf<0x10F>(pg[j]), g2 = dppf<0x112>(xg[j]) + dppf<0x10E>(pg[j]);
                        const float v1 = dppf<0x111>(xv[j]) + dppf<0x10F>(pv[j]), v2 = dppf<0x112>(xv[j]) + dppf<0x10E>(pv[j]);
                        const float cgv = bg[j] + w0g[j] * g2 + w1g[j] * g1 + w2g[j] * xg[j];
                        const float cvv = bv[j] + w0v[j] * v2 + w1v[j] * v1 + w2v[j] * xv[j];
                        o[j] = gelu_tanh(cgv) * cvv; }
                    ow[m][nj] = cvt_pk_bf16(o[0], o[1]);
                    pg = xg; pv = xv; } }
#pragma unroll
            for (int m = 0; m < 4; ++m)
                if (!(m == 0 && fr < 2)) { u32x4 w; w.x = ow[m][0]; w.y = ow[m][1]; w.z = ow[m][2]; w.w = ow[m][3]; *(u32x4*)(act + (size_t)(rbase + 16 * m) * DFF + jg0) = w; } }
    }
};
__device__ __forceinline__ void tr_item(const float* W, int ldw, bf16_t* WT, int Kd, int k0, int n0, int sc0, const float* kscale, const float* nscale, LAS float* scr, int lane) {
#pragma unroll 8
    for (int i = 0; i < 32; ++i) { const int kk = 2 * i + (lane >> 5); float v = W[(size_t)(k0 + kk) * ldw + sc0 + (lane & 31)]; if (kscale) v *= kscale[k0 + kk]; scr[kk * 33 + (lane & 31)] = v; }
    LDS_FENCE();
    const int c = lane & 7;
#pragma unroll
    for (int j = 0; j < 4; ++j) { const int n = (lane >> 3) + 8 * j; const LAS float* s = scr + (8 * c) * 33 + n; const float ns = nscale ? nscale[sc0 + n] : 1.f;
        u32x4 o; o.x = cvt_pk_bf16(s[0] * ns, s[33] * ns); o.y = cvt_pk_bf16(s[2 * 33] * ns, s[3 * 33] * ns); o.z = cvt_pk_bf16(s[4 * 33] * ns, s[5 * 33] * ns); o.w = cvt_pk_bf16(s[6 * 33] * ns, s[7 * 33] * ns);
        *(u32x4*)(WT + (size_t)(n0 + n) * Kd + k0 + 8 * c) = o; }
    LDS_FENCE();
}
__device__ __forceinline__ void phase0(const Params& P, LAS unsigned char* lds, int G, int bid) {
    int tid_ = threadIdx.x; asm volatile("" : "+v"(tid_)); const int tid = tid_, lane = tid & 63, wave = tid >> 6;
    bf16_t* wt = (bf16_t*)(P.ws + OFF_WT);
    LAS float* scr = (LAS float*)(lds + wave * 8704);
    const int gw = bid * 8 + wave, NGW = G * 8;
    constexpr int IPL = 1024 + 512 + 2816 + 1408 + 512 + 128 + 32;
    for (int it = gw; it < NL * IPL; it += NGW) {
        const int l = it / IPL; int r = it % IPL;
        bf16_t* wl = wt + (size_t)l * WLAYER;
        const float* W; int ldw, Kd, kb, nb, sc0; bf16_t* WT; const float* ks = nullptr; const float* ns = nullptr;
        if (r < 1024) { W = P.w_in + (size_t)l * 1024 * 2056; ldw = 2056; Kd = 1024; WT = wl + WIN; ks = P.mix_g + l * 1024; kb = r / 64; nb = r % 64; sc0 = 32 * nb < 1536 ? 32 * nb : 32 * nb + 8; }
        else if ((r -= 1024) < 512) { W = P.w_out + (size_t)l * 1024 * 1024; ldw = 1024; Kd = 1024; WT = wl + WOUT; kb = r / 32; nb = r % 32; sc0 = 32 * nb; }
        else if ((r -= 512) < 2816) { W = P.w_up + (size_t)l * 1024 * DUP; ldw = DUP; Kd = 1024; WT = wl + WUP; ks = P.ffn_g + l * 1024; kb = r / 176; nb = r % 176;
            const int n0 = 32 * nb, pn = n0 >> 8, rr = n0 & 255; sc0 = rr < 128 ? 128 * pn + rr : DFF + 128 * pn + (rr - 128); }
        else if ((r -= 2816) < 1408) { W = P.w_down + (size_t)l * DFF * 1024; ldw = 1024; Kd = DFF; WT = wl + WDOWN; kb = r / 32; nb = r % 32; sc0 = 32 * nb; }
        else if ((r -= 1408) < 512) { W = P.w_gate + (size_t)l * 1024 * 1024; ldw = 1024; Kd = 1024; WT = wl + WGATE; ks = P.ple_g + l * 1024; kb = r / 32; nb = r % 32; sc0 = 32 * nb; }
        else if ((r -= 512) < 128) { W = P.w_ple + (size_t)l * DPLE * 1024; ldw = 1024; Kd = DPLE; WT = wl + WPLE; kb = r / 32; nb = r % 32; sc0 = 32 * nb; }
        else { r -= 128; const int gi = r >> 3, rr = r & 7; kb = rr >> 2; nb = rr & 3; W = P.pool_w + (size_t)(l * 4 + gi) * 128 * 128; ldw = 128; Kd = 128; WT = wl + WPOOL + gi * 128 * 128;
            ns = P.pool_scale + l * 512 + gi * 128; sc0 = 32 * nb; }
        tr_item(W, ldw, WT, Kd, 64 * kb, 32 * nb, sc0, ks, ns, scr, lane);
    }
    for (int idx = bid * 512 + tid; idx < NL * 16 * 1024; idx += G * 512) {
        const int l = idx >> 14, j = (idx >> 10) & 15, k = idx & 1023;
        const float v = j < 8 ? P.w_in[(size_t)l * 1024 * 2056 + (size_t)k * 2056 + 1536 + j] * P.mix_g[l * 1024 + k] : 0.f;
        wt[(size_t)l * WLAYER + WDT + j * 1024 + k] = f2bf(v);
    }
    bf16_t* hb0 = (bf16_t*)(P.ws + OFF_HB0); float* ss0 = (float*)(P.ws + OFF_SS);
    for (int row = gw; row < T; row += NGW) {
        const f32x4* xr = (const f32x4*)(P.x + (size_t)row * D) + lane; float s = 0.f;
#pragma unroll
        for (int j = 0; j < 4; ++j) { const f32x4 v = xr[64 * j]; s += (v.x * v.x + v.y * v.y) + (v.z * v.z + v.w * v.w);
            u32x2 w; w.x = cvt_pk_bf16(v.x, v.y); w.y = cvt_pk_bf16(v.z, v.w); *(u32x2*)(hb0 + (size_t)row * D + 4 * lane + 256 * j) = w; }
        s = wave_sum(s);
        if (lane < 16) ss0[(size_t)row * 16 + lane] = lane == 0 ? s : 0.f;
    }
}

#define MFMA32(a, b, c) __builtin_amdgcn_mfma_f32_32x32x16_bf16((a), (b), (c), 0, 0, 0)
__device__ __forceinline__ void conv8x2(const bf16_t* proj, long row0, int tl0, bool seqstart, int pcol, const float* cw, const float* cb, int xch, float (&o0)[8], float (&o1)[8]) {
    unsigned v[11];
#pragma unroll
    for (int i = 0; i < 11; ++i) { const int tl = tl0 - 3 + i; v[i] = (tl >= 0 || !seqstart) ? *(const unsigned*)(proj + (size_t)(row0 + tl) * NPROJ + pcol) : 0u; }
    const f32x2 w0 = *(const f32x2*)(cw + xch), w1 = *(const f32x2*)(cw + 1024 + xch), w2 = *(const f32x2*)(cw + 2048 + xch), w3 = *(const f32x2*)(cw + 3072 + xch), bb = *(const f32x2*)(cb + xch);
#pragma unroll
    for (int i = 0; i < 8; ++i) {
        const float a = bb.x + w0.x * bf_lo(v[i]) + w1.x * bf_lo(v[i + 1]) + w2.x * bf_lo(v[i + 2]) + w3.x * bf_lo(v[i + 3]);
        const float b = bb.y + w0.y * bf_hi(v[i]) + w1.y * bf_hi(v[i + 1]) + w2.y * bf_hi(v[i + 2]) + w3.y * bf_hi(v[i + 3]);
        o0[i] = silu_f(a); o1[i] = silu_f(b); }
}
__device__ __forceinline__ float chunk_cumsum(LAS float* dtT, LAS float* acs, int wave, int lane, float Ah) {
    float last = 0.f;
    if (wave < 4) {
        const float a0 = dtT[wave * 128 + 2 * lane] * Ah, a1 = dtT[wave * 128 + 2 * lane + 1] * Ah; float v = a0 + a1;
#pragma unroll
        for (int o = 1; o < 64; o <<= 1) { const float t = __shfl_up(v, o); if (lane >= o) v += t; }
        acs[wave * 128 + 2 * lane] = v - a1; acs[wave * 128 + 2 * lane + 1] = v;
        last = __shfl(v, 63);
    }
    return last;
}
struct SsdCtx { const bf16_t* proj; const bf16_t* hb; const float* ss; const bf16_t* wdt; const float* cw; const float* cb; const float* dt_bias; const float* a_log; const float* d_skip; const float* norm_g;
                bf16_t* states; float* dtbuf; float* cdecay; bf16_t* mix; const bf16_t* pwt; };

__device__ __forceinline__ void ssd_s1_job(const SsdCtx& C, LAS unsigned char* lds, int b, int c, int g) {
    int tid_ = threadIdx.x; asm volatile("" : "+v"(tid_)); const int tid = tid_, lane = tid & 63, wave = tid >> 6;
    LAS bf16_t* XdT = (LAS bf16_t*)lds; LAS bf16_t* BT = (LAS bf16_t*)(lds + 256 * PIT * 2);
    LAS float* dtT = (LAS float*)(lds + 139264); LAS float* acs = dtT + 512;
    const long row0 = (long)b * SEQ + c * 128;
    {
        pg8::f32x4 acc = {0.f, 0.f, 0.f, 0.f};
        const bf16_t* ar = C.hb + (size_t)(row0 + 16 * wave + (lane & 15)) * D + 8 * (lane >> 4);
        const bf16_t* br = C.wdt + (size_t)(lane & 15) * D + 8 * (lane >> 4);
#pragma unroll 1
        for (int kb = 0; kb < 4; ++kb) {
            bf16x8 a[8], bb[8];
#pragma unroll
            for (int i = 0; i < 8; ++i) { a[i] = __builtin_nontemporal_load((const bf16x8*)(ar + 256 * kb + 32 * i)); bb[i] = *(const bf16x8*)(br + 256 * kb + 32 * i); }
#pragma unroll
            for (int i = 0; i < 8; ++i) acc = __builtin_amdgcn_mfma_f32_16x16x32_bf16(a[i], bb[i], acc, 0, 0, 0);
        }
        const int head = lane & 15;
        if (head >= 4 * g && head < 4 * g + 4) {
            const float bias = C.dt_bias[head];
#pragma unroll
            for (int rg = 0; rg < 4; ++rg) { const int tok = 16 * wave + 4 * (lane >> 4) + rg; const float rs = row_rstd(C.ss, (int)(row0 + tok));
                const float dt = softplus_f(acc[rg] * rs + bias); dtT[(head - 4 * g) * 128 + tok] = dt; C.dtbuf[(size_t)(row0 + tok) * 8 + head] = dt; } }
    }
    __syncthreads();
    {
        const float Ah = wave < 4 ? -__expf(C.a_log[4 * g + wave]) : 0.f;
        const float last = chunk_cumsum(dtT, acs, wave, lane, Ah);
        if (wave < 4 && lane == 0) C.cdecay[(size_t)(b * 128 + c) * 8 + 4 * g + wave] = __expf(last);
    }
    __syncthreads();
    for (int idx = tid; idx < 192 * 16; idx += 512) {
        const int cp = idx % 192, r = idx / 192; const bool isx = cp < 128;
        const int xch = isx ? g * 256 + 2 * cp : 512 + g * 128 + 2 * (cp - 128);
        float o0[8], o1[8];
        conv8x2(C.proj, row0, 8 * r, c == 0, 512 + xch, C.cw, C.cb, xch, o0, o1);
        if (isx) { const int hh = cp >> 5; const float al = acs[hh * 128 + 127];
#pragma unroll
            for (int i = 0; i < 8; ++i) { const float sc = dtT[hh * 128 + 8 * r + i] * __expf(al - acs[hh * 128 + 8 * r + i]); o0[i] *= sc; o1[i] *= sc; } }
        LAS bf16_t* dst = isx ? XdT + (2 * cp) * PIT + 8 * r : BT + (2 * (cp - 128)) * PIT + 8 * r;
        u32x4 w0, w1; w0.x = cvt_pk_bf16(o0[0], o0[1]); w0.y = cvt_pk_bf16(o0[2], o0[3]); w0.z = cvt_pk_bf16(o0[4], o0[5]); w0.w = cvt_pk_bf16(o0[6], o0[7]);
        w1.x = cvt_pk_bf16(o1[0], o1[1]); w1.y = cvt_pk_bf16(o1[2], o1[3]); w1.z = cvt_pk_bf16(o1[4], o1[5]); w1.w = cvt_pk_bf16(o1[6], o1[7]);
        *(LAS u32x4*)dst = w0; *(LAS u32x4*)(dst + PIT) = w1;
    }
    __syncthreads();
    {
        const int hh = wave >> 1, nh = wave & 1, r = lane & 31, hq = lane >> 5;
        f32x16 acc[2][2];
#pragma unroll
        for (int i = 0; i < 2; ++i)
#pragma unroll
            for (int j = 0; j < 2; ++j)
#pragma unroll
                for (int e = 0; e < 16; ++e) acc[i][j][e] = 0.f;
#pragma unroll 2
        for (int ks = 0; ks < 8; ++ks) {
            bf16x8 a[2], bb[2];
#pragma unroll
            for (int i = 0; i < 2; ++i) { a[i] = *(const LAS bf16x8*)(XdT + (64 * hh + 32 * i + r) * PIT + 16 * ks + 8 * hq); bb[i] = *(const LAS bf16x8*)(BT + (64 * nh + 32 * i + r) * PIT + 16 * ks + 8 * hq); }
#pragma unroll
            for (int i = 0; i < 2; ++i)
#pragma unroll
                for (int j = 0; j < 2; ++j) acc[i][j] = MFMA32(a[i], bb[j], acc[i][j]);
        }
        bf16_t* st = C.states + ((size_t)(b * 128 + c) * 8 + 4 * g + hh) * 64 * 128;
#pragma unroll
        for (int i = 0; i < 2; ++i)
#pragma unroll
            for (int j = 0; j < 2; ++j)
#pragma unroll
                for (int e = 0; e < 16; ++e) { const int p = 32 * i + (e & 3) + 8 * (e >> 2) + 4 * hq, n = 64 * nh + 32 * j + r; st[p * 128 + n] = f2bf(acc[i][j][e]); }
    }
    __syncthreads();
}

template <int W> __device__ __forceinline__ void pool_fill(const bf16_t* proj, long row0, bool seqstart, int gi, LAS bf16_t* Pl, int tid) {
    const int cp = tid & 63, run = tid >> 6, pcol = 1536 + gi * 128 + 2 * cp;
    float u0[31], u1[31];
#pragma unroll
    for (int i = 0; i < 31; ++i) { const int tl = 16 * run - 15 + i; const unsigned v = (tl >= 0 || !seqstart) ? *(const unsigned*)(proj + (size_t)(row0 + tl) * NPROJ + pcol) : 0u; u0[i] = bf_lo(v); u1[i] = bf_hi(v); }
    float s0 = 0.f, s1 = 0.f;
#pragma unroll
    for (int j = 1; j < W; ++j) { s0 += u0[15 - j]; s1 += u1[15 - j]; }
#pragma unroll
    for (int i = 0; i < 16; ++i) {
        s0 += u0[15 + i]; s1 += u1[15 + i];
        const int tl = 16 * run + i; const float dv = seqstart ? (float)(tl + 1 < W ? tl + 1 : W) : (float)W; const float inv = 1.f / dv;
        *(LAS unsigned*)(Pl + tl * PIT + 2 * cp) = cvt_pk_bf16(s0 * inv - u0[15 + i], s1 * inv - u1[15 + i]);
        s0 -= u0[15 + i - (W - 1)]; s1 -= u1[15 + i - (W - 1)];
    }
}
__device__ __forceinline__ void pool_job(const SsdCtx& C, LAS unsigned char* lds, int tb, int gi) {
    int tid_ = threadIdx.x; asm volatile("" : "+v"(tid_)); const int tid = tid_, lane = tid & 63, wave = tid >> 6;
    LAS bf16_t* Pl = (LAS bf16_t*)lds; LAS bf16_t* Wp = (LAS bf16_t*)(lds + 128 * PIT * 2);
    const long row0 = (long)tb * 128; const bool seqstart = (tb & 127) == 0;
    for (int i = tid; i < 2048; i += 512) { const int d = i >> 4, c8 = i & 15; *(LAS u32x4*)(Wp + d * PIT + 8 * c8) = *(const u32x4*)(C.pwt + (size_t)gi * 16384 + d * 128 + 8 * c8); }
    if (gi == 0) pool_fill<2>(C.proj, row0, seqstart, gi, Pl, tid); else if (gi == 1) pool_fill<4>(C.proj, row0, seqstart, gi, Pl, tid);
    else if (gi == 2) pool_fill<8>(C.proj, row0, seqstart, gi, Pl, tid); else pool_fill<16>(C.proj, row0, seqstart, gi, Pl, tid);
    __syncthreads();
    {
        const int mi = wave >> 1, r = lane & 31, hq = lane >> 5;
        f32x16 acc[2];
#pragma unroll
        for (int j = 0; j < 2; ++j)
#pragma unroll
            for (int e = 0; e < 16; ++e) acc[j][e] = 0.f;
#pragma unroll 2
        for (int ks = 0; ks < 8; ++ks) {
            const bf16x8 a = *(const LAS bf16x8*)(Pl + (32 * mi + r) * PIT + 16 * ks + 8 * hq);
#pragma unroll
            for (int j = 0; j < 2; ++j) { const int ni = 2 * (wave & 1) + j; const bf16x8 bb = *(const LAS bf16x8*)(Wp + (32 * ni + r) * PIT + 16 * ks + 8 * hq); acc[j] = MFMA32(a, bb, acc[j]); }
        }
#pragma unroll
        for (int j = 0; j < 2; ++j) { const int ni = 2 * (wave & 1) + j;
#pragma unroll
            for (int e = 0; e < 16; ++e) { const int tl = 32 * mi + (e & 3) + 8 * (e >> 2) + 4 * hq; C.mix[(size_t)(row0 + tl) * D + 512 + gi * 128 + 32 * ni + r] = f2bf(acc[j][e]); } }
    }
    __syncthreads();
}

__device__ __forceinline__ void scan_phase(bf16_t* states, const float* cdecay, int G, int bid) {
    int tid_ = threadIdx.x; asm volatile("" : "+v"(tid_));
    for (int idx = bid * 512 + tid_; idx < 2 * 8 * 64 * 128; idx += G * 512) {
        const int n = idx & 127, p = (idx >> 7) & 63, h = (idx >> 13) & 7, b = idx >> 16;
        bf16_t* sp = states + ((size_t)b * 128 * 8 + h) * 8192 + p * 128 + n; const float* dp = cdecay + (size_t)b * 128 * 8 + h;
        float s = 0.f;
        for (int c0 = 0; c0 < 128; c0 += 16) {
            float v[16], d[16];
#pragma unroll
            for (int i = 0; i < 16; ++i) { v[i] = bf2f(sp[(size_t)(c0 + i) * 8 * 8192]); d[i] = dp[(c0 + i) * 8]; }
#pragma unroll
            for (int i = 0; i < 16; ++i) { sp[(size_t)(c0 + i) * 8 * 8192] = f2bf(s); s = s * d[i] + v[i]; }
        }
    }
}
__device__ __forceinline__ void ssd_s3_job(const SsdCtx& C, LAS unsigned char* lds, int b, int c, int g) {
    int tid_ = threadIdx.x; asm volatile("" : "+v"(tid_)); const int tid = tid_, lane = tid & 63, wave = tid >> 6;
    LAS bf16_t* Cn = (LAS bf16_t*)lds; LAS bf16_t* CBm = (LAS bf16_t*)(lds + 128 * PIT * 2); LAS bf16_t* Bn = (LAS bf16_t*)(lds + 256 * PIT * 2); LAS bf16_t* XT = Bn;
    LAS float* dtT = (LAS float*)(lds + 139264); LAS float* acs = dtT + 512; LAS float* red = dtT + 1024;
    const long row0 = (long)b * SEQ + c * 128;
    { const int tok = tid >> 2, hh = tid & 3; dtT[hh * 128 + tok] = C.dtbuf[(size_t)(row0 + tok) * 8 + 4 * g + hh]; }
    __syncthreads();
    { const float Ah = wave < 4 ? -__expf(C.a_log[4 * g + wave]) : 0.f; (void)chunk_cumsum(dtT, acs, wave, lane, Ah); }
    for (int idx = tid; idx < 128 * 16; idx += 512) {
        const int cp = idx & 127, r = idx >> 7; const bool isB = cp < 64;
        const int xch = isB ? 512 + g * 128 + 2 * cp : 768 + g * 128 + 2 * (cp - 64);
        float o0[8], o1[8];
        conv8x2(C.proj, row0, 8 * r, c == 0, 512 + xch, C.cw, C.cb, xch, o0, o1);
        LAS bf16_t* dst = (isB ? Bn + 2 * cp : Cn + 2 * (cp - 64)) + (8 * r) * PIT;
#pragma unroll
        for (int i = 0; i < 8; ++i) *(LAS unsigned*)(dst + i * PIT) = cvt_pk_bf16(o0[i], o1[i]);
    }
    __syncthreads();
    {
        const int mi = wave >> 1, r = lane & 31, hq = lane >> 5;
        f32x16 acc[2];
#pragma unroll
        for (int j = 0; j < 2; ++j)
#pragma unroll
            for (int e = 0; e < 16; ++e) acc[j][e] = 0.f;
#pragma unroll 2
        for (int ks = 0; ks < 8; ++ks) {
            const bf16x8 a = *(const LAS bf16x8*)(Cn + (32 * mi + r) * PIT + 16 * ks + 8 * hq);
#pragma unroll
            for (int j = 0; j < 2; ++j) { const int ni = 2 * (wave & 1) + j; const bf16x8 bb = *(const LAS bf16x8*)(Bn + (32 * ni + r) * PIT + 16 * ks + 8 * hq); acc[j] = MFMA32(a, bb, acc[j]); }
        }
#pragma unroll
        for (int j = 0; j < 2; ++j) { const int ni = 2 * (wave & 1) + j;
#pragma unroll
            for (int e = 0; e < 16; ++e) { const int l = 32 * mi + (e & 3) + 8 * (e >> 2) + 4 * hq; CBm[l * PIT + 32 * ni + r] = f2bf(acc[j][e]); } }
    }
    __syncthreads();
    for (int idx = tid; idx < 128 * 16; idx += 512) {
        const int cp = idx & 127, r = idx >> 7; const int xch = g * 256 + 2 * cp;
        float o0[8], o1[8];
        conv8x2(C.proj, row0, 8 * r, c == 0, 512 + xch, C.cw, C.cb, xch, o0, o1);
        LAS bf16_t* dst = XT + (2 * cp) * PIT + 8 * r;
        u32x4 w0, w1; w0.x = cvt_pk_bf16(o0[0], o0[1]); w0.y = cvt_pk_bf16(o0[2], o0[3]); w0.z = cvt_pk_bf16(o0[4], o0[5]); w0.w = cvt_pk_bf16(o0[6], o0[7]);
        w1.x = cvt_pk_bf16(o1[0], o1[1]); w1.y = cvt_pk_bf16(o1[2], o1[3]); w1.z = cvt_pk_bf16(o1[4], o1[5]); w1.w = cvt_pk_bf16(o1[6], o1[7]);
        *(LAS u32x4*)dst = w0; *(LAS u32x4*)(dst + PIT) = w1;
    }
    __syncthreads();
    const int hh = wave >> 1, lh = wave & 1, r = lane & 31, hq = lane >> 5, h = 4 * g + hh;
    f32x16 acc[2][2];
#pragma unroll
    for (int i = 0; i < 2; ++i)
#pragma unroll
        for (int j = 0; j < 2; ++j)
#pragma unroll
            for (int e = 0; e < 16; ++e) acc[i][j][e] = 0.f;
    {
        const bf16_t* pv = C.states + ((size_t)(b * 128 + c) * 8 + h) * 64 * 128;
#pragma unroll 2
        for (int ks = 0; ks < 8; ++ks) {
            bf16x8 a[2], bb[2];
#pragma unroll
            for (int i = 0; i < 2; ++i) { a[i] = *(const bf16x8*)(pv + (32 * i + r) * 128 + 16 * ks + 8 * hq); bb[i] = *(const LAS bf16x8*)(Cn + (64 * lh + 32 * i + r) * PIT + 16 * ks + 8 * hq); }
#pragma unroll
            for (int i = 0; i < 2; ++i)
#pragma unroll
                for (int j = 0; j < 2; ++j) acc[i][j] = MFMA32(a[i], bb[j], acc[i][j]);
        }
#pragma unroll
        for (int j = 0; j < 2; ++j) { const float el = __expf(acs[hh * 128 + 64 * lh + 32 * j + r]);
#pragma unroll
            for (int i = 0; i < 2; ++i)
#pragma unroll
                for (int e = 0; e < 16; ++e) acc[i][j][e] *= el; }
    }
#pragma unroll
    for (int li = 0; li < 2; ++li) {
        const int l = 64 * lh + 32 * li + r; const float al = acs[hh * 128 + l];
        const int nks = 4 * lh + 2 * li + 2;
        for (int ks = 0; ks < nks; ++ks) {
            const int s0 = 16 * ks + 8 * hq;
            const u32x4 cb = *(const LAS u32x4*)(CBm + l * PIT + s0);
            const f32x4 as0 = *(const LAS f32x4*)(acs + hh * 128 + s0), as1 = *(const LAS f32x4*)(acs + hh * 128 + s0 + 4);
            const f32x4 d0 = *(const LAS f32x4*)(dtT + hh * 128 + s0), d1 = *(const LAS f32x4*)(dtT + hh * 128 + s0 + 4);
            float m[8];
            m[0] = bf_lo(cb.x) * __expf(al - as0[0]) * d0[0]; m[1] = bf_hi(cb.x) * __expf(al - as0[1]) * d0[1];
            m[2] = bf_lo(cb.y) * __expf(al - as0[2]) * d0[2]; m[3] = bf_hi(cb.y) * __expf(al - as0[3]) * d0[3];
            m[4] = bf_lo(cb.z) * __expf(al - as1[0]) * d1[0]; m[5] = bf_hi(cb.z) * __expf(al - as1[1]) * d1[1];
            m[6] = bf_lo(cb.w) * __expf(al - as1[2]) * d1[2]; m[7] = bf_hi(cb.w) * __expf(al - as1[3]) * d1[3];
#pragma unroll
            for (int j = 0; j < 8; ++j) m[j] = (s0 + j <= l) ? m[j] : 0.f;
            u32x4 mw; mw.x = cvt_pk_bf16(m[0], m[1]); mw.y = cvt_pk_bf16(m[2], m[3]); mw.z = cvt_pk_bf16(m[4], m[5]); mw.w = cvt_pk_bf16(m[6], m[7]);
            const bf16x8 mf = __builtin_bit_cast(bf16x8, mw);
#pragma unroll
            for (int pi = 0; pi < 2; ++pi) { const bf16x8 a = *(const LAS bf16x8*)(XT + (64 * hh + 32 * pi + r) * PIT + s0); acc[pi][li] = MFMA32(a, mf, acc[pi][li]); }
        }
    }
    const float Dh = C.d_skip[h];
    float sq[2] = {0.f, 0.f};
#pragma unroll
    for (int li = 0; li < 2; ++li) { const int l = 64 * lh + 32 * li + r;
#pragma unroll
        for (int pi = 0; pi < 2; ++pi)
#pragma unroll
            for (int e4 = 0; e4 < 4; ++e4) { const int p0 = 32 * pi + 8 * e4 + 4 * hq;
                const u32x2 zz = *(const u32x2*)(C.proj + (size_t)(row0 + l) * NPROJ + g * 256 + hh * 64 + p0);
                const float zf[4] = {bf_lo(zz.x), bf_hi(zz.x), bf_lo(zz.y), bf_hi(zz.y)};
#pragma unroll
                for (int k = 0; k < 4; ++k) { const float xs = bf2f(XT[(64 * hh + p0 + k) * PIT + l]); float y = acc[pi][li][4 * e4 + k] + xs * Dh; y *= silu_f(zf[k]); acc[pi][li][4 * e4 + k] = y; sq[li] += y * y; } }
        sq[li] += __shfl_xor(sq[li], 32);
        if (hq == 0) red[hh * 128 + l] = sq[li]; }
    __syncthreads();
#pragma unroll
    for (int li = 0; li < 2; ++li) { const int l = 64 * lh + 32 * li + r;
        const float rstd = rsqrtf((red[l] + red[128 + l] + red[256 + l] + red[384 + l]) * (1.f / 256.f) + EPS);
#pragma unroll
        for (int pi = 0; pi < 2; ++pi)
#pragma unroll
            for (int e4 = 0; e4 < 4; ++e4) { const int p0 = 32 * pi + 8 * e4 + 4 * hq, ch = g * 256 + hh * 64 + p0;
                const f32x4 ng = *(const f32x4*)(C.norm_g + ch);
                u32x2 w; w.x = cvt_pk_bf16(acc[pi][li][4 * e4] * rstd * ng[0], acc[pi][li][4 * e4 + 1] * rstd * ng[1]); w.y = cvt_pk_bf16(acc[pi][li][4 * e4 + 2] * rstd * ng[2], acc[pi][li][4 * e4 + 3] * rstd * ng[3]);
                *(u32x2*)(C.mix + (size_t)(row0 + l) * D + ch) = w; } }
    __syncthreads();
}

__device__ __forceinline__ void fixup_phase(const Params& P, int l, bf16_t* act, const float* head, const float* tail, bf16_t* pb, int G, int bid) {
    const float* cw = P.fconv_w + (size_t)l * 3 * DUP; const float* cb = P.fconv_b + (size_t)l * DUP;
    int tid_ = threadIdx.x; asm volatile("" : "+v"(tid_)); const int gt = bid * 512 + tid_, NT = G * 512;
    for (int idx = gt; idx < 512 * DFF; idx += NT) {
        const int s = idx / DFF, j = idx % DFF; const bool first = (s & 255) == 0;
        float o[2];
        float cvals[2][2];
#pragma unroll
        for (int gv = 0; gv < 2; ++gv) { const int col = j + gv * DFF;
            const float tm2 = first ? 0.f : tail[(size_t)((s - 1) * 2) * DUP + col], tm1 = first ? 0.f : tail[(size_t)((s - 1) * 2 + 1) * DUP + col];
            const float h0 = head[(size_t)(s * 2) * DUP + col], h1 = head[(size_t)(s * 2 + 1) * DUP + col];
            const float w0 = cw[col], w1 = cw[DUP + col], w2 = cw[2 * DUP + col], bb = cb[col];
            cvals[gv][0] = bb + w0 * tm2 + w1 * tm1 + w2 * h0; cvals[gv][1] = bb + w0 * tm1 + w1 * h0 + w2 * h1; }
        o[0] = gelu_tanh(cvals[0][0]) * cvals[1][0]; o[1] = gelu_tanh(cvals[0][1]) * cvals[1][1];
        act[(size_t)(64 * s) * DFF + j] = f2bf(o[0]); act[(size_t)(64 * s + 1) * DFF + j] = f2bf(o[1]);
    }
    const f32x4* ps = (const f32x4*)(P.p + (size_t)l * T * DPLE);
    for (int idx = gt; idx < T * DPLE / 4; idx += NT) { const f32x4 v = ps[idx]; u32x2 w; w.x = cvt_pk_bf16(v.x, v.y); w.y = cvt_pk_bf16(v.z, v.w); *(u32x2*)(pb + (size_t)idx * 4) = w; }
}

#define XB_TMO      128
#define XB_XCNT(j)  (256  + 64 * (j))
#define XB_XSUB(j)  (1280 + 64 * (j))
#define XB_XGEN(j)  (2304 + 64 * (j))
#define XB_TOP      3328
#define XB_TOPGEN   3392
#define XCD_BAR_WORDS 3456
#define XB_SPIN_CAP (1u << 18)

__device__ __forceinline__ unsigned xb_ld(unsigned* p)              { return __hip_atomic_load(p, __ATOMIC_RELAXED, __HIP_MEMORY_SCOPE_AGENT); }
__device__ __forceinline__ unsigned xb_add(unsigned* p, unsigned v) { return __hip_atomic_fetch_add(p, v, __ATOMIC_RELAXED, __HIP_MEMORY_SCOPE_AGENT); }
__device__ __forceinline__ unsigned xb_xcc_id() { return (unsigned)__builtin_amdgcn_s_getreg((3 << 11) | 20) & 0xFu; }
#define XB_SPIN(cond, bar) do { unsigned _sp = 0; while (cond) { __builtin_amdgcn_s_sleep(1); \
    if ((++_sp & 255u) == 0u) { if (xb_ld(&(bar)[XB_TMO])) break; if (_sp > XB_SPIN_CAP) { atomicAdd(&(bar)[XB_TMO], 1u); break; } } } } while (0)

struct XcdBarrier {
    unsigned* bar; unsigned x;
    volatile LAS unsigned* st;
};

__device__ __forceinline__ XcdBarrier xcd_barrier_post(unsigned* bar, volatile LAS unsigned* st) {
    XcdBarrier b; b.bar = bar; b.x = xb_xcc_id(); b.st = st;
    if (threadIdx.x == 0) (void)xb_add(&bar[XB_XCNT(b.x)], 1u);
    return b;
}
__device__ __forceinline__ void xcd_barrier_complete(unsigned* bar, unsigned x, unsigned& nloc, unsigned& nx) {
    const unsigned G = gridDim.x * gridDim.y * gridDim.z;
    unsigned sum, cnt, mine, sp = 0u;
    for (;;) {
        sum = 0u; cnt = 0u; mine = 0u;
#pragma unroll
        for (unsigned j = 0; j < 16; ++j) { const unsigned c = xb_ld(&bar[XB_XCNT(j)]); sum += c; cnt += (c > 0u) ? 1u : 0u; mine = (j == x) ? c : mine; }
        if (sum == G) break;
        __builtin_amdgcn_s_sleep(1);
        if ((++sp & 255u) == 0u) { if (xb_ld(&bar[XB_TMO])) break; if (sp > XB_SPIN_CAP) { atomicAdd(&bar[XB_TMO], 1u); break; } }
    }
    nloc = mine > 0u ? mine : 1u; nx = cnt > 0u ? cnt : 1u;
}

__device__ __forceinline__ void xcd_barrier(const XcdBarrier& b) {
    asm volatile("s_waitcnt vmcnt(0)" ::: "memory");
    __syncthreads();
    if (threadIdx.x == 0) {
        unsigned* bar = b.bar;
        __builtin_amdgcn_s_waitcnt(0);
        unsigned nloc = b.st[0], nx = b.st[1];
        if (nloc == 0u) { xcd_barrier_complete(bar, b.x, nloc, nx); b.st[0] = nloc; b.st[1] = nx; }
        const unsigned old = xb_add(&bar[XB_XSUB(b.x)], 1u);
        const unsigned gen = old / nloc;
        if (old + 1u == (gen + 1u) * nloc) {
            __builtin_amdgcn_fence(__ATOMIC_RELEASE, "agent");
            asm volatile("s_waitcnt vmcnt(0)" ::: "memory");
            const unsigned og = xb_add(&bar[XB_TOP], 1u);
            const unsigned tg = og / nx;
            if (og + 1u == (tg + 1u) * nx) xb_add(&bar[XB_TOPGEN], 1u);
            else XB_SPIN(xb_ld(&bar[XB_TOPGEN]) == tg, bar);
            __builtin_amdgcn_fence(__ATOMIC_ACQUIRE, "agent");
            xb_add(&bar[XB_XGEN(b.x)], 1u);
            asm volatile("s_waitcnt vmcnt(0)" ::: "memory");
        } else {
            XB_SPIN(xb_ld(&bar[XB_XGEN(b.x)]) == gen, bar);
            __builtin_amdgcn_fence(__ATOMIC_ACQUIRE, "agent");
            asm volatile("s_waitcnt vmcnt(0)" ::: "memory");
        }
    }
    __syncthreads();
}


__global__ __launch_bounds__(512, 2) void hymba_fwd(Params P) {
    extern __shared__ __attribute__((aligned(16))) unsigned char shm[];
    LAS unsigned char* lds = (LAS unsigned char*)shm;
    cg::grid_group grid = cg::this_grid();
    const int G = (int)gridDim.x, bid = (int)blockIdx.x;
    bf16_t* hbuf[2] = {(bf16_t*)(P.ws + OFF_HB0), (bf16_t*)(P.ws + OFF_HB1)};
    float* ssbuf[2] = {(float*)(P.ws + OFF_SS), (float*)(P.ws + OFF_SS) + (size_t)T * 16};
    bf16_t* wt = (bf16_t*)(P.ws + OFF_WT);
    bf16_t* proj = (bf16_t*)(P.ws + OFF_R); bf16_t* act = proj; bf16_t* states = (bf16_t*)(P.ws + OFF_ST);
    bf16_t* mix = (bf16_t*)(P.ws + OFF_MIX); bf16_t* qb = mix; float* head = (float*)(P.ws + OFF_MIX); float* tail = (float*)(P.ws + OFF_TAIL);
    bf16_t* pb = (bf16_t*)(P.ws + OFF_PB); float* dtbuf = (float*)(P.ws + OFF_DT); float* cdecay = (float*)(P.ws + OFF_CD);
    pg8::StaticOrder S;
    volatile LAS unsigned* xst = (volatile LAS unsigned*)(lds + LDS_BYTES - 16);
    if (threadIdx.x == 0) { xst[0] = 0u; xst[1] = 0u; }
    __syncthreads();
    const XcdBarrier xb = xcd_barrier_post((unsigned*)(P.ws + OFF_BAR), xst);

    phase0(P, lds, G, bid);
    grid.sync();
    int cur = 0;
#pragma unroll 1
    for (int l = 0; l < NL; ++l) {
        const bf16_t* wl = wt + (size_t)l * WLAYER;
        bf16_t* hb = cur ? hbuf[1] : hbuf[0]; bf16_t* hbn = cur ? hbuf[0] : hbuf[1];
        float* ss = cur ? ssbuf[1] : ssbuf[0]; float* ssn = cur ? ssbuf[0] : ssbuf[1];
        { S.init(T, NPROJ, G, bid); EpiIn E{proj, ss}; pg8::gemm_phase<EpiIn, pg8::StaticOrder>(lds, pg8::Gemm{hb, wl + WIN, T, NPROJ, D}, S, E, nullptr); }
        xcd_barrier(xb);
        SsdCtx C{proj, hb, ss, wl + WDT, P.conv_w + (size_t)l * 4 * 1024, P.conv_b + (size_t)l * 1024, P.dt_bias + l * 8, P.a_log + l * 8, P.d_skip + l * 8, P.norm_g + l * 512,
                 states, dtbuf, cdecay, mix, wl + WPOOL};
        for (int job = bid; job < 512 + 1024; job += G) {
            if (job < 512) ssd_s1_job(C, lds, job >> 8, (job >> 1) & 127, job & 1);
            else { const int j = job - 512; pool_job(C, lds, j >> 2, j & 3); }
        }
        xcd_barrier(xb);
        scan_phase(states, cdecay, G, bid);
        xcd_barrier(xb);
        for (int job = bid; job < 512; job += G) ssd_s3_job(C, lds, job >> 8, (job >> 1) & 127, job & 1);
        xcd_barrier(xb);
        { S.init(T, D, G, bid); EpiRes<false> E{hb, hb, ss, nullptr, nullptr}; pg8::gemm_phase<EpiRes<false>, pg8::StaticOrder>(lds, pg8::Gemm{mix, wl + WOUT, T, D, D}, S, E, nullptr); }
        xcd_barrier(xb);
        { UpOrder SU; SU.init(T, DUP, G, bid); SU.cw = P.fconv_w + (size_t)l * 3 * DUP; SU.cb = P.fconv_b + (size_t)l * DUP; SU.pbuf = (LAS float*)(lds + 131072); SU.na = 0;
          EpiUp E{act, ss, (const LAS float*)(lds + 131072), head, tail, 0}; pg8::gemm_phase<EpiUp, UpOrder>(lds, pg8::Gemm{hb, wl + WUP, T, DUP, D}, SU, E, nullptr); }
        xcd_barrier(xb);
        fixup_phase(P, l, act, head, tail, pb, G, bid);
        xcd_barrier(xb);
        { S.init(T, D, G, bid); EpiRes<false> E{hb, hb, ss, nullptr, nullptr}; pg8::gemm_phase<EpiRes<false>, pg8::StaticOrder>(lds, pg8::Gemm{act, wl + WDOWN, T, D, DFF}, S, E, nullptr); }
        { S.init(T, D, G, bid); EpiQ E{qb}; pg8::gemm_phase<EpiQ, pg8::StaticOrder>(lds, pg8::Gemm{pb, wl + WPLE, T, D, DPLE}, S, E, nullptr); }
        xcd_barrier(xb);
        { S.init(T, D, G, bid); EpiRes<true> E{hb, hbn, ssn, ss, qb}; pg8::gemm_phase<EpiRes<true>, pg8::StaticOrder>(lds, pg8::Gemm{hb, wl + WGATE, T, D, D}, S, E, nullptr); }
        xcd_barrier(xb);
        cur ^= 1;
    }
    {
        const int lane = threadIdx.x & 63, wave = threadIdx.x >> 6;
        const float* ss = cur ? ssbuf[1] : ssbuf[0]; const bf16_t* hb = cur ? hbuf[1] : hbuf[0];
        for (int row = bid * 8 + wave; row < T; row += G * 8) {
            const float rs = row_rstd(ss, row); const u32x2* hr = (const u32x2*)(hb + (size_t)row * D) + lane; f32x4* xr = (f32x4*)(P.out + (size_t)row * D) + lane; const f32x4* gr = (const f32x4*)P.final_g + lane;
#pragma unroll
            for (int j = 0; j < 4; ++j) { const u32x2 hh = hr[64 * j]; const f32x4 gg = gr[64 * j]; f32x4 v = {bf_lo(hh.x), bf_hi(hh.x), bf_lo(hh.y), bf_hi(hh.y)}; v = v * rs * gg; xr[64 * j] = v; }
        }
    }
}

extern "C" void kernel_launch(void* const* d_in, const int* in_sizes, int n_in, void* d_out, int out_size, void* d_ws, size_t ws_size, hipStream_t stream) {
    static int grid = 0;
    if (grid == 0) {
        if (n_in != 22 || ws_size < WS_END) { fprintf(stderr, "kernel_launch: unexpected inputs (n_in %d, ws %zu, need %zu)\n", n_in, ws_size, (size_t)WS_END); grid = -1; return; }
        int dev = 0, cus = 0, per_cu = 0;
        (void)hipGetDevice(&dev); (void)hipDeviceGetAttribute(&cus, hipDeviceAttributeMultiprocessorCount, dev);
        if (hipFuncSetAttribute((const void*)hymba_fwd, hipFuncAttributeMaxDynamicSharedMemorySize, LDS_BYTES) != hipSuccess) { fprintf(stderr, "kernel_launch: hipFuncSetAttribute failed\n"); grid = -1; return; }
        if (hipOccupancyMaxActiveBlocksPerMultiprocessor(&per_cu, (const void*)hymba_fwd, 512, LDS_BYTES) != hipSuccess || per_cu < 1) { fprintf(stderr, "kernel_launch: occupancy query says %d blocks per CU\n", per_cu); per_cu = 1; }
        (void)hipGetLastError();
        grid = cus;
    }
    if (grid < 0) return;
    Params p{};
    const float** pp = (const float**)&p;
    for (int i = 0; i < 22; ++i) pp[i] = (const float*)d_in[i];
    p.out = (float*)d_out; p.ws = (unsigned char*)d_ws;
    if (hipMemsetAsync((char*)d_ws + OFF_BAR, 0, 16384, stream) != hipSuccess) { fprintf(stderr, "kernel_launch: memset failed\n"); return; }
    void* args[] = {&p};
    hipError_t e = hipLaunchCooperativeKernel((const void*)hymba_fwd, dim3(grid), dim3(512), args, LDS_BYTES, stream);
    if (e != hipSuccess) fprintf(stderr, "cooperative launch failed: %s (grid %d)\n", hipGetErrorString(e), grid);
}
```

```cpp
#include <hip/hip_runtime.h>
#include <hip/hip_cooperative_groups.h>
#include <cstdio>
#include <cstdint>
namespace cg = cooperative_groups;
namespace pg8 {
#define PG8_LAS __attribute__((address_space(3)))
typedef unsigned short bf16_t;
typedef short bf16x8 __attribute__((ext_vector_type(8)));
typedef float f32x4 __attribute__((ext_vector_type(4)));
typedef unsigned u32x4 __attribute__((ext_vector_type(4)));
constexpr int BM = 256, BK = 64, HALF = 128, HTB = HALF * BK * 2  , STAGE_BYTES = 8 * HTB, NXCD = 8, WGM = 8;

__host__ __device__ __forceinline__ int lds_byte(int r, int c) { const int st = (r >> 4) * 2 + (c >> 5), rr = r & 15, cc = c & 31, ob = rr * 64 + cc * 2; return st * 1024 + (ob ^ (((ob >> 9) & 1) << 5)); }
__host__ __device__ __forceinline__ void stage_rc(int b, int& R, int& C) { const int st = b / 1024, sb = b % 1024, swz = sb ^ (((sb >> 9) & 1) << 5); R = (st >> 1) * 16 + swz / 64; C = (st & 1) * 32 + (swz % 64) / 2; }
__host__ __device__ __forceinline__ int perm32(int rho) { const int n = rho >> 4, i = rho & 15; return 8 * (i >> 2) + 4 * n + (i & 3); }

struct Unit { int pm, pn; };
struct Gemm { const bf16_t* A; const bf16_t* Bt; int M, N, K; };

struct StaticOrder {
    int nM, nN, nwg, G, c;
    __host__ __device__ void init(int M, int N, int G_, int c_) { nM = M / BM; nN = N / BM; nwg = nM * nN; G = G_; c = c_; }
    __host__ __device__ bool next(int i, Unit& u) const {
        const long L = (long)i * G + c; if (L >= nwg) return false;
        int wgid = (int)L; { const int q = nwg / NXCD, r = nwg % NXCD, xcd = wgid % NXCD, off = wgid / NXCD; wgid = (xcd < r ? xcd * (q + 1) : r * (q + 1) + (xcd - r) * q) + off; }
        const int nig = WGM * nN, gid = wgid / nig, fm = gid * WGM, gsz = (nM - fm) < WGM ? (nM - fm) : WGM;
        u.pm = fm + ((wgid % nig) % gsz); u.pn = (wgid % nig) / gsz; return true;
    }
    __device__ __forceinline__ void a_ready(const Unit&) const {}
    __device__ __forceinline__ void done(const Unit&) const {}
};
__device__ __forceinline__ unsigned cvt_pk_bf16(float lo, float hi) { unsigned r; asm volatile("v_cvt_pk_bf16_f32 %0, %1, %2" : "=v"(r) : "v"(lo), "v"(hi)); return r; }

template <class Epi, class Sched, bool ALIGN_EPI = false, bool SP2 = false>
__device__ __forceinline__ void gemm_phase(PG8_LAS unsigned char* lds, const Gemm g, const Sched& S, const Epi& E) {
    int tid_ = threadIdx.x; asm volatile("" : "+v"(tid_));
    const int tid = tid_, wid = __builtin_amdgcn_readfirstlane(tid >> 6), lane = tid & 63, wr = wid >> 2, wc = wid & 3, fr = lane & 15, fq = lane >> 4;
    int K_ = g.K; asm volatile("" : "+s"(K_));
    const int K = K_, nt = K / BK;
    unsigned voffA[2], voffB[2];
#pragma unroll
    for (int i = 0; i < 2; ++i) { int R, C; stage_rc(tid * 16 + i * 8192, R, C); const int Rb = Epi::PERM ? ((R & ~31) + perm32(R & 31)) : R;
        voffA[i] = (unsigned)(R * K + C) * 2u; voffB[i] = (unsigned)(Rb * K + C) * 2u; }
    const size_t kstep = (size_t)(BK * 2);
    const size_t hstep = (size_t)HALF * K * 2;
    const size_t tstep = 2 * hstep;
    const unsigned ldsw = (unsigned)wid * 1024u;
    const int aoff = lds_byte(wr * 64 + fr, fq * 8), boff = lds_byte(wc * 32 + fr, fq * 8);
#define PG8_SA(b, h) (((b) * 2 + (h)) * HTB)
#define PG8_SB(b, h) ((4 + (b) * 2 + (h)) * HTB)
#define PG8_STAGE(bufoff, gbase, voff) do { _Pragma("unroll") for (int _i = 0; _i < 2; ++_i) \
        __builtin_amdgcn_global_load_lds((const unsigned*)((const char*)(gbase) + (voff)[_i]), (PG8_LAS unsigned*)(lds + (bufoff) + ldsw + _i * 8192), 16, 0, 0); } while (0)
#define PG8_LDA(dst, b, h) do { _Pragma("unroll") for (int m = 0; m < 4; ++m) _Pragma("unroll") for (int k = 0; k < 2; ++k) dst[m][k] = *(const PG8_LAS bf16x8*)(lds + PG8_SA(b, h) + aoff + m * 2048 + k * 1024); } while (0)
#define PG8_LDB(dst, b, h) do { _Pragma("unroll") for (int n = 0; n < 2; ++n) _Pragma("unroll") for (int k = 0; k < 2; ++k) dst[n][k] = *(const PG8_LAS bf16x8*)(lds + PG8_SB(b, h) + boff + n * 2048 + k * 1024); } while (0)
#define PG8_MMA(ai, bj, At, Bt) do { __builtin_amdgcn_s_setprio(1); _Pragma("unroll") for (int m = 0; m < 4; ++m) _Pragma("unroll") for (int n = 0; n < 2; ++n) _Pragma("unroll") for (int k = 0; k < 2; ++k) \
        acc[ai][bj][m][n] = __builtin_amdgcn_mfma_f32_16x16x32_bf16(Bt[n][k], At[m][k], acc[ai][bj][m][n], 0, 0, 0); __builtin_amdgcn_s_setprio(0); } while (0)
#define PG8_WAIT_V(n) asm volatile("s_waitcnt vmcnt(" #n ")" ::: "memory")
#define PG8_WAIT_L(n) asm volatile("s_waitcnt lgkmcnt(" #n ")" ::: "memory")
#define PG8_BAR __builtin_amdgcn_s_barrier()
#define PG8_SCHED __builtin_amdgcn_sched_barrier(0)
    Unit cur, nxt; int ui = 0;
    if (!S.next(0, cur)) return;
    f32x4 acc[2][2][4][2];
#pragma unroll
    for (int a = 0; a < 2; ++a)
#pragma unroll
        for (int b = 0; b < 2; ++b)
#pragma unroll
            for (int m = 0; m < 4; ++m)
#pragma unroll
                for (int n = 0; n < 2; ++n) acc[a][b][m][n] = (f32x4){0.f, 0.f, 0.f, 0.f};
    bf16x8 At[4][2], B0[2][2], B1[2][2];
    const char* cA = (const char*)g.A + (size_t)cur.pm * tstep; const char* cB = (const char*)g.Bt + (size_t)cur.pn * tstep;
    S.a_ready(cur);
    if constexpr (SP2) {
        PG8_STAGE(PG8_SB(0, 0), cB, voffB); PG8_STAGE(PG8_SB(0, 1), cB + hstep, voffB); PG8_STAGE(PG8_SA(0, 0), cA, voffA); PG8_STAGE(PG8_SA(0, 1), cA + hstep, voffA);
        if (wr == 1) PG8_BAR;
        PG8_WAIT_V(2); PG8_BAR;
        PG8_STAGE(PG8_SB(1, 0), cB + kstep, voffB); PG8_STAGE(PG8_SA(1, 0), cA + kstep, voffA); PG8_STAGE(PG8_SB(1, 1), cB + hstep + kstep, voffB);
        PG8_WAIT_V(6); PG8_BAR;
    } else {
        PG8_STAGE(PG8_SB(0, 0), cB, voffB); PG8_STAGE(PG8_SA(0, 0), cA, voffA); PG8_STAGE(PG8_SB(0, 1), cB + hstep, voffB); PG8_STAGE(PG8_SA(0, 1), cA + hstep, voffA);
        if (wr == 1) PG8_BAR;
        PG8_WAIT_V(4); PG8_BAR;
        PG8_STAGE(PG8_SB(1, 0), cB + kstep, voffB); PG8_STAGE(PG8_SA(1, 0), cA + kstep, voffA); PG8_STAGE(PG8_SB(1, 1), cB + hstep + kstep, voffB);
        PG8_WAIT_V(6); PG8_BAR;
    }
    for (;;) {
        const bool has_next = S.next(ui + 1, nxt);
        const char* nA = has_next ? (const char*)g.A + (size_t)nxt.pm * tstep : cA; const char* nB = has_next ? (const char*)g.Bt + (size_t)nxt.pn * tstep : cB;
        for (int t = 0; t < nt; t += 2) {
            const bool last = (t == nt - 2);
            const char* a1 = cA + (size_t)(t + 1) * kstep;
            const char* a2 = last ? nA : cA + (size_t)(t + 2) * kstep; const char* b2 = last ? nB : cB + (size_t)(t + 2) * kstep;
            const char* a3 = a2 + kstep; const char* b3 = b2 + kstep;
            if (last && has_next) S.a_ready(nxt);
            if constexpr (SP2) {
            PG8_LDB(B0, 0, 0); PG8_LDB(B1, 0, 1); PG8_SCHED; PG8_LDA(At, 0, 0); PG8_STAGE(PG8_SA(1, 1), a1 + hstep, voffA);
            PG8_WAIT_V(8); PG8_WAIT_L(0); PG8_BAR; PG8_MMA(0, 0, At, B0); PG8_MMA(0, 1, At, B1); PG8_BAR; PG8_SCHED;
            PG8_LDA(At, 0, 1); PG8_STAGE(PG8_SB(0, 0), b2, voffB); PG8_STAGE(PG8_SB(0, 1), b2 + hstep, voffB); PG8_STAGE(PG8_SA(0, 0), a2, voffA);
            PG8_WAIT_V(8); PG8_WAIT_L(0); PG8_BAR; PG8_MMA(1, 0, At, B0); PG8_MMA(1, 1, At, B1); PG8_BAR; PG8_SCHED;
            PG8_LDB(B0, 1, 0); PG8_LDB(B1, 1, 1); PG8_SCHED; PG8_LDA(At, 1, 0); PG8_STAGE(PG8_SA(0, 1), a2 + hstep, voffA);
            PG8_WAIT_V(8); PG8_WAIT_L(0); PG8_BAR; PG8_MMA(0, 0, At, B0); PG8_MMA(0, 1, At, B1); PG8_BAR; PG8_SCHED;
            PG8_LDA(At, 1, 1); PG8_STAGE(PG8_SB(1, 0), b3, voffB); PG8_STAGE(PG8_SB(1, 1), b3 + hstep, voffB); PG8_STAGE(PG8_SA(1, 0), a3, voffA);
            PG8_WAIT_V(8); PG8_WAIT_L(0); PG8_BAR; PG8_MMA(1, 0, At, B0); PG8_MMA(1, 1, At, B1); PG8_BAR; PG8_SCHED;
            } else {
            PG8_LDB(B0, 0, 0); PG8_SCHED; PG8_LDA(At, 0, 0); PG8_STAGE(PG8_SA(1, 1), a1 + hstep, voffA);
            PG8_WAIT_L(8); PG8_BAR; PG8_WAIT_L(0); PG8_MMA(0, 0, At, B0); PG8_BAR; PG8_SCHED;
            PG8_LDB(B1, 0, 1); PG8_STAGE(PG8_SB(0, 0), b2, voffB);
            PG8_BAR; PG8_WAIT_L(0); PG8_MMA(0, 1, At, B1); PG8_BAR;
            PG8_LDA(At, 0, 1); PG8_STAGE(PG8_SA(0, 0), a2, voffA);
            PG8_BAR; PG8_WAIT_L(0); PG8_MMA(1, 0, At, B0); PG8_BAR; PG8_SCHED;
            PG8_STAGE(PG8_SB(0, 1), b2 + hstep, voffB);
            PG8_WAIT_V(6); PG8_BAR; PG8_MMA(1, 1, At, B1); PG8_BAR;
            PG8_LDB(B0, 1, 0); PG8_SCHED; PG8_LDA(At, 1, 0); PG8_STAGE(PG8_SA(0, 1), a2 + hstep, voffA);
            PG8_WAIT_L(8); PG8_BAR; PG8_WAIT_L(0); PG8_MMA(0, 0, At, B0); PG8_BAR; PG8_SCHED;
            PG8_LDB(B1, 1, 1); PG8_STAGE(PG8_SB(1, 0), b3, voffB);
            PG8_BAR; PG8_WAIT_L(0); PG8_MMA(0, 1, At, B1); PG8_BAR;
            PG8_LDA(At, 1, 1); PG8_STAGE(PG8_SA(1, 0), a3, voffA);
            PG8_BAR; PG8_WAIT_L(0); PG8_MMA(1, 0, At, B0); PG8_BAR; PG8_SCHED;
            PG8_STAGE(PG8_SB(1, 1), b3 + hstep, voffB);
            PG8_WAIT_V(6); PG8_BAR; PG8_MMA(1, 1, At, B1); PG8_BAR;
            }
        }
        if constexpr (ALIGN_EPI) { if (wr == 0) PG8_BAR; }
        if constexpr (!Epi::AFTER_DRAIN) { E(acc, cur, wr, wc, fr, fq); S.done(cur); }
        if (!has_next) break;
#pragma unroll
        for (int a = 0; a < 2; ++a)
#pragma unroll
            for (int b = 0; b < 2; ++b)
#pragma unroll
                for (int m = 0; m < 4; ++m)
#pragma unroll
                    for (int n = 0; n < 2; ++n) acc[a][b][m][n] = (f32x4){0.f, 0.f, 0.f, 0.f};
        cur = nxt; cA = nA; cB = nB; ++ui;
        if constexpr (ALIGN_EPI) { if (wr == 1) PG8_BAR; }
    }
    PG8_WAIT_V(0);
    if constexpr (!ALIGN_EPI) { if (wr == 0) PG8_BAR; }
    PG8_BAR;
    if constexpr (Epi::AFTER_DRAIN) { E.fused(acc, cur, wr, wc, fr, fq, lds, wid, lane); S.done(cur); }
#undef PG8_SA
#undef PG8_SB
#undef PG8_STAGE
#undef PG8_LDA
#undef PG8_LDB
#undef PG8_MMA
#undef PG8_WAIT_V
#undef PG8_WAIT_L
#undef PG8_BAR
#undef PG8_SCHED
}
}
#define LAS __attribute__((address_space(3)))
typedef pg8::bf16_t bf16_t; typedef pg8::bf16x8 bf16x8; typedef pg8::f32x4 f32x4; typedef pg8::u32x4 u32x4;
typedef float f32x16 __attribute__((ext_vector_type(16)));
typedef unsigned u32x2 __attribute__((ext_vector_type(2)));
typedef float f32x2 __attribute__((ext_vector_type(2)));
using pg8::cvt_pk_bf16;

constexpr int T = 32768, D = 1024, SEQ = 16384, NL = 4, NPROJ = 2048, DFF = 2816, DUP = 5632, DPLE = 256;
constexpr float EPS = 1e-6f;
constexpr size_t WIN = 0, WDT = WIN + (size_t)2048 * 1024, WOUT = WDT + (size_t)16 * 1024, WUP = WOUT + (size_t)1024 * 1024, WDOWN = WUP + (size_t)5632 * 1024,
                 WGATE = WDOWN + (size_t)1024 * 2816, WPLE = WGATE + (size_t)1024 * 1024, WPOOL = WPLE + (size_t)1024 * 256, WLAYER = WPOOL + (size_t)4 * 128 * 128;
constexpr size_t OFF_HB0 = 0, OFF_HB1 = OFF_HB0 + (size_t)T * D * 2, OFF_WT = OFF_HB1 + (size_t)T * D * 2, OFF_R = OFF_WT + WLAYER * 2 * NL,
                 OFF_ST = OFF_R + (size_t)T * NPROJ * 2, OFF_MIX = OFF_R + (size_t)T * DFF * 2, OFF_TAIL = OFF_MIX + (size_t)512 * 2 * DUP * 4,
                 OFF_PB = OFF_MIX + (size_t)T * D * 2, OFF_SS = OFF_PB + (size_t)T * DPLE * 2, OFF_DT = OFF_SS + (size_t)2 * T * 16 * 4,
                 OFF_CD = OFF_DT + (size_t)T * 8 * 4, OFF_BAR = OFF_CD + 8192, WS_END = OFF_BAR + 16384;
static_assert(OFF_ST + (size_t)2 * 128 * 8 * 64 * 128 * 2 <= OFF_MIX, "states must fit behind proj");
static_assert(WS_END <= (size_t)512 * 1024 * 1024, "workspace");
constexpr int LDS_BYTES = 147456;
constexpr int PIT = 136;

struct Params {
    const float *x, *p, *mix_g, *w_in, *conv_w, *conv_b, *dt_bias, *a_log, *d_skip, *norm_g, *pool_w, *pool_scale, *w_out, *ffn_g, *w_up, *fconv_w, *fconv_b, *w_down,
        *ple_g, *w_gate, *w_ple, *final_g;
    float* out; unsigned char* ws;
};

__device__ __forceinline__ float bf_lo(unsigned u) { return __uint_as_float(u << 16); }
__device__ __forceinline__ float bf_hi(unsigned u) { return __uint_as_float(u & 0xffff0000u); }
__device__ __forceinline__ float bf2f(bf16_t b) { return __uint_as_float(((unsigned)b) << 16); }
__device__ __forceinline__ bf16_t f2bf(float f) { return (bf16_t)(cvt_pk_bf16(f, 0.f) & 0xffffu); }
__device__ __forceinline__ float fast_sigmoid(float v) { return __builtin_amdgcn_rcpf(1.f + __builtin_amdgcn_exp2f(-1.4426950409f * v)); }
__device__ __forceinline__ float silu_f(float v) { return v * fast_sigmoid(v); }
__device__ __forceinline__ float gelu_tanh(float v) { const float t = v * (1.f + 0.044715f * v * v); return v * __builtin_amdgcn_rcpf(1.f + __builtin_amdgcn_exp2f(-2.302208198f * t)); }
__device__ __forceinline__ float softplus_f(float v) { return v > 20.f ? v : log1pf(__expf(v)); }
__device__ __forceinline__ float wave_sum(float v) {
#pragma unroll
    for (int o = 1; o < 64; o <<= 1) v += __shfl_xor(v, o);
    return v;
}
template <int CTRL> __device__ __forceinline__ float dppf(float v) { return __builtin_bit_cast(float, __builtin_amdgcn_update_dpp(0, __builtin_bit_cast(int, v), CTRL, 0xf, 0xf, true)); }
__device__ __forceinline__ float row_rstd(const float* ss, int row) {
    const f32x4* p = (const f32x4*)(ss + (size_t)row * 16);
    const f32x4 a = p[0], b = p[1], c = p[2], d = p[3];
    const float s = ((a.x + a.y) + (a.z + a.w)) + ((b.x + b.y) + (b.z + b.w)) + ((c.x + c.y) + (c.z + c.w)) + ((d.x + d.y) + (d.z + d.w));
    return rsqrtf(s * (1.f / 1024.f) + EPS);
}
__device__ __forceinline__ float row_rstd_coop(const float* ss, int row, int fq) {
    const f32x4 a = *(const f32x4*)(ss + (size_t)row * 16 + 4 * fq);
    float s = (a.x + a.y) + (a.z + a.w);
    s += __shfl_xor(s, 16); s += __shfl_xor(s, 32);
    return rsqrtf(s * (1.f / 1024.f) + EPS);
}
__device__ __forceinline__ void rstd8(const float* ss, int rbase, int fq, float (&rs)[2][4]) {
    f32x4 a[2][4];
#pragma unroll
    for (int ai = 0; ai < 2; ++ai)
#pragma unroll
        for (int m = 0; m < 4; ++m) a[ai][m] = *(const f32x4*)(ss + (size_t)(rbase + ai * 128 + m * 16) * 16 + 4 * fq);
#pragma unroll
    for (int ai = 0; ai < 2; ++ai)
#pragma unroll
        for (int m = 0; m < 4; ++m) { float s = (a[ai][m].x + a[ai][m].y) + (a[ai][m].z + a[ai][m].w); s += __shfl_xor(s, 16); s += __shfl_xor(s, 32); rs[ai][m] = rsqrtf(s * (1.f / 1024.f) + EPS); }
}
#define LDS_FENCE() asm volatile("s_waitcnt lgkmcnt(0)" ::: "memory")

struct EpiIn {
    static constexpr bool PERM = true, AFTER_DRAIN = false;
    bf16_t* O; const float* ss;
    __device__ __forceinline__ void operator()(const f32x4 (&acc)[2][2][4][2], const pg8::Unit& u, int wr, int wc, int fr, int fq) const {
        const int col0 = u.pn * 256 + wc * 32 + 8 * fq, rbase = u.pm * 256 + wr * 64 + fr;
        float rs[2][4]; rstd8(ss, rbase, fq, rs);
#pragma unroll
        for (int ai = 0; ai < 2; ++ai)
#pragma unroll
            for (int m = 0; m < 4; ++m) {
                const int row = rbase + ai * 128 + m * 16; const float r1 = rs[ai][m];
                bf16_t* rowp = O + (size_t)row * NPROJ + col0;
#pragma unroll
                for (int bj = 0; bj < 2; ++bj) { const f32x4 v0 = acc[ai][bj][m][0] * r1, v1 = acc[ai][bj][m][1] * r1;
                    u32x4 w; w.x = cvt_pk_bf16(v0[0], v0[1]); w.y = cvt_pk_bf16(v0[2], v0[3]); w.z = cvt_pk_bf16(v1[0], v1[1]); w.w = cvt_pk_bf16(v1[2], v1[3]);
                    *(u32x4*)(rowp + bj * 128) = w; } }
    }
};
struct EpiQ {
    static constexpr bool PERM = true, AFTER_DRAIN = false;
    bf16_t* O;
    __device__ __forceinline__ void operator()(const f32x4 (&acc)[2][2][4][2], const pg8::Unit& u, int wr, int wc, int fr, int fq) const {
        const int col0 = u.pn * 256 + wc * 32 + 8 * fq;
#pragma unroll
        for (int ai = 0; ai < 2; ++ai)
#pragma unroll
            for (int m = 0; m < 4; ++m) {
                const int row = u.pm * 256 + ai * 128 + wr * 64 + m * 16 + fr; bf16_t* rowp = O + (size_t)row * D + col0;
#pragma unroll
                for (int bj = 0; bj < 2; ++bj) { const f32x4 v0 = acc[ai][bj][m][0], v1 = acc[ai][bj][m][1];
                    u32x4 w; w.x = cvt_pk_bf16(v0[0], v0[1]); w.y = cvt_pk_bf16(v0[2], v0[3]); w.z = cvt_pk_bf16(v1[0], v1[1]); w.w = cvt_pk_bf16(v1[2], v1[3]);
                    *(u32x4*)(rowp + bj * 128) = w; } }
    }
};
template <bool GATE> struct EpiRes {
    static constexpr bool PERM = false, AFTER_DRAIN = false;
    const bf16_t* rin; bf16_t* hb; float* ssw; const float* ssr; const bf16_t* q;
    __device__ __forceinline__ void operator()(const f32x4 (&acc)[2][2][4][2], const pg8::Unit& u, int wr, int wc, int fr, int fq) const {
        constexpr int MB = GATE ? 2 : 4;
        const int col0 = u.pn * 256 + wc * 32 + 4 * fq, rbase = u.pm * 256 + wr * 64 + fr;
        float rs[2][4];
        if (GATE) rstd8(ssr, rbase, fq, rs);
#pragma unroll
        for (int ai = 0; ai < 2; ++ai)
#pragma unroll
            for (int mb = 0; mb < 4; mb += MB) {
                u32x2 hv[MB][4], qv[MB][4];
#pragma unroll
                for (int mm = 0; mm < MB; ++mm)
#pragma unroll
                    for (int c = 0; c < 4; ++c) { const size_t off = (size_t)(rbase + ai * 128 + (mb + mm) * 16) * D + col0 + (c >> 1) * 128 + (c & 1) * 16;
                        hv[mm][c] = *(const u32x2*)(rin + off); if (GATE) qv[mm][c] = *(const u32x2*)(q + off); }
#pragma unroll
                for (int mm = 0; mm < MB; ++mm) { const int m = mb + mm, row = rbase + ai * 128 + m * 16; float sq = 0.f;
#pragma unroll
                    for (int c = 0; c < 4; ++c) { const size_t off = (size_t)row * D + col0 + (c >> 1) * 128 + (c & 1) * 16;
                        const u32x2 hh = hv[mm][c]; f32x4 v = {bf_lo(hh.x), bf_hi(hh.x), bf_lo(hh.y), bf_hi(hh.y)}; const f32x4 a = acc[ai][c >> 1][m][c & 1];
                        if (GATE) { const float r1 = rs[ai][m]; const u32x2 qq = qv[mm][c];
                            v[0] += bf_lo(qq.x) * fast_sigmoid(a[0] * r1); v[1] += bf_hi(qq.x) * fast_sigmoid(a[1] * r1);
                            v[2] += bf_lo(qq.y) * fast_sigmoid(a[2] * r1); v[3] += bf_hi(qq.y) * fast_sigmoid(a[3] * r1); }
                        else v += a;
                        u32x2 w; w.x = cvt_pk_bf16(v[0], v[1]); w.y = cvt_pk_bf16(v[2], v[3]); *(u32x2*)(hb + off) = w;
                        const float r0 = bf_lo(w.x), r1v = bf_hi(w.x), r2 = bf_lo(w.y), r3 = bf_hi(w.y);
                        sq += (r0 * r0 + r1v * r1v) + (r2 * r2 + r3 * r3); }
                    sq += __shfl_xor(sq, 16); sq += __shfl_xor(sq, 32);
                    if (fq == 0) ssw[(size_t)row * 16 + u.pn * 4 + wc] = sq; } }
    }
};
struct UpOrder : pg8::StaticOrder {
    const float* cw; const float* cb; LAS float* pbuf; mutable int na;
    __device__ __forceinline__ void a_ready(const pg8::Unit& u) const {
        const int t = threadIdx.x, qd = t >> 6, c = 2 * (t & 63);
        const float* src = ((qd & 3) == 3 ? cb : cw + (size_t)(qd & 3) * DUP) + (qd >> 2) * DFF + u.pn * 128 + c;
        const f32x2 v = *(const f32x2*)src;
        *(LAS f32x2*)(pbuf + (na & 1) * 1024 + qd * 128 + c) = v;
        ++na;
    }
};
struct EpiUp {
    static constexpr bool PERM = true, AFTER_DRAIN = false;
    bf16_t* act; const float* ss; const LAS float* pbuf; float* head; float* tail; mutable int ne;
    __device__ __forceinline__ void operator()(const f32x4 (&acc)[2][2][4][2], const pg8::Unit& u, int wr, int wc, int fr, int fq) const {
        const LAS float* pp = pbuf + (ne & 1) * 1024 + wc * 32 + 8 * fq; ++ne;
        const int jg0 = u.pn * 128 + wc * 32 + 8 * fq, rb0 = u.pm * 256 + wr * 64 + fr;
        float rs[2][4]; rstd8(ss, rb0, fq, rs);
#pragma unroll
        for (int ai = 0; ai < 2; ++ai) {
            const int rbase = rb0 + ai * 128, strip = u.pm * 4 + ai * 2 + wr;
            unsigned ow[4][4];
#pragma unroll
            for (int nj = 0; nj < 4; ++nj) {
                const int n = nj >> 1, j0 = 2 * (nj & 1), cl = 4 * n + j0, jg = jg0 + cl;
                const f32x2 w0g = *(const LAS f32x2*)(pp + cl), w1g = *(const LAS f32x2*)(pp + 128 + cl), w2g = *(const LAS f32x2*)(pp + 256 + cl), bg = *(const LAS f32x2*)(pp + 384 + cl);
                const f32x2 w0v = *(const LAS f32x2*)(pp + 512 + cl), w1v = *(const LAS f32x2*)(pp + 640 + cl), w2v = *(const LAS f32x2*)(pp + 768 + cl), bv = *(const LAS f32x2*)(pp + 896 + cl);
                f32x2 pg = {0.f, 0.f}, pv = {0.f, 0.f};
#pragma unroll
                for (int m = 0; m < 4; ++m) {
                    const float r1 = rs[ai][m];
                    const f32x2 xg = {acc[ai][0][m][n][j0] * r1, acc[ai][0][m][n][j0 + 1] * r1}, xv = {acc[ai][1][m][n][j0] * r1, acc[ai][1][m][n][j0 + 1] * r1};
                    if (m == 0 && fr < 2) { float* hp = head + ((size_t)(strip * 2 + fr)) * DUP + jg; *(f32x2*)hp = xg; *(f32x2*)(hp + DFF) = xv; }
                    if (m == 3 && fr >= 14) { float* tp = tail + ((size_t)(strip * 2 + fr - 14)) * DUP + jg; *(f32x2*)tp = xg; *(f32x2*)(tp + DFF) = xv; }
                    float o[2];
#pragma unroll
                    for (int j = 0; j < 2; ++j) {
                        const float g1 = dppf<0x111>(xg[j]) + dppf<0x10F>(pg[j]), g2 = dppf<0x112>(xg[j]) + dppf<0x10E>(pg[j]);
                        const float v1 = dppf<0x111>(xv[j]) + dppf<0x10F>(pv[j]), v2 = dppf<0x112>(xv[j]) + dppf<0x10E>(pv[j]);
                        const float cgv = bg[j] + w0g[j] * g2 + w1g[j] * g1 + w2g[j] * xg[j];
                        const float cvv = bv[j] + w0v[j] * v2 + w1v[j] * v1 + w2v[j] * xv[j];
                        o[j] = gelu_tanh(cgv) * cvv; }
                    ow[m][nj] = cvt_pk_bf16(o[0], o[1]);
                    pg = xg; pv = xv; } }
#pragma unroll
            for (int m = 0; m < 4; ++m)
                if (!(m == 0 && fr < 2)) { u32x4 w; w.x = ow[m][0]; w.y = ow[m][1]; w.z = ow[m][2]; w.w = ow[m][3]; *(u32x4*)(act + (size_t)(rbase + 16 * m) * DFF + jg0) = w; } }
    }
};
__device__ __forceinline__ void tr_item(const float* W, int ldw, bf16_t* WT, int Kd, int k0, int n0, int sc0, const float* kscale, const float* nscale, LAS float* scr, int lane) {
#pragma unroll 8
    for (int i = 0; i < 32; ++i) { const int kk = 2 * i + (lane >> 5); float v = W[(size_t)(k0 + kk) * ldw + sc0 + (lane & 31)]; if (kscale) v *= kscale[k0 + kk]; scr[kk * 33 + (lane & 31)] = v; }
    LDS_FENCE();
    const int c = lane & 7;
#pragma unroll
    for (int j = 0; j < 4; ++j) { const int n = (lane >> 3) + 8 * j; const LAS float* s = scr + (8 * c) * 33 + n; const float ns = nscale ? nscale[sc0 + n] : 1.f;
        u32x4 o; o.x = cvt_pk_bf16(s[0] * ns, s[33] * ns); o.y = cvt_pk_bf16(s[2 * 33] * ns, s[3 * 33] * ns); o.z = cvt_pk_bf16(s[4 * 33] * ns, s[5 * 33] * ns); o.w = cvt_pk_bf16(s[6 * 33] * ns, s[7 * 33] * ns);
        *(u32x4*)(WT + (size_t)(n0 + n) * Kd + k0 + 8 * c) = o; }
    LDS_FENCE();
}
__device__ __forceinline__ void phase0(const Params& P, LAS unsigned char* lds, int G, int bid) {
    int tid_ = threadIdx.x; asm volatile("" : "+v"(tid_)); const int tid = tid_, lane = tid & 63, wave = tid >> 6;
    bf16_t* wt = (bf16_t*)(P.ws + OFF_WT);
    LAS float* scr = (LAS float*)(lds + wave * 8704);
    const int gw = bid * 8 + wave, NGW = G * 8;
    constexpr int IPL = 1024 + 512 + 2816 + 1408 + 512 + 128 + 32;
    for (int it = gw; it < NL * IPL; it += NGW) {
        const int l = it / IPL; int r = it % IPL;
        bf16_t* wl = wt + (size_t)l * WLAYER;
        const float* W; int ldw, Kd, kb, nb, sc0; bf16_t* WT; const float* ks = nullptr; const float* ns = nullptr;
        if (r < 1024) { W = P.w_in + (size_t)l * 1024 * 2056; ldw = 2056; Kd = 1024; WT = wl + WIN; ks = P.mix_g + l * 1024; kb = r / 64; nb = r % 64; sc0 = 32 * nb < 1536 ? 32 * nb : 32 * nb + 8; }
        else if ((r -= 1024) < 512) { W = P.w_out + (size_t)l * 1024 * 1024; ldw = 1024; Kd = 1024; WT = wl + WOUT; kb = r / 32; nb = r % 32; sc0 = 32 * nb; }
        else if ((r -= 512) < 2816) { W = P.w_up + (size_t)l * 1024 * DUP; ldw = DUP; Kd = 1024; WT = wl + WUP; ks = P.ffn_g + l * 1024; kb = r / 176; nb = r % 176;
            const int n0 = 32 * nb, pn = n0 >> 8, rr = n0 & 255; sc0 = rr < 128 ? 128 * pn + rr : DFF + 128 * pn + (rr - 128); }
        else if ((r -= 2816) < 1408) { W = P.w_down + (size_t)l * DFF * 1024; ldw = 1024; Kd = DFF; WT = wl + WDOWN; kb = r / 32; nb = r % 32; sc0 = 32 * nb; }
        else if ((r -= 1408) < 512) { W = P.w_gate + (size_t)l * 1024 * 1024; ldw = 1024; Kd = 1024; WT = wl + WGATE; ks = P.ple_g + l * 1024; kb = r / 32; nb = r % 32; sc0 = 32 * nb; }
        else if ((r -= 512) < 128) { W = P.w_ple + (size_t)l * DPLE * 1024; ldw = 1024; Kd = DPLE; WT = wl + WPLE; kb = r / 32; nb = r % 32; sc0 = 32 * nb; }
        else { r -= 128; const int gi = r >> 3, rr = r & 7; kb = rr >> 2; nb = rr & 3; W = P.pool_w + (size_t)(l * 4 + gi) * 128 * 128; ldw = 128; Kd = 128; WT = wl + WPOOL + gi * 128 * 128;
            ns = P.pool_scale + l * 512 + gi * 128; sc0 = 32 * nb; }
        tr_item(W, ldw, WT, Kd, 64 * kb, 32 * nb, sc0, ks, ns, scr, lane);
    }
    for (int idx = bid * 512 + tid; idx < NL * 16 * 1024; idx += G * 512) {
        const int l = idx >> 14, j = (idx >> 10) & 15, k = idx & 1023;
        const float v = j < 8 ? P.w_in[(size_t)l * 1024 * 2056 + (size_t)k * 2056 + 1536 + j] * P.mix_g[l * 1024 + k] : 0.f;
        wt[(size_t)l * WLAYER + WDT + j * 1024 + k] = f2bf(v);
    }
    bf16_t* hb0 = (bf16_t*)(P.ws + OFF_HB0); float* ss0 = (float*)(P.ws + OFF_SS);
    for (int row = gw; row < T; row += NGW) {
        const f32x4* xr = (const f32x4*)(P.x + (size_t)row * D) + lane; float s = 0.f;
#pragma unroll
        for (int j = 0; j < 4; ++j) { const f32x4 v = xr[64 * j]; s += (v.x * v.x + v.y * v.y) + (v.z * v.z + v.w * v.w);
            u32x2 w; w.x = cvt_pk_bf16(v.x, v.y); w.y = cvt_pk_bf16(v.z, v.w); *(u32x2*)(hb0 + (size_t)row * D + 4 * lane + 256 * j) = w; }
        s = wave_sum(s);
        if (lane < 16) ss0[(size_t)row * 16 + lane] = lane == 0 ? s : 0.f;
    }
}

#define MFMA32(a, b, c) __builtin_amdgcn_mfma_f32_32x32x16_bf16((a), (b), (c), 0, 0, 0)
__device__ __forceinline__ void conv8x2(const bf16_t* proj, long row0, int tl0, bool seqstart, int pcol, const float* cw, const float* cb, int xch, float (&o0)[8], float (&o1)[8]) {
    unsigned v[11];
#pragma unroll
    for (int i = 0; i < 11; ++i) { const int tl = tl0 - 3 + i; v[i] = (tl >= 0 || !seqstart) ? *(const unsigned*)(proj + (size_t)(row0 + tl) * NPROJ + pcol) : 0u; }
    const f32x2 w0 = *(const f32x2*)(cw + xch), w1 = *(const f32x2*)(cw + 1024 + xch), w2 = *(const f32x2*)(cw + 2048 + xch), w3 = *(const f32x2*)(cw + 3072 + xch), bb = *(const f32x2*)(cb + xch);
#pragma unroll
    for (int i = 0; i < 8; ++i) {
        const float a = bb.x + w0.x * bf_lo(v[i]) + w1.x * bf_lo(v[i + 1]) + w2.x * bf_lo(v[i + 2]) + w3.x * bf_lo(v[i + 3]);
        const float b = bb.y + w0.y * bf_hi(v[i]) + w1.y * bf_hi(v[i + 1]) + w2.y * bf_hi(v[i + 2]) + w3.y * bf_hi(v[i + 3]);
        o0[i] = silu_f(a); o1[i] = silu_f(b); }
}
__device__ __forceinline__ float chunk_cumsum(LAS float* dtT, LAS float* acs, int wave, int lane, float Ah) {
    float last = 0.f;
    if (wave < 4) {
        const float a0 = dtT[wave * 128 + 2 * lane] * Ah, a1 = dtT[wave * 128 + 2 * lane + 1] * Ah; float v = a0 + a1;
#pragma unroll
        for (int o = 1; o < 64; o <<= 1) { const float t = __shfl_up(v, o); if (lane >= o) v += t; }
        acs[wave * 128 + 2 * lane] = v - a1; acs[wave * 128 + 2 * lane + 1] = v;
        last = __shfl(v, 63);
    }
    return last;
}
struct SsdCtx { const bf16_t* proj; const bf16_t* hb; const float* ss; const bf16_t* wdt; const float* cw; const float* cb; const float* dt_bias; const float* a_log; const float* d_skip; const float* norm_g;
                bf16_t* states; float* dtbuf; float* cdecay; bf16_t* mix; const bf16_t* pwt; };

__device__ __forceinline__ void ssd_s1_job(const SsdCtx& C, LAS unsigned char* lds, int b, int c, int g) {
    int tid_ = threadIdx.x; asm volatile("" : "+v"(tid_)); const int tid = tid_, lane = tid & 63, wave = tid >> 6;
    LAS bf16_t* XdT = (LAS bf16_t*)lds; LAS bf16_t* BT = (LAS bf16_t*)(lds + 256 * PIT * 2);
    LAS float* dtT = (LAS float*)(lds + 139264); LAS float* acs = dtT + 512;
    const long row0 = (long)b * SEQ + c * 128;
    {
        pg8::f32x4 acc = {0.f, 0.f, 0.f, 0.f};
        const bf16_t* ar = C.hb + (size_t)(row0 + 16 * wave + (lane & 15)) * D + 8 * (lane >> 4);
        const bf16_t* br = C.wdt + (size_t)(lane & 15) * D + 8 * (lane >> 4);
#pragma unroll 1
        for (int kb = 0; kb < 4; ++kb) {
            bf16x8 a[8], bb[8];
#pragma unroll
            for (int i = 0; i < 8; ++i) { a[i] = __builtin_nontemporal_load((const bf16x8*)(ar + 256 * kb + 32 * i)); bb[i] = *(const bf16x8*)(br + 256 * kb + 32 * i); }
#pragma unroll
            for (int i = 0; i < 8; ++i) acc = __builtin_amdgcn_mfma_f32_16x16x32_bf16(a[i], bb[i], acc, 0, 0, 0);
        }
        const int head = lane & 15;
        if (head >= 4 * g && head < 4 * g + 4) {
            const float bias = C.dt_bias[head];
#pragma unroll
            for (int rg = 0; rg < 4; ++rg) { const int tok = 16 * wave + 4 * (lane >> 4) + rg; const float rs = row_rstd(C.ss, (int)(row0 + tok));
                const float dt = softplus_f(acc[rg] * rs + bias); dtT[(head - 4 * g) * 128 + tok] = dt; C.dtbuf[(size_t)(row0 + tok) * 8 + head] = dt; } }
    }
    __syncthreads();
    {
        const float Ah = wave < 4 ? -__expf(C.a_log[4 * g + wave]) : 0.f;
        const float last = chunk_cumsum(dtT, acs, wave, lane, Ah);
        if (wave < 4 && lane == 0) C.cdecay[(size_t)(b * 128 + c) * 8 + 4 * g + wave] = __expf(last);
    }
    __syncthreads();
    for (int idx = tid; idx < 192 * 16; idx += 512) {
        const int cp = idx % 192, r = idx / 192; const bool isx = cp < 128;
        const int xch = isx ? g * 256 + 2 * cp : 512 + g * 128 + 2 * (cp - 128);
        float o0[8], o1[8];
        conv8x2(C.proj, row0, 8 * r, c == 0, 512 + xch, C.cw, C.cb, xch, o0, o1);
        if (isx) { const int hh = cp >> 5; const float al = acs[hh * 128 + 127];
#pragma unroll
            for (int i = 0; i < 8; ++i) { const float sc = dtT[hh * 128 + 8 * r + i] * __expf(al - acs[hh * 128 + 8 * r + i]); o0[i] *= sc; o1[i] *= sc; } }
        LAS bf16_t* dst = isx ? XdT + (2 * cp) * PIT + 8 * r : BT + (2 * (cp - 128)) * PIT + 8 * r;
        u32x4 w0, w1; w0.x = cvt_pk_bf16(o0[0], o0[1]); w0.y = cvt_pk_bf16(o0[2], o0[3]); w0.z = cvt_pk_bf16(o0[4], o0[5]); w0.w = cvt_pk_bf16(o0[6], o0[7]);
        w1.x = cvt_pk_bf16(o1[0], o1[1]); w1.y = cvt_pk_bf16(o1[2], o1[3]); w1.z = cvt_pk_bf16(o1[4], o1[5]); w1.w = cvt_pk_bf16(o1[6], o1[7]);
        *(LAS u32x4*)dst = w0; *(LAS u32x4*)(dst + PIT) = w1;
    }
    __syncthreads();
    {
        const int hh = wave >> 1, nh = wave & 1, r = lane & 31, hq = lane >> 5;
        f32x16 acc[2][2];
#pragma unroll
        for (int i = 0; i < 2; ++i)
#pragma unroll
            for (int j = 0; j < 2; ++j)
#pragma unroll
                for (int e = 0; e < 16; ++e) acc[i][j][e] = 0.f;
#pragma unroll 2
        for (int ks = 0; ks < 8; ++ks) {
            bf16x8 a[2], bb[2];
#pragma unroll
            for (int i = 0; i < 2; ++i) { a[i] = *(const LAS bf16x8*)(XdT + (64 * hh + 32 * i + r) * PIT + 16 * ks + 8 * hq); bb[i] = *(const LAS bf16x8*)(BT + (64 * nh + 32 * i + r) * PIT + 16 * ks + 8 * hq); }
#pragma unroll
            for (int i = 0; i < 2; ++i)
#pragma unroll
                for (int j = 0; j < 2; ++j) acc[i][j] = MFMA32(a[i], bb[j], acc[i][j]);
        }
        bf16_t* st = C.states + ((size_t)(b * 128 + c) * 8 + 4 * g + hh) * 64 * 128;
#pragma unroll
        for (int i = 0; i < 2; ++i)
#pragma unroll
            for (int j = 0; j < 2; ++j)
#pragma unroll
                for (int e = 0; e < 16; ++e) { const int p = 32 * i + (e & 3) + 8 * (e >> 2) + 4 * hq, n = 64 * nh + 32 * j + r; st[p * 128 + n] = f2bf(acc[i][j][e]); }
    }
    __syncthreads();
}

template <int W> __device__ __forceinline__ void pool_fill(const bf16_t* proj, long row0, bool seqstart, int gi, LAS bf16_t* Pl, int tid) {
    const int cp = tid & 63, run = tid >> 6, pcol = 1536 + gi * 128 + 2 * cp;
    float u0[31], u1[31];
#pragma unroll
    for (int i = 0; i < 31; ++i) { const int tl = 16 * run - 15 + i; const unsigned v = (tl >= 0 || !seqstart) ? *(const unsigned*)(proj + (size_t)(row0 + tl) * NPROJ + pcol) : 0u; u0[i] = bf_lo(v); u1[i] = bf_hi(v); }
    float s0 = 0.f, s1 = 0.f;
#pragma unroll
    for (int j = 1; j < W; ++j) { s0 += u0[15 - j]; s1 += u1[15 - j]; }
#pragma unroll
    for (int i = 0; i < 16; ++i) {
        s0 += u0[15 + i]; s1 += u1[15 + i];
        const int tl = 16 * run + i; const float dv = seqstart ? (float)(tl + 1 < W ? tl + 1 : W) : (float)W; const float inv = 1.f / dv;
        *(LAS unsigned*)(Pl + tl * PIT + 2 * cp) = cvt_pk_bf16(s0 * inv - u0[15 + i], s1 * inv - u1[15 + i]);
        s0 -= u0[15 + i - (W - 1)]; s1 -= u1[15 + i - (W - 1)];
    }
}
__device__ __forceinline__ void pool_job(const SsdCtx& C, LAS unsigned char* lds, int tb, int gi) {
    int tid_ = threadIdx.x; asm volatile("" : "+v"(tid_)); const int tid = tid_, lane = tid & 63, wave = tid >> 6;
    LAS bf16_t* Pl = (LAS bf16_t*)lds; LAS bf16_t* Wp = (LAS bf16_t*)(lds + 128 * PIT * 2);
    const long row0 = (long)tb * 128; const bool seqstart = (tb & 127) == 0;
    for (int i = tid; i < 2048; i += 512) { const int d = i >> 4, c8 = i & 15; *(LAS u32x4*)(Wp + d * PIT + 8 * c8) = *(const u32x4*)(C.pwt + (size_t)gi * 16384 + d * 128 + 8 * c8); }
    if (gi == 0) pool_fill<2>(C.proj, row0, seqstart, gi, Pl, tid); else if (gi == 1) pool_fill<4>(C.proj, row0, seqstart, gi, Pl, tid);
    else if (gi == 2) pool_fill<8>(C.proj, row0, seqstart, gi, Pl, tid); else pool_fill<16>(C.proj, row0, seqstart, gi, Pl, tid);
    __syncthreads();
    {
        const int mi = wave >> 1, r = lane & 31, hq = lane >> 5;
        f32x16 acc[2];
#pragma unroll
        for (int j = 0; j < 2; ++j)
#pragma unroll
            for (int e = 0; e < 16; ++e) acc[j][e] = 0.f;
#pragma unroll 2
        for (int ks = 0; ks < 8; ++ks) {
            const bf16x8 a = *(const LAS bf16x8*)(Pl + (32 * mi + r) * PIT + 16 * ks + 8 * hq);
#pragma unroll
            for (int j = 0; j < 2; ++j) { const int ni = 2 * (wave & 1) + j; const bf16x8 bb = *(const LAS bf16x8*)(Wp + (32 * ni + r) * PIT + 16 * ks + 8 * hq); acc[j] = MFMA32(a, bb, acc[j]); }
        }
#pragma unroll
        for (int j = 0; j < 2; ++j) { const int ni = 2 * (wave & 1) + j;
#pragma unroll
            for (int e = 0; e < 16; ++e) { const int tl = 32 * mi + (e & 3) + 8 * (e >> 2) + 4 * hq; C.mix[(size_t)(row0 + tl) * D + 512 + gi * 128 + 32 * ni + r] = f2bf(acc[j][e]); } }
    }
    __syncthreads();
}

__device__ __forceinline__ void scan_phase(bf16_t* states, const float* cdecay, int G, int bid) {
    int tid_ = threadIdx.x; asm volatile("" : "+v"(tid_));
    for (int idx = bid * 512 + tid_; idx < 2 * 8 * 64 * 128; idx += G * 512) {
        const int n = idx & 127, p = (idx >> 7) & 63, h = (idx >> 13) & 7, b = idx >> 16;
        bf16_t* sp = states + ((size_t)b * 128 * 8 + h) * 8192 + p * 128 + n; const float* dp = cdecay + (size_t)b * 128 * 8 + h;
        float s = 0.f;
        for (int c0 = 0; c0 < 128; c0 += 16) {
            float v[16], d[16];
#pragma unroll
            for (int i = 0; i < 16; ++i) { v[i] = bf2f(sp[(size_t)(c0 + i) * 8 * 8192]); d[i] = dp[(c0 + i) * 8]; }
#pragma unroll
            for (int i = 0; i < 16; ++i) { sp[(size_t)(c0 + i) * 8 * 8192] = f2bf(s); s = s * d[i] + v[i]; }
        }
    }
}
__device__ __forceinline__ void ssd_s3_job(const SsdCtx& C, LAS unsigned char* lds, int b, int c, int g) {
    int tid_ = threadIdx.x; asm volatile("" : "+v"(tid_)); const int tid = tid_, lane = tid & 63, wave = tid >> 6;
    LAS bf16_t* Cn = (LAS bf16_t*)lds; LAS bf16_t* CBm = (LAS bf16_t*)(lds + 128 * PIT * 2); LAS bf16_t* Bn = (LAS bf16_t*)(lds + 256 * PIT * 2); LAS bf16_t* XT = Bn;
    LAS float* dtT = (LAS float*)(lds + 139264); LAS float* acs = dtT + 512; LAS float* red = dtT + 1024;
    const long row0 = (long)b * SEQ + c * 128;
    { const int tok = tid >> 2, hh = tid & 3; dtT[hh * 128 + tok] = C.dtbuf[(size_t)(row0 + tok) * 8 + 4 * g + hh]; }
    __syncthreads();
    { const float Ah = wave < 4 ? -__expf(C.a_log[4 * g + wave]) : 0.f; (void)chunk_cumsum(dtT, acs, wave, lane, Ah); }
    for (int idx = tid; idx < 128 * 16; idx += 512) {
        const int cp = idx & 127, r = idx >> 7; const bool isB = cp < 64;
        const int xch = isB ? 512 + g * 128 + 2 * cp : 768 + g * 128 + 2 * (cp - 64);
        float o0[8], o1[8];
        conv8x2(C.proj, row0, 8 * r, c == 0, 512 + xch, C.cw, C.cb, xch, o0, o1);
        LAS bf16_t* dst = (isB ? Bn + 2 * cp : Cn + 2 * (cp - 64)) + (8 * r) * PIT;
#pragma unroll
        for (int i = 0; i < 8; ++i) *(LAS unsigned*)(dst + i * PIT) = cvt_pk_bf16(o0[i], o1[i]);
    }
    __syncthreads();
    {
        const int mi = wave >> 1, r = lane & 31, hq = lane >> 5;
        f32x16 acc[2];
#pragma unroll
        for (int j = 0; j < 2; ++j)
#pragma unroll
            for (int e = 0; e < 16; ++e) acc[j][e] = 0.f;
#pragma unroll 2
        for (int ks = 0; ks < 8; ++ks) {
            const bf16x8 a = *(const LAS bf16x8*)(Cn + (32 * mi + r) * PIT + 16 * ks + 8 * hq);
#pragma unroll
            for (int j = 0; j < 2; ++j) { const int ni = 2 * (wave & 1) + j; const bf16x8 bb = *(const LAS bf16x8*)(Bn + (32 * ni + r) * PIT + 16 * ks + 8 * hq); acc[j] = MFMA32(a, bb, acc[j]); }
        }
#pragma unroll
        for (int j = 0; j < 2; ++j) { const int ni = 2 * (wave & 1) + j;
#pragma unroll
            for (int e = 0; e < 16; ++e) { const int l = 32 * mi + (e & 3) + 8 * (e >> 2) + 4 * hq; CBm[l * PIT + 32 * ni + r] = f2bf(acc[j][e]); } }
    }
    __syncthreads();
    for (int idx = tid; idx < 128 * 16; idx += 512) {
        const int cp = idx & 127, r = idx >> 7; const int xch = g * 256 + 2 * cp;
        float o0[8], o1[8];
        conv8x2(C.proj, row0, 8 * r, c == 0, 512 + xch, C.cw, C.cb, xch, o0, o1);
        LAS bf16_t* dst = XT + (2 * cp) * PIT + 8 * r;
        u32x4 w0, w1; w0.x = cvt_pk_bf16(o0[0], o0[1]); w0.y = cvt_pk_bf16(o0[2], o0[3]); w0.z = cvt_pk_bf16(o0[4], o0[5]); w0.w = cvt_pk_bf16(o0[6], o0[7]);
        w1.x = cvt_pk_bf16(o1[0], o1[1]); w1.y = cvt_pk_bf16(o1[2], o1[3]); w1.z = cvt_pk_bf16(o1[4], o1[5]); w1.w = cvt_pk_bf16(o1[6], o1[7]);
        *(LAS u32x4*)dst = w0; *(LAS u32x4*)(dst + PIT) = w1;
    }
    __syncthreads();
    const int hh = wave >> 1, lh = wave & 1, r = lane & 31, hq = lane >> 5, h = 4 * g + hh;
    f32x16 acc[2][2];
#pragma unroll
    for (int i = 0; i < 2; ++i)
#pragma unroll
        for (int j = 0; j < 2; ++j)
#pragma unroll
            for (int e = 0; e < 16; ++e) acc[i][j][e] = 0.f;
    {
        const bf16_t* pv = C.states + ((size_t)(b * 128 + c) * 8 + h) * 64 * 128;
#pragma unroll 2
        for (int ks = 0; ks < 8; ++ks) {
            bf16x8 a[2], bb[2];
#pragma unroll
            for (int i = 0; i < 2; ++i) { a[i] = *(const bf16x8*)(pv + (32 * i + r) * 128 + 16 * ks + 8 * hq); bb[i] = *(const LAS bf16x8*)(Cn + (64 * lh + 32 * i + r) * PIT + 16 * ks + 8 * hq); }
#pragma unroll
            for (int i = 0; i < 2; ++i)
#pragma unroll
                for (int j = 0; j < 2; ++j) acc[i][j] = MFMA32(a[i], bb[j], acc[i][j]);
        }
#pragma unroll
        for (int j = 0; j < 2; ++j) { const float el = __expf(acs[hh * 128 + 64 * lh + 32 * j + r]);
#pragma unroll
            for (int i = 0; i < 2; ++i)
#pragma unroll
                for (int e = 0; e < 16; ++e) acc[i][j][e] *= el; }
    }
#pragma unroll
    for (int li = 0; li < 2; ++li) {
        const int l = 64 * lh + 32 * li + r; const float al = acs[hh * 128 + l];
        const int nks = 4 * lh + 2 * li + 2;
        for (int ks = 0; ks < nks; ++ks) {
            const int s0 = 16 * ks + 8 * hq;
            const u32x4 cb = *(const LAS u32x4*)(CBm + l * PIT + s0);
            const f32x4 as0 = *(const LAS f32x4*)(acs + hh * 128 + s0), as1 = *(const LAS f32x4*)(acs + hh * 128 + s0 + 4);
            const f32x4 d0 = *(const LAS f32x4*)(dtT + hh * 128 + s0), d1 = *(const LAS f32x4*)(dtT + hh * 128 + s0 + 4);
            float m[8];
            m[0] = bf_lo(cb.x) * __expf(al - as0[0]) * d0[0]; m[1] = bf_hi(cb.x) * __expf(al - as0[1]) * d0[1];
            m[2] = bf_lo(cb.y) * __expf(al - as0[2]) * d0[2]; m[3] = bf_hi(cb.y) * __expf(al - as0[3]) * d0[3];
            m[4] = bf_lo(cb.z) * __expf(al - as1[0]) * d1[0]; m[5] = bf_hi(cb.z) * __expf(al - as1[1]) * d1[1];
            m[6] = bf_lo(cb.w) * __expf(al - as1[2]) * d1[2]; m[7] = bf_hi(cb.w) * __expf(al - as1[3]) * d1[3];
#pragma unroll
            for (int j = 0; j < 8; ++j) m[j] = (s0 + j <= l) ? m[j] : 0.f;
            u32x4 mw; mw.x = cvt_pk_bf16(m[0], m[1]); mw.y = cvt_pk_bf16(m[2], m[3]); mw.z = cvt_pk_bf16(m[4], m[5]); mw.w = cvt_pk_bf16(m[6], m[7]);
            const bf16x8 mf = __builtin_bit_cast(bf16x8, mw);
#pragma unroll
            for (int pi = 0; pi < 2; ++pi) { const bf16x8 a = *(const LAS bf16x8*)(XT + (64 * hh + 32 * pi + r) * PIT + s0); acc[pi][li] = MFMA32(a, mf, acc[pi][li]); }
        }
    }
    const float Dh = C.d_skip[h];
    float sq[2] = {0.f, 0.f};
#pragma unroll
    for (int li = 0; li < 2; ++li) { const int l = 64 * lh + 32 * li + r;
#pragma unroll
        for (int pi = 0; pi < 2; ++pi)
#pragma unroll
            for (int e4 = 0; e4 < 4; ++e4) { const int p0 = 32 * pi + 8 * e4 + 4 * hq;
                const u32x2 zz = *(const u32x2*)(C.proj + (size_t)(row0 + l) * NPROJ + g * 256 + hh * 64 + p0);
                const float zf[4] = {bf_lo(zz.x), bf_hi(zz.x), bf_lo(zz.y), bf_hi(zz.y)};
#pragma unroll
                for (int k = 0; k < 4; ++k) { const float xs = bf2f(XT[(64 * hh + p0 + k) * PIT + l]); float y = acc[pi][li][4 * e4 + k] + xs * Dh; y *= silu_f(zf[k]); acc[pi][li][4 * e4 + k] = y; sq[li] += y * y; } }
        sq[li] += __shfl_xor(sq[li], 32);
        if (hq == 0) red[hh * 128 + l] = sq[li]; }
    __syncthreads();
#pragma unroll
    for (int li = 0; li < 2; ++li) { const int l = 64 * lh + 32 * li + r;
        const float rstd = rsqrtf((red[l] + red[128 + l] + red[256 + l] + red[384 + l]) * (1.f / 256.f) + EPS);
#pragma unroll
        for (int pi = 0; pi < 2; ++pi)
#pragma unroll
            for (int e4 = 0; e4 < 4; ++e4) { const int p0 = 32 * pi + 8 * e4 + 4 * hq, ch = g * 256 + hh * 64 + p0;
                const f32x4 ng = *(const f32x4*)(C.norm_g + ch);
                u32x2 w; w.x = cvt_pk_bf16(acc[pi][li][4 * e4] * rstd * ng[0], acc[pi][li][4 * e4 + 1] * rstd * ng[1]); w.y = cvt_pk_bf16(acc[pi][li][4 * e4 + 2] * rstd * ng[2], acc[pi][li][4 * e4 + 3] * rstd * ng[3]);
                *(u32x2*)(C.mix + (size_t)(row0 + l) * D + ch) = w; } }
    __syncthreads();
}

__device__ __forceinline__ void fixup_phase(const Params& P, int l, bf16_t* act, const float* head, const float* tail, bf16_t* pb, int G, int bid) {
    const float* cw = P.fconv_w + (size_t)l * 3 * DUP; const float* cb = P.fconv_b + (size_t)l * DUP;
    int tid_ = threadIdx.x; asm volatile("" : "+v"(tid_)); const int gt = bid * 512 + tid_, NT = G * 512;
    for (int idx = gt; idx < 512 * DFF; idx += NT) {
        const int s = idx / DFF, j = idx % DFF; const bool first = (s & 255) == 0;
        float o[2];
        float cvals[2][2];
#pragma unroll
        for (int gv = 0; gv < 2; ++gv) { const int col = j + gv * DFF;
            const float tm2 = first ? 0.f : tail[(size_t)((s - 1) * 2) * DUP + col], tm1 = first ? 0.f : tail[(size_t)((s - 1) * 2 + 1) * DUP + col];
            const float h0 = head[(size_t)(s * 2) * DUP + col], h1 = head[(size_t)(s * 2 + 1) * DUP + col];
            const float w0 = cw[col], w1 = cw[DUP + col], w2 = cw[2 * DUP + col], bb = cb[col];
            cvals[gv][0] = bb + w0 * tm2 + w1 * tm1 + w2 * h0; cvals[gv][1] = bb + w0 * tm1 + w1 * h0 + w2 * h1; }
        o[0] = gelu_tanh(cvals[0][0]) * cvals[1][0]; o[1] = gelu_tanh(cvals[0][1]) * cvals[1][1];
        act[(size_t)(64 * s) * DFF + j] = f2bf(o[0]); act[(size_t)(64 * s + 1) * DFF + j] = f2bf(o[1]);
    }
    const f32x4* ps = (const f32x4*)(P.p + (size_t)l * T * DPLE);
    for (int idx = gt; idx < T * DPLE / 4; idx += NT) { const f32x4 v = ps[idx]; u32x2 w; w.x = cvt_pk_bf16(v.x, v.y); w.y = cvt_pk_bf16(v.z, v.w); *(u32x2*)(pb + (size_t)idx * 4) = w; }
}

#define XB_TMO      128
#define XB_XCNT(j)  (256  + 64 * (j))
#define XB_XSUB(j)  (1280 + 64 * (j))
#define XB_XGEN(j)  (2304 + 64 * (j))
#define XB_TOP      3328
#define XB_TOPGEN   3392
#define XCD_BAR_WORDS 3456
#define XB_SPIN_CAP (1u << 18)

__device__ __forceinline__ unsigned xb_ld(unsigned* p)              { return __hip_atomic_load(p, __ATOMIC_RELAXED, __HIP_MEMORY_SCOPE_AGENT); }
__device__ __forceinline__ unsigned xb_add(unsigned* p, unsigned v) { return __hip_atomic_fetch_add(p, v, __ATOMIC_RELAXED, __HIP_MEMORY_SCOPE_AGENT); }
__device__ __forceinline__ unsigned xb_xcc_id() { return (unsigned)__builtin_amdgcn_s_getreg((3 << 11) | 20) & 0xFu; }
#define XB_SPIN(cond, bar) do { unsigned _sp = 0; while (cond) { __builtin_amdgcn_s_sleep(1); \
    if ((++_sp & 255u) == 0u) { if (xb_ld(&(bar)[XB_TMO])) break; if (_sp > XB_SPIN_CAP) { atomicAdd(&(bar)[XB_TMO], 1u); break; } } } } while (0)

struct XcdBarrier {
    unsigned* bar; unsigned x;
    volatile LAS unsigned* st;
};

__device__ __forceinline__ XcdBarrier xcd_barrier_post(unsigned* bar, volatile LAS unsigned* st) {
    XcdBarrier b; b.bar = bar; b.x = xb_xcc_id(); b.st = st;
    if (threadIdx.x == 0) (void)xb_add(&bar[XB_XCNT(b.x)], 1u);
    return b;
}
__device__ __forceinline__ void xcd_barrier_complete(unsigned* bar, unsigned x, unsigned& nloc, unsigned& nx) {
    const unsigned G = gridDim.x * gridDim.y * gridDim.z;
    unsigned sum, cnt, mine, sp = 0u;
    for (;;) {
        sum = 0u; cnt = 0u; mine = 0u;
#pragma unroll
        for (unsigned j = 0; j < 16; ++j) { const unsigned c = xb_ld(&bar[XB_XCNT(j)]); sum += c; cnt += (c > 0u) ? 1u : 0u; mine = (j == x) ? c : mine; }
        if (sum == G) break;
        __builtin_amdgcn_s_sleep(1);
        if ((++sp & 255u) == 0u) { if (xb_ld(&bar[XB_TMO])) break; if (sp > XB_SPIN_CAP) { atomicAdd(&bar[XB_TMO], 1u); break; } }
    }
    nloc = mine > 0u ? mine : 1u; nx = cnt > 0u ? cnt : 1u;
}

__device__ __forceinline__ void xcd_barrier(const XcdBarrier& b) {
    asm volatile("s_waitcnt vmcnt(0)" ::: "memory");
    __syncthreads();
    if (threadIdx.x == 0) {
        unsigned* bar = b.bar;
        __builtin_amdgcn_s_waitcnt(0);
        unsigned nloc = b.st[0], nx = b.st[1];
        if (nloc == 0u) { xcd_barrier_complete(bar, b.x, nloc, nx); b.st[0] = nloc; b.st[1] = nx; }
        const unsigned old = xb_add(&bar[XB_XSUB(b.x)], 1u);
        const unsigned gen = old / nloc;
        if (old + 1u == (gen + 1u) * nloc) {
            __builtin_amdgcn_fence(__ATOMIC_RELEASE, "agent");
            asm volatile("s_waitcnt vmcnt(0)" ::: "memory");
            const unsigned og = xb_add(&bar[XB_TOP], 1u);
            const unsigned tg = og / nx;
            if (og + 1u == (tg + 1u) * nx) xb_add(&bar[XB_TOPGEN], 1u);
            else XB_SPIN(xb_ld(&bar[XB_TOPGEN]) == tg, bar);
            __builtin_amdgcn_fence(__ATOMIC_ACQUIRE, "agent");
            xb_add(&bar[XB_XGEN(b.x)], 1u);
            asm volatile("s_waitcnt vmcnt(0)" ::: "memory");
        } else {
            XB_SPIN(xb_ld(&bar[XB_XGEN(b.x)]) == gen, bar);
            __builtin_amdgcn_fence(__ATOMIC_ACQUIRE, "agent");
            asm volatile("s_waitcnt vmcnt(0)" ::: "memory");
        }
    }
    __syncthreads();
}


__global__ __launch_bounds__(512, 2) void hymba_fwd(Params P) {
    extern __shared__ __attribute__((aligned(16))) unsigned char shm[];
    LAS unsigned char* lds = (LAS unsigned char*)shm;
    cg::grid_group grid = cg::this_grid();
    const int G = (int)gridDim.x, bid = (int)blockIdx.x;
    bf16_t* hbuf[2] = {(bf16_t*)(P.ws + OFF_HB0), (bf16_t*)(P.ws + OFF_HB1)};
    float* ssbuf[2] = {(float*)(P.ws + OFF_SS), (float*)(P.ws + OFF_SS) + (size_t)T * 16};
    bf16_t* wt = (bf16_t*)(P.ws + OFF_WT);
    bf16_t* proj = (bf16_t*)(P.ws + OFF_R); bf16_t* act = proj; bf16_t* states = (bf16_t*)(P.ws + OFF_ST);
    bf16_t* mix = (bf16_t*)(P.ws + OFF_MIX); bf16_t* qb = mix; float* head = (float*)(P.ws + OFF_MIX); float* tail = (float*)(P.ws + OFF_TAIL);
    bf16_t* pb = (bf16_t*)(P.ws + OFF_PB); float* dtbuf = (float*)(P.ws + OFF_DT); float* cdecay = (float*)(P.ws + OFF_CD);
    pg8::StaticOrder S;
    volatile LAS unsigned* xst = (volatile LAS unsigned*)(lds + LDS_BYTES - 16);
    if (threadIdx.x == 0) { xst[0] = 0u; xst[1] = 0u; }
    __syncthreads();
    const XcdBarrier xb = xcd_barrier_post((unsigned*)(P.ws + OFF_BAR), xst);

    phase0(P, lds, G, bid);
    grid.sync();
    int cur = 0;
#pragma unroll 1
    for (int l = 0; l < NL; ++l) {
        const bf16_t* wl = wt + (size_t)l * WLAYER;
        bf16_t* hb = cur ? hbuf[1] : hbuf[0]; bf16_t* hbn = cur ? hbuf[0] : hbuf[1];
        float* ss = cur ? ssbuf[1] : ssbuf[0]; float* ssn = cur ? ssbuf[0] : ssbuf[1];
        { S.init(T, NPROJ, G, bid); EpiIn E{proj, ss}; pg8::gemm_phase<EpiIn, pg8::StaticOrder, true, true>(lds, pg8::Gemm{hb, wl + WIN, T, NPROJ, D}, S, E); }
        xcd_barrier(xb);
        SsdCtx C{proj, hb, ss, wl + WDT, P.conv_w + (size_t)l * 4 * 1024, P.conv_b + (size_t)l * 1024, P.dt_bias + l * 8, P.a_log + l * 8, P.d_skip + l * 8, P.norm_g + l * 512,
                 states, dtbuf, cdecay, mix, wl + WPOOL};
        for (int job = bid; job < 512 + 1024; job += G) {
            if (job < 512) ssd_s1_job(C, lds, job >> 8, (job >> 1) & 127, job & 1);
            else { const int j = job - 512; pool_job(C, lds, j >> 2, j & 3); }
        }
        xcd_barrier(xb);
        scan_phase(states, cdecay, G, bid);
        xcd_barrier(xb);
        for (int job = bid; job < 512; job += G) ssd_s3_job(C, lds, job >> 8, (job >> 1) & 127, job & 1);
        xcd_barrier(xb);
        { S.init(T, D, G, bid); EpiRes<false> E{hb, hb, ss, nullptr, nullptr}; pg8::gemm_phase<EpiRes<false>, pg8::StaticOrder, true, true>(lds, pg8::Gemm{mix, wl + WOUT, T, D, D}, S, E); }
        xcd_barrier(xb);
        { UpOrder SU; SU.init(T, DUP, G, bid); SU.cw = P.fconv_w + (size_t)l * 3 * DUP; SU.cb = P.fconv_b + (size_t)l * DUP; SU.pbuf = (LAS float*)(lds + 131072); SU.na = 0;
          EpiUp E{act, ss, (const LAS float*)(lds + 131072), head, tail, 0}; pg8::gemm_phase<EpiUp, UpOrder, true, true>(lds, pg8::Gemm{hb, wl + WUP, T, DUP, D}, SU, E); }
        xcd_barrier(xb);
        fixup_phase(P, l, act, head, tail, pb, G, bid);
        xcd_barrier(xb);
        { S.init(T, D, G, bid); EpiRes<false> E{hb, hb, ss, nullptr, nullptr}; pg8::gemm_phase<EpiRes<false>, pg8::StaticOrder, true, true>(lds, pg8::Gemm{act, wl + WDOWN, T, D, DFF}, S, E); }
        { S.init(T, D, G, bid); EpiQ E{qb}; pg8::gemm_phase<EpiQ, pg8::StaticOrder, true, true>(lds, pg8::Gemm{pb, wl + WPLE, T, D, DPLE}, S, E); }
        xcd_barrier(xb);
        { S.init(T, D, G, bid); EpiRes<true> E{hb, hbn, ssn, ss, qb}; pg8::gemm_phase<EpiRes<true>, pg8::StaticOrder, true, true>(lds, pg8::Gemm{hb, wl + WGATE, T, D, D}, S, E); }
        xcd_barrier(xb);
        cur ^= 1;
    }
    {
        const int lane = threadIdx.x & 63, wave = threadIdx.x >> 6;
        const float* ss = cur ? ssbuf[1] : ssbuf[0]; const bf16_t* hb = cur ? hbuf[1] : hbuf[0];
        for (int row = bid * 8 + wave; row < T; row += G * 8) {
            const float rs = row_rstd(ss, row); const u32x2* hr = (const u32x2*)(hb + (size_t)row * D) + lane; f32x4* xr = (f32x4*)(P.out + (size_t)row * D) + lane; const f32x4* gr = (const f32x4*)P.final_g + lane;
#pragma unroll
            for (int j = 0; j < 4; ++j) { const u32x2 hh = hr[64 * j]; const f32x4 gg = gr[64 * j]; f32x4 v = {bf_lo(hh.x), bf_hi(hh.x), bf_lo(hh.y), bf_hi(hh.y)}; v = v * rs * gg; xr[64 * j] = v; }
        }
    }
}

extern "C" void kernel_launch(void* const* d_in, const int* in_sizes, int n_in, void* d_out, int out_size, void* d_ws, size_t ws_size, hipStream_t stream) {
    static int grid = 0;
    if (grid == 0) {
        if (n_in != 22 || ws_size < WS_END) { fprintf(stderr, "kernel_launch: unexpected inputs (n_in %d, ws %zu, need %zu)\n", n_in, ws_size, (size_t)WS_END); grid = -1; return; }
        int dev = 0, cus = 0, per_cu = 0;
        (void)hipGetDevice(&dev); (void)hipDeviceGetAttribute(&cus, hipDeviceAttributeMultiprocessorCount, dev);
        if (hipFuncSetAttribute((const void*)hymba_fwd, hipFuncAttributeMaxDynamicSharedMemorySize, LDS_BYTES) != hipSuccess) { fprintf(stderr, "kernel_launch: hipFuncSetAttribute failed\n"); grid = -1; return; }
        if (hipOccupancyMaxActiveBlocksPerMultiprocessor(&per_cu, (const void*)hymba_fwd, 512, LDS_BYTES) != hipSuccess || per_cu < 1) { fprintf(stderr, "kernel_launch: occupancy query says %d blocks per CU\n", per_cu); per_cu = 1; }
        (void)hipGetLastError();
        grid = cus;
    }
    if (grid < 0) return;
    Params p{};
    const float** pp = (const float**)&p;
    for (int i = 0; i < 22; ++i) pp[i] = (const float*)d_in[i];
    p.out = (float*)d_out; p.ws = (unsigned char*)d_ws;
    if (hipMemsetAsync((char*)d_ws + OFF_BAR, 0, 16384, stream) != hipSuccess) { fprintf(stderr, "kernel_launch: memset failed\n"); return; }
    void* args[] = {&p};
    hipError_t e = hipLaunchCooperativeKernel((const void*)hymba_fwd, dim3(grid), dim3(512), args, LDS_BYTES, stream);
    if (e != hipSuccess) fprintf(stderr, "cooperative launch failed: %s (grid %d)\n", hipGetErrorString(e), grid);
}
```

```cpp
#include <hip/hip_runtime.h>
#include <hip/hip_cooperative_groups.h>
#include <cstdio>
#include <cstdint>
namespace cg = cooperative_groups;
namespace pg8 {
#define PG8_LAS __attribute__((address_space(3)))
typedef unsigned short bf16_t;
typedef short bf16x8 __attribute__((ext_vector_type(8)));
typedef float f32x4 __attribute__((ext_vector_type(4)));
typedef unsigned u32x4 __attribute__((ext_vector_type(4)));
constexpr int BM = 256, BK = 64, HALF = 128, HTB = HALF * BK * 2  , STAGE_BYTES = 8 * HTB, NXCD = 8, WGM = 8;

__host__ __device__ __forceinline__ int lds_byte(int r, int c) { const int st = (r >> 4) * 2 + (c >> 5), rr = r & 15, cc = c & 31, ob = rr * 64 + cc * 2; return st * 1024 + (ob ^ (((ob >> 9) & 1) << 5)); }
__host__ __device__ __forceinline__ void stage_rc(int b, int& R, int& C) { const int st = b / 1024, sb = b % 1024, swz = sb ^ (((sb >> 9) & 1) << 5); R = (st >> 1) * 16 + swz / 64; C = (st & 1) * 32 + (swz % 64) / 2; }
__host__ __device__ __forceinline__ int perm32(int rho) { const int n = rho >> 4, i = rho & 15; return 8 * (i >> 2) + 4 * n + (i & 3); }

struct Unit { int pm, pn; };
struct Gemm { const bf16_t* A; const bf16_t* Bt; int M, N, K; };

struct StaticOrder {
    int nM, nN, nwg, G, c;
    __host__ __device__ void init(int M, int N, int G_, int c_) { nM = M / BM; nN = N / BM; nwg = nM * nN; G = G_; c = c_; }
    __host__ __device__ bool next(int i, Unit& u) const {
        const long L = (long)i * G + c; if (L >= nwg) return false;
        int wgid = (int)L; { const int q = nwg / NXCD, r = nwg % NXCD, xcd = wgid % NXCD, off = wgid / NXCD; wgid = (xcd < r ? xcd * (q + 1) : r * (q + 1) + (xcd - r) * q) + off; }
        const int nig = WGM * nN, gid = wgid / nig, fm = gid * WGM, gsz = (nM - fm) < WGM ? (nM - fm) : WGM;
        u.pm = fm + ((wgid % nig) % gsz); u.pn = (wgid % nig) / gsz; return true;
    }
    __device__ __forceinline__ void a_ready(const Unit&) const {}
    __device__ __forceinline__ void done(const Unit&) const {}
};
__device__ __forceinline__ unsigned cvt_pk_bf16(float lo, float hi) { unsigned r; asm volatile("v_cvt_pk_bf16_f32 %0, %1, %2" : "=v"(r) : "v"(lo), "v"(hi)); return r; }

template <class Epi, class Sched, bool ALIGN_EPI = false, bool SP2 = false>
__device__ __forceinline__ void gemm_phase(PG8_LAS unsigned char* lds, const Gemm g, const Sched& S, const Epi& E) {
    int tid_ = threadIdx.x; asm volatile("" : "+v"(tid_));
    const int tid = tid_, wid = __builtin_amdgcn_readfirstlane(tid >> 6), lane = tid & 63, wr = wid >> 2, wc = wid & 3, fr = lane & 15, fq = lane >> 4;
    int K_ = g.K; asm volatile("" : "+s"(K_));
    const int K = K_, nt = K / BK;
    unsigned voffA[2], voffB[2];
#pragma unroll
    for (int i = 0; i < 2; ++i) { int R, C; stage_rc(tid * 16 + i * 8192, R, C); const int Rb = Epi::PERM ? ((R & ~31) + perm32(R & 31)) : R;
        voffA[i] = (unsigned)(R * K + C) * 2u; voffB[i] = (unsigned)(Rb * K + C) * 2u; }
    const size_t kstep = (size_t)(BK * 2);
    const size_t hstep = (size_t)HALF * K * 2;
    const size_t tstep = 2 * hstep;
    const unsigned ldsw = (unsigned)wid * 1024u;
    const int aoff = lds_byte(wr * 64 + fr, fq * 8), boff = lds_byte(wc * 32 + fr, fq * 8);
#define PG8_SA(b, h) (((b) * 2 + (h)) * HTB)
#define PG8_SB(b, h) ((4 + (b) * 2 + (h)) * HTB)
#define PG8_STAGE(bufoff, gbase, voff) do { _Pragma("unroll") for (int _i = 0; _i < 2; ++_i) \
        __builtin_amdgcn_global_load_lds((const unsigned*)((const char*)(gbase) + (voff)[_i]), (PG8_LAS unsigned*)(lds + (bufoff) + ldsw + _i * 8192), 16, 0, 0); } while (0)
#define PG8_LDA(dst, b, h) do { _Pragma("unroll") for (int m = 0; m < 4; ++m) _Pragma("unroll") for (int k = 0; k < 2; ++k) dst[m][k] = *(const PG8_LAS bf16x8*)(lds + PG8_SA(b, h) + aoff + m * 2048 + k * 1024); } while (0)
#define PG8_LDB(dst, b, h) do { _Pragma("unroll") for (int n = 0; n < 2; ++n) _Pragma("unroll") for (int k = 0; k < 2; ++k) dst[n][k] = *(const PG8_LAS bf16x8*)(lds + PG8_SB(b, h) + boff + n * 2048 + k * 1024); } while (0)
#define PG8_MMA(ai, bj, At, Bt) do { __builtin_amdgcn_s_setprio(1); _Pragma("unroll") for (int m = 0; m < 4; ++m) _Pragma("unroll") for (int n = 0; n < 2; ++n) _Pragma("unroll") for (int k = 0; k < 2; ++k) \
        acc[ai][bj][m][n] = __builtin_amdgcn_mfma_f32_16x16x32_bf16(Bt[n][k], At[m][k], acc[ai][bj][m][n], 0, 0, 0); __builtin_amdgcn_s_setprio(0); } while (0)
#define PG8_WAIT_V(n) asm volatile("s_waitcnt vmcnt(" #n ")" ::: "memory")
#define PG8_WAIT_L(n) asm volatile("s_waitcnt lgkmcnt(" #n ")" ::: "memory")
#define PG8_BAR __builtin_amdgcn_s_barrier()
#define PG8_SCHED __builtin_amdgcn_sched_barrier(0)
    Unit cur, nxt; int ui = 0;
    if (!S.next(0, cur)) return;
    f32x4 acc[2][2][4][2];
#pragma unroll
    for (int a = 0; a < 2; ++a)
#pragma unroll
        for (int b = 0; b < 2; ++b)
#pragma unroll
            for (int m = 0; m < 4; ++m)
#pragma unroll
                for (int n = 0; n < 2; ++n) acc[a][b][m][n] = (f32x4){0.f, 0.f, 0.f, 0.f};
    bf16x8 At[4][2], B0[2][2], B1[2][2];
    const char* cA = (const char*)g.A + (size_t)cur.pm * tstep; const char* cB = (const char*)g.Bt + (size_t)cur.pn * tstep;
    S.a_ready(cur);
    if constexpr (SP2) {
        PG8_STAGE(PG8_SB(0, 0), cB, voffB); PG8_STAGE(PG8_SB(0, 1), cB + hstep, voffB); PG8_STAGE(PG8_SA(0, 0), cA, voffA); PG8_STAGE(PG8_SA(0, 1), cA + hstep, voffA);
        if (wr == 1) PG8_BAR;
        PG8_WAIT_V(2); PG8_BAR;
        PG8_STAGE(PG8_SB(1, 0), cB + kstep, voffB); PG8_STAGE(PG8_SA(1, 0), cA + kstep, voffA); PG8_STAGE(PG8_SB(1, 1), cB + hstep + kstep, voffB);
        PG8_WAIT_V(6); PG8_BAR;
    } else {
        PG8_STAGE(PG8_SB(0, 0), cB, voffB); PG8_STAGE(PG8_SA(0, 0), cA, voffA); PG8_STAGE(PG8_SB(0, 1), cB + hstep, voffB); PG8_STAGE(PG8_SA(0, 1), cA + hstep, voffA);
        if (wr == 1) PG8_BAR;
        PG8_WAIT_V(4); PG8_BAR;
        PG8_STAGE(PG8_SB(1, 0), cB + kstep, voffB); PG8_STAGE(PG8_SA(1, 0), cA + kstep, voffA); PG8_STAGE(PG8_SB(1, 1), cB + hstep + kstep, voffB);
        PG8_WAIT_V(6); PG8_BAR;
    }
    for (;;) {
        const bool has_next = S.next(ui + 1, nxt);
        const char* nA = has_next ? (const char*)g.A + (size_t)nxt.pm * tstep : cA; const char* nB = has_next ? (const char*)g.Bt + (size_t)nxt.pn * tstep : cB;
        for (int t = 0; t < nt; t += 2) {
            const bool last = (t == nt - 2);
            const char* a1 = cA + (size_t)(t + 1) * kstep;
            const char* a2 = last ? nA : cA + (size_t)(t + 2) * kstep; const char* b2 = last ? nB : cB + (size_t)(t + 2) * kstep;
            const char* a3 = a2 + kstep; const char* b3 = b2 + kstep;
            if (last && has_next) S.a_ready(nxt);
            if constexpr (SP2) {
            PG8_LDB(B0, 0, 0); PG8_LDB(B1, 0, 1); PG8_SCHED; PG8_LDA(At, 0, 0); PG8_STAGE(PG8_SA(1, 1), a1 + hstep, voffA);
            PG8_WAIT_V(8); PG8_WAIT_L(0); PG8_BAR; PG8_MMA(0, 0, At, B0); PG8_MMA(0, 1, At, B1); PG8_BAR; PG8_SCHED;
            PG8_LDA(At, 0, 1); PG8_STAGE(PG8_SB(0, 0), b2, voffB); PG8_STAGE(PG8_SB(0, 1), b2 + hstep, voffB); PG8_STAGE(PG8_SA(0, 0), a2, voffA);
            PG8_WAIT_V(8); PG8_WAIT_L(0); PG8_BAR; PG8_MMA(1, 0, At, B0); PG8_MMA(1, 1, At, B1); PG8_BAR; PG8_SCHED;
            PG8_LDB(B0, 1, 0); PG8_LDB(B1, 1, 1); PG8_SCHED; PG8_LDA(At, 1, 0); PG8_STAGE(PG8_SA(0, 1), a2 + hstep, voffA);
            PG8_WAIT_V(8); PG8_WAIT_L(0); PG8_BAR; PG8_MMA(0, 0, At, B0); PG8_MMA(0, 1, At, B1); PG8_BAR; PG8_SCHED;
            PG8_LDA(At, 1, 1); PG8_STAGE(PG8_SB(1, 0), b3, voffB); PG8_STAGE(PG8_SB(1, 1), b3 + hstep, voffB); PG8_STAGE(PG8_SA(1, 0), a3, voffA);
            PG8_WAIT_V(8); PG8_WAIT_L(0); PG8_BAR; PG8_MMA(1, 0, At, B0); PG8_MMA(1, 1, At, B1); PG8_BAR; PG8_SCHED;
            } else {
            PG8_LDB(B0, 0, 0); PG8_SCHED; PG8_LDA(At, 0, 0); PG8_STAGE(PG8_SA(1, 1), a1 + hstep, voffA);
            PG8_WAIT_L(8); PG8_BAR; PG8_WAIT_L(0); PG8_MMA(0, 0, At, B0); PG8_BAR; PG8_SCHED;
            PG8_LDB(B1, 0, 1); PG8_STAGE(PG8_SB(0, 0), b2, voffB);
            PG8_BAR; PG8_WAIT_L(0); PG8_MMA(0, 1, At, B1); PG8_BAR;
            PG8_LDA(At, 0, 1); PG8_STAGE(PG8_SA(0, 0), a2, voffA);
            PG8_BAR; PG8_WAIT_L(0); PG8_MMA(1, 0, At, B0); PG8_BAR; PG8_SCHED;
            PG8_STAGE(PG8_SB(0, 1), b2 + hstep, voffB);
            PG8_WAIT_V(6); PG8_BAR; PG8_MMA(1, 1, At, B1); PG8_BAR;
            PG8_LDB(B0, 1, 0); PG8_SCHED; PG8_LDA(At, 1, 0); PG8_STAGE(PG8_SA(0, 1), a2 + hstep, voffA);
            PG8_WAIT_L(8); PG8_BAR; PG8_WAIT_L(0); PG8_MMA(0, 0, At, B0); PG8_BAR; PG8_SCHED;
            PG8_LDB(B1, 1, 1); PG8_STAGE(PG8_SB(1, 0), b3, voffB);
            PG8_BAR; PG8_WAIT_L(0); PG8_MMA(0, 1, At, B1); PG8_BAR;
            PG8_LDA(At, 1, 1); PG8_STAGE(PG8_SA(1, 0), a3, voffA);
            PG8_BAR; PG8_WAIT_L(0); PG8_MMA(1, 0, At, B0); PG8_BAR; PG8_SCHED;
            PG8_STAGE(PG8_SB(1, 1), b3 + hstep, voffB);
            PG8_WAIT_V(6); PG8_BAR; PG8_MMA(1, 1, At, B1); PG8_BAR;
            }
        }
        if constexpr (ALIGN_EPI) { if (wr == 0) PG8_BAR; }
        if constexpr (!Epi::AFTER_DRAIN) { E(acc, cur, wr, wc, fr, fq); S.done(cur); }
        if (!has_next) break;
#pragma unroll
        for (int a = 0; a < 2; ++a)
#pragma unroll
            for (int b = 0; b < 2; ++b)
#pragma unroll
                for (int m = 0; m < 4; ++m)
#pragma unroll
                    for (int n = 0; n < 2; ++n) acc[a][b][m][n] = (f32x4){0.f, 0.f, 0.f, 0.f};
        cur = nxt; cA = nA; cB = nB; ++ui;
        if constexpr (ALIGN_EPI) { if (wr == 1) PG8_BAR; }
    }
    PG8_WAIT_V(0);
    if constexpr (!ALIGN_EPI) { if (wr == 0) PG8_BAR; }
    PG8_BAR;
    if constexpr (Epi::AFTER_DRAIN) { E.fused(acc, cur, wr, wc, fr, fq, lds, wid, lane); S.done(cur); }
#undef PG8_SA
#undef PG8_SB
#undef PG8_STAGE
#undef PG8_LDA
#undef PG8_LDB
#undef PG8_MMA
#undef PG8_WAIT_V
#undef PG8_WAIT_L
#undef PG8_BAR
#undef PG8_SCHED
}
}
#define LAS __attribute__((address_space(3)))
typedef pg8::bf16_t bf16_t; typedef pg8::bf16x8 bf16x8; typedef pg8::f32x4 f32x4; typedef pg8::u32x4 u32x4;
typedef float f32x16 __attribute__((ext_vector_type(16)));
typedef unsigned u32x2 __attribute__((ext_vector_type(2)));
typedef float f32x2 __attribute__((ext_vector_type(2)));
using pg8::cvt_pk_bf16;

constexpr int T = 32768, D = 1024, SEQ = 16384, NL = 4, NPROJ = 2048, DFF = 2816, DUP = 5632, DPLE = 256;
constexpr float EPS = 1e-6f;
constexpr size_t WIN = 0, WDT = WIN + (size_t)2048 * 1024, WOUT = WDT + (size_t)16 * 1024, WUP = WOUT + (size_t)1024 * 1024, WDOWN = WUP + (size_t)5632 * 1024,
                 WGATE = WDOWN + (size_t)1024 * 2816, WPLE = WGATE + (size_t)1024 * 1024, WPOOL = WPLE + (size_t)1024 * 256, WLAYER = WPOOL + (size_t)4 * 128 * 128;
constexpr size_t OFF_HB0 = 0, OFF_HB1 = OFF_HB0 + (size_t)T * D * 2, OFF_WT = OFF_HB1 + (size_t)T * D * 2, OFF_R = OFF_WT + WLAYER * 2 * NL,
                 OFF_ST = OFF_R + (size_t)T * NPROJ * 2, OFF_MIX = OFF_R + (size_t)T * DFF * 2, OFF_TAIL = OFF_MIX + (size_t)512 * 2 * DUP * 4,
                 OFF_PB = OFF_MIX + (size_t)T * D * 2, OFF_SS = OFF_PB + (size_t)T * DPLE * 2, OFF_DT = OFF_SS + (size_t)2 * T * 16 * 4,
                 OFF_CD = OFF_DT + (size_t)T * 8 * 4, OFF_BAR = OFF_CD + 8192, WS_END = OFF_BAR + 16384;
static_assert(OFF_ST + (size_t)2 * 128 * 8 * 64 * 128 * 2 <= OFF_MIX, "states must fit behind proj");
static_assert(WS_END <= (size_t)512 * 1024 * 1024, "workspace");
constexpr int LDS_BYTES = 147456;
constexpr int PIT = 136;

struct Params {
    const float *x, *p, *mix_g, *w_in, *conv_w, *conv_b, *dt_bias, *a_log, *d_skip, *norm_g, *pool_w, *pool_scale, *w_out, *ffn_g, *w_up, *fconv_w, *fconv_b, *w_down,
        *ple_g, *w_gate, *w_ple, *final_g;
    float* out; unsigned char* ws;
};

__device__ __forceinline__ float bf_lo(unsigned u) { return __uint_as_float(u << 16); }
__device__ __forceinline__ float bf_hi(unsigned u) { return __uint_as_float(u & 0xffff0000u); }
__device__ __forceinline__ float bf2f(bf16_t b) { return __uint_as_float(((unsigned)b) << 16); }
__device__ __forceinline__ bf16_t f2bf(float f) { return (bf16_t)(cvt_pk_bf16(f, 0.f) & 0xffffu); }
__device__ __forceinline__ float fast_sigmoid(float v) { return __builtin_amdgcn_rcpf(1.f + __builtin_amdgcn_exp2f(-1.4426950409f * v)); }
__device__ __forceinline__ float silu_f(float v) { return v * fast_sigmoid(v); }
__device__ __forceinline__ float gelu_tanh(float v) { const float t = v * (1.f + 0.044715f * v * v); return v * __builtin_amdgcn_rcpf(1.f + __builtin_amdgcn_exp2f(-2.302208198f * t)); }
__device__ __forceinline__ float softplus_f(float v) { return v > 20.f ? v : log1pf(__expf(v)); }
__device__ __forceinline__ float wave_sum(float v) {
#pragma unroll
    for (int o = 1; o < 64; o <<= 1) v += __shfl_xor(v, o);
    return v;
}
template <int CTRL> __device__ __forceinline__ float dppf(float v) { return __builtin_bit_cast(float, __builtin_amdgcn_update_dpp(0, __builtin_bit_cast(int, v), CTRL, 0xf, 0xf, true)); }
__device__ __forceinline__ float row_rstd(const float* ss, int row) {
    const f32x4* p = (const f32x4*)(ss + (size_t)row * 16);
    const f32x4 a = p[0], b = p[1], c = p[2], d = p[3];
    const float s = ((a.x + a.y) + (a.z + a.w)) + ((b.x + b.y) + (b.z + b.w)) + ((c.x + c.y) + (c.z + c.w)) + ((d.x + d.y) + (d.z + d.w));
    return rsqrtf(s * (1.f / 1024.f) + EPS);
}
__device__ __forceinline__ float row_rstd_coop(const float* ss, int row, int fq) {
    const f32x4 a = *(const f32x4*)(ss + (size_t)row * 16 + 4 * fq);
    float s = (a.x + a.y) + (a.z + a.w);
    s += __shfl_xor(s, 16); s += __shfl_xor(s, 32);
    return rsqrtf(s * (1.f / 1024.f) + EPS);
}
__device__ __forceinline__ void rstd8(const float* ss, int rbase, int fq, float (&rs)[2][4]) {
    f32x4 a[2][4];
#pragma unroll
    for (int ai = 0; ai < 2; ++ai)
#pragma unroll
        for (int m = 0; m < 4; ++m) a[ai][m] = *(const f32x4*)(ss + (size_t)(rbase + ai * 128 + m * 16) * 16 + 4 * fq);
#pragma unroll
    for (int ai = 0; ai < 2; ++ai)
#pragma unroll
        for (int m = 0; m < 4; ++m) { float s = (a[ai][m].x + a[ai][m].y) + (a[ai][m].z + a[ai][m].w); s += __shfl_xor(s, 16); s += __shfl_xor(s, 32); rs[ai][m] = rsqrtf(s * (1.f / 1024.f) + EPS); }
}
__device__ __forceinline__ void rstd4(const float* ss, int rbase, int fq, float (&rs)[4]) {
    f32x4 a[4];
#pragma unroll
    for (int m = 0; m < 4; ++m) a[m] = *(const f32x4*)(ss + (size_t)(rbase + m * 16) * 16 + 4 * fq);
#pragma unroll
    for (int m = 0; m < 4; ++m) { float s = (a[m].x + a[m].y) + (a[m].z + a[m].w); s += __shfl_xor(s, 16); s += __shfl_xor(s, 32); rs[m] = rsqrtf(s * (1.f / 1024.f) + EPS); }
}
#define LDS_FENCE() asm volatile("s_waitcnt lgkmcnt(0)" ::: "memory")

struct EpiIn {
    static constexpr bool PERM = true, AFTER_DRAIN = false;
    bf16_t* O; const LAS float* rsbuf; mutable int ne;
    __device__ __forceinline__ void operator()(const f32x4 (&acc)[2][2][4][2], const pg8::Unit& u, int wr, int wc, int fr, int fq) const {
        const int col0 = u.pn * 256 + wc * 32 + 8 * fq, rbase = u.pm * 256 + wr * 64 + fr;
        const LAS float* rp = rsbuf + (ne & 1) * 256 + wr * 64 + fr; ++ne;
#pragma unroll
        for (int ai = 0; ai < 2; ++ai)
#pragma unroll
            for (int m = 0; m < 4; ++m) {
                const int row = rbase + ai * 128 + m * 16; const float r1 = rp[ai * 128 + m * 16];
                bf16_t* rowp = O + (size_t)row * NPROJ + col0;
#pragma unroll
                for (int bj = 0; bj < 2; ++bj) { const f32x4 v0 = acc[ai][bj][m][0] * r1, v1 = acc[ai][bj][m][1] * r1;
                    u32x4 w; w.x = cvt_pk_bf16(v0[0], v0[1]); w.y = cvt_pk_bf16(v0[2], v0[3]); w.z = cvt_pk_bf16(v1[0], v1[1]); w.w = cvt_pk_bf16(v1[2], v1[3]);
                    *(u32x4*)(rowp + bj * 128) = w; } }
    }
};
struct EpiQ {
    static constexpr bool PERM = true, AFTER_DRAIN = false;
    bf16_t* O;
    __device__ __forceinline__ void operator()(const f32x4 (&acc)[2][2][4][2], const pg8::Unit& u, int wr, int wc, int fr, int fq) const {
        const int col0 = u.pn * 256 + wc * 32 + 8 * fq;
#pragma unroll
        for (int ai = 0; ai < 2; ++ai)
#pragma unroll
            for (int m = 0; m < 4; ++m) {
                const int row = u.pm * 256 + ai * 128 + wr * 64 + m * 16 + fr; bf16_t* rowp = O + (size_t)row * D + col0;
#pragma unroll
                for (int bj = 0; bj < 2; ++bj) { const f32x4 v0 = acc[ai][bj][m][0], v1 = acc[ai][bj][m][1];
                    u32x4 w; w.x = cvt_pk_bf16(v0[0], v0[1]); w.y = cvt_pk_bf16(v0[2], v0[3]); w.z = cvt_pk_bf16(v1[0], v1[1]); w.w = cvt_pk_bf16(v1[2], v1[3]);
                    *(u32x4*)(rowp + bj * 128) = w; } }
    }
};
template <bool GATE> struct EpiRes {
    static constexpr bool PERM = false, AFTER_DRAIN = false;
    const bf16_t* rin; bf16_t* hb; float* ssw; const float* ssr; const bf16_t* q;
    __device__ __forceinline__ void operator()(const f32x4 (&acc)[2][2][4][2], const pg8::Unit& u, int wr, int wc, int fr, int fq) const {
        constexpr int MB = GATE ? 2 : 4;
        const int col0 = u.pn * 256 + wc * 32 + 4 * fq, rbase = u.pm * 256 + wr * 64 + fr;
        float rs[2][4];
        if (GATE) rstd8(ssr, rbase, fq, rs);
#pragma unroll
        for (int ai = 0; ai < 2; ++ai)
#pragma unroll
            for (int mb = 0; mb < 4; mb += MB) {
                u32x2 hv[MB][4], qv[MB][4];
#pragma unroll
                for (int mm = 0; mm < MB; ++mm)
#pragma unroll
                    for (int c = 0; c < 4; ++c) { const size_t off = (size_t)(rbase + ai * 128 + (mb + mm) * 16) * D + col0 + (c >> 1) * 128 + (c & 1) * 16;
                        hv[mm][c] = *(const u32x2*)(rin + off); if (GATE) qv[mm][c] = *(const u32x2*)(q + off); }
#pragma unroll
                for (int mm = 0; mm < MB; ++mm) { const int m = mb + mm, row = rbase + ai * 128 + m * 16; float sq = 0.f;
#pragma unroll
                    for (int c = 0; c < 4; ++c) { const size_t off = (size_t)row * D + col0 + (c >> 1) * 128 + (c & 1) * 16;
                        const u32x2 hh = hv[mm][c]; f32x4 v = {bf_lo(hh.x), bf_hi(hh.x), bf_lo(hh.y), bf_hi(hh.y)}; const f32x4 a = acc[ai][c >> 1][m][c & 1];
                        if (GATE) { const float r1 = rs[ai][m]; const u32x2 qq = qv[mm][c];
                            v[0] += bf_lo(qq.x) * fast_sigmoid(a[0] * r1); v[1] += bf_hi(qq.x) * fast_sigmoid(a[1] * r1);
                            v[2] += bf_lo(qq.y) * fast_sigmoid(a[2] * r1); v[3] += bf_hi(qq.y) * fast_sigmoid(a[3] * r1); }
                        else v += a;
                        u32x2 w; w.x = cvt_pk_bf16(v[0], v[1]); w.y = cvt_pk_bf16(v[2], v[3]); *(u32x2*)(hb + off) = w;
                        const float r0 = bf_lo(w.x), r1v = bf_hi(w.x), r2 = bf_lo(w.y), r3 = bf_hi(w.y);
                        sq += (r0 * r0 + r1v * r1v) + (r2 * r2 + r3 * r3); }
                    sq += __shfl_xor(sq, 16); sq += __shfl_xor(sq, 32);
                    if (fq == 0) ssw[(size_t)row * 16 + u.pn * 4 + wc] = sq; } }
    }
};
template <bool UP> struct RsOrder : pg8::StaticOrder {
    const float* ss; LAS float* rsbuf; const float* cw; const float* cb; LAS float* pbuf; mutable int na;
    __device__ __forceinline__ void a_ready(const pg8::Unit& u) const {
        int t = threadIdx.x; asm volatile("" : "+v"(t));
        const int par = na & 1; ++na;
        if (UP) { const int qd = t >> 6, c = 2 * (t & 63);
            const float* src = ((qd & 3) == 3 ? cb : cw + (size_t)(qd & 3) * DUP) + (qd >> 2) * DFF + u.pn * 128 + c;
            const f32x2 v = *(const f32x2*)src;
            *(LAS f32x2*)(pbuf + par * 1024 + qd * 128 + c) = v; }
        if (t < 256) { rsbuf[par * 256 + t] = row_rstd(ss, u.pm * 256 + t); }
    }
};
__device__ __forceinline__ f32x2 gelu_tanh2(f32x2 v) {
    const f32x2 t = v * (v * v * 0.044715f + 1.0f), a = t * (-2.302208198f);
    f32x2 e; e.x = __builtin_amdgcn_exp2f(a.x); e.y = __builtin_amdgcn_exp2f(a.y);
    const f32x2 d = e + 1.0f; f32x2 r; r.x = __builtin_amdgcn_rcpf(d.x); r.y = __builtin_amdgcn_rcpf(d.y);
    return v * r;
}
struct EpiUp {
    static constexpr bool PERM = true, AFTER_DRAIN = false;
    bf16_t* act; const LAS float* rsbuf; const LAS float* pbuf; float* head; float* tail; mutable int ne;
    __device__ __forceinline__ void operator()(const f32x4 (&acc)[2][2][4][2], const pg8::Unit& u, int wr, int wc, int fr, int fq) const {
        const LAS float* pp = pbuf + (ne & 1) * 1024 + wc * 32 + 8 * fq; const LAS float* rp = rsbuf + (ne & 1) * 256 + wr * 64 + fr; ++ne;
        const int jg0 = u.pn * 128 + wc * 32 + 8 * fq, rb0 = u.pm * 256 + wr * 64 + fr;
#pragma unroll
        for (int ai = 0; ai < 2; ++ai) {
            const int rbase = rb0 + ai * 128, strip = u.pm * 4 + ai * 2 + wr;
            float rs[4];
#pragma unroll
            for (int m = 0; m < 4; ++m) rs[m] = rp[ai * 128 + m * 16];
            unsigned ow[4][4];
#pragma unroll
            for (int nj = 0; nj < 4; ++nj) {
                const int n = nj >> 1, j0 = 2 * (nj & 1), cl = 4 * n + j0, jg = jg0 + cl;
                const f32x2 w0g = *(const LAS f32x2*)(pp + cl), w1g = *(const LAS f32x2*)(pp + 128 + cl), w2g = *(const LAS f32x2*)(pp + 256 + cl), bg = *(const LAS f32x2*)(pp + 384 + cl);
                const f32x2 w0v = *(const LAS f32x2*)(pp + 512 + cl), w1v = *(const LAS f32x2*)(pp + 640 + cl), w2v = *(const LAS f32x2*)(pp + 768 + cl), bv = *(const LAS f32x2*)(pp + 896 + cl);
                f32x2 pg = {0.f, 0.f}, pv = {0.f, 0.f};
#pragma unroll
                for (int m = 0; m < 4; ++m) {
                    const float r1 = rs[m];
                    const f32x2 ag = {acc[ai][0][m][n][j0], acc[ai][0][m][n][j0 + 1]}, av = {acc[ai][1][m][n][j0], acc[ai][1][m][n][j0 + 1]};
                    const f32x2 xg = ag * r1, xv = av * r1;
                    if (m == 0 && fr < 2) { float* hp = head + ((size_t)(strip * 2 + fr)) * DUP + jg; *(f32x2*)hp = xg; *(f32x2*)(hp + DFF) = xv; }
                    if (m == 3 && fr >= 14) { float* tp = tail + ((size_t)(strip * 2 + fr - 14)) * DUP + jg; *(f32x2*)tp = xg; *(f32x2*)(tp + DFF) = xv; }
                    f32x2 g1, g2, v1, v2;
                    g1.x = dppf<0x111>(xg.x) + dppf<0x10F>(pg.x); g1.y = dppf<0x111>(xg.y) + dppf<0x10F>(pg.y);
                    g2.x = dppf<0x112>(xg.x) + dppf<0x10E>(pg.x); g2.y = dppf<0x112>(xg.y) + dppf<0x10E>(pg.y);
                    v1.x = dppf<0x111>(xv.x) + dppf<0x10F>(pv.x); v1.y = dppf<0x111>(xv.y) + dppf<0x10F>(pv.y);
                    v2.x = dppf<0x112>(xv.x) + dppf<0x10E>(pv.x); v2.y = dppf<0x112>(xv.y) + dppf<0x10E>(pv.y);
                    const f32x2 cgv = w2g * xg + (w1g * g1 + (w0g * g2 + bg));
                    const f32x2 cvv = w2v * xv + (w1v * v1 + (w0v * v2 + bv));
                    const f32x2 o = gelu_tanh2(cgv) * cvv;
                    ow[m][nj] = cvt_pk_bf16(o.x, o.y);
                    pg = xg; pv = xv; } }
#pragma unroll
            for (int m = 0; m < 4; ++m)
                if (!(m == 0 && fr < 2)) { u32x4 w; w.x = ow[m][0]; w.y = ow[m][1]; w.z = ow[m][2]; w.w = ow[m][3]; *(u32x4*)(act + (size_t)(rbase + 16 * m) * DFF + jg0) = w; } }
    }
};
__device__ __forceinline__ void tr_item(const float* W, int ldw, bf16_t* WT, int Kd, int k0, int n0, int sc0, const float* kscale, const float* nscale, LAS float* scr, int lane) {
#pragma unroll
    for (int i = 0; i < 32; ++i) { const int kk = 2 * i + (lane >> 5); float v = W[(size_t)(k0 + kk) * ldw + sc0 + (lane & 31)]; if (kscale) v *= kscale[k0 + kk]; scr[kk * 33 + (lane & 31)] = v; }
    LDS_FENCE();
    const int c = lane & 7;
#pragma unroll
    for (int j = 0; j < 4; ++j) { const int n = (lane >> 3) + 8 * j; const LAS float* s = scr + (8 * c) * 33 + n; const float ns = nscale ? nscale[sc0 + n] : 1.f;
        u32x4 o; o.x = cvt_pk_bf16(s[0] * ns, s[33] * ns); o.y = cvt_pk_bf16(s[2 * 33] * ns, s[3 * 33] * ns); o.z = cvt_pk_bf16(s[4 * 33] * ns, s[5 * 33] * ns); o.w = cvt_pk_bf16(s[6 * 33] * ns, s[7 * 33] * ns);
        *(u32x4*)(WT + (size_t)(n0 + n) * Kd + k0 + 8 * c) = o; }
    LDS_FENCE();
}
__device__ __forceinline__ void phase0(const Params& P, LAS unsigned char* lds, int G, int bid) {
    int tid_ = threadIdx.x; asm volatile("" : "+v"(tid_)); const int tid = tid_, lane = tid & 63, wave = tid >> 6;
    bf16_t* wt = (bf16_t*)(P.ws + OFF_WT);
    LAS float* scr = (LAS float*)(lds + wave * 8704);
    const int gw = bid * 8 + wave, NGW = G * 8;
    constexpr int IPL = 1024 + 512 + 2816 + 1408 + 512 + 128 + 32;
    for (int it = gw; it < NL * IPL; it += NGW) {
        const int l = it / IPL; int r = it % IPL;
        bf16_t* wl = wt + (size_t)l * WLAYER;
        const float* W; int ldw, Kd, kb, nb, sc0; bf16_t* WT; const float* ks = nullptr; const float* ns = nullptr;
        if (r < 1024) { W = P.w_in + (size_t)l * 1024 * 2056; ldw = 2056; Kd = 1024; WT = wl + WIN; ks = P.mix_g + l * 1024; kb = r / 64; nb = r % 64; sc0 = 32 * nb < 1536 ? 32 * nb : 32 * nb + 8; }
        else if ((r -= 1024) < 512) { W = P.w_out + (size_t)l * 1024 * 1024; ldw = 1024; Kd = 1024; WT = wl + WOUT; kb = r / 32; nb = r % 32; sc0 = 32 * nb; }
        else if ((r -= 512) < 2816) { W = P.w_up + (size_t)l * 1024 * DUP; ldw = DUP; Kd = 1024; WT = wl + WUP; ks = P.ffn_g + l * 1024; kb = r / 176; nb = r % 176;
            const int n0 = 32 * nb, pn = n0 >> 8, rr = n0 & 255; sc0 = rr < 128 ? 128 * pn + rr : DFF + 128 * pn + (rr - 128); }
        else if ((r -= 2816) < 1408) { W = P.w_down + (size_t)l * DFF * 1024; ldw = 1024; Kd = DFF; WT = wl + WDOWN; kb = r / 32; nb = r % 32; sc0 = 32 * nb; }
        else if ((r -= 1408) < 512) { W = P.w_gate + (size_t)l * 1024 * 1024; ldw = 1024; Kd = 1024; WT = wl + WGATE; ks = P.ple_g + l * 1024; kb = r / 32; nb = r % 32; sc0 = 32 * nb; }
        else if ((r -= 512) < 128) { W = P.w_ple + (size_t)l * DPLE * 1024; ldw = 1024; Kd = DPLE; WT = wl + WPLE; kb = r / 32; nb = r % 32; sc0 = 32 * nb; }
        else { r -= 128; const int gi = r >> 3, rr = r & 7; kb = rr >> 2; nb = rr & 3; W = P.pool_w + (size_t)(l * 4 + gi) * 128 * 128; ldw = 128; Kd = 128; WT = wl + WPOOL + gi * 128 * 128;
            ns = P.pool_scale + l * 512 + gi * 128; sc0 = 32 * nb; }
        tr_item(W, ldw, WT, Kd, 64 * kb, 32 * nb, sc0, ks, ns, scr, lane);
    }
    for (int idx = bid * 512 + tid; idx < NL * 16 * 1024; idx += G * 512) {
        const int l = idx >> 14, j = (idx >> 10) & 15, k = idx & 1023;
        const float v = j < 8 ? P.w_in[(size_t)l * 1024 * 2056 + (size_t)k * 2056 + 1536 + j] * P.mix_g[l * 1024 + k] : 0.f;
        wt[(size_t)l * WLAYER + WDT + j * 1024 + k] = f2bf(v);
    }
    {
        const f32x4* ps = (const f32x4*)P.p; bf16_t* pb = (bf16_t*)P.out; const int NT = G * 512; constexpr int NV = NL * T * DPLE / 4;
        for (int idx = bid * 512 + tid; idx < NV; idx += 8 * NT) {
            f32x4 v[8];
#pragma unroll
            for (int k = 0; k < 8; ++k) if (idx + k * NT < NV) v[k] = __builtin_nontemporal_load(ps + idx + k * NT);
#pragma unroll
            for (int k = 0; k < 8; ++k) if (idx + k * NT < NV) { u32x2 w; w.x = cvt_pk_bf16(v[k].x, v[k].y); w.y = cvt_pk_bf16(v[k].z, v[k].w); *(u32x2*)(pb + (size_t)(idx + k * NT) * 4) = w; }
        }
    }
    bf16_t* hb0 = (bf16_t*)(P.ws + OFF_HB0); float* ss0 = (float*)(P.ws + OFF_SS);
    for (int row = gw; row < T; row += NGW) {
        const f32x4* xr = (const f32x4*)(P.x + (size_t)row * D) + lane; float s = 0.f;
#pragma unroll
        for (int j = 0; j < 4; ++j) { const f32x4 v = xr[64 * j]; s += (v.x * v.x + v.y * v.y) + (v.z * v.z + v.w * v.w);
            u32x2 w; w.x = cvt_pk_bf16(v.x, v.y); w.y = cvt_pk_bf16(v.z, v.w); *(u32x2*)(hb0 + (size_t)row * D + 4 * lane + 256 * j) = w; }
        s = wave_sum(s);
        if (lane < 16) ss0[(size_t)row * 16 + lane] = lane == 0 ? s : 0.f;
    }
}

#define MFMA32(a, b, c) __builtin_amdgcn_mfma_f32_32x32x16_bf16((a), (b), (c), 0, 0, 0)
__device__ __forceinline__ void conv_load(const bf16_t* proj, long row0, int tl0, bool seqstart, int pcol, unsigned (&v)[11]) {
#pragma unroll
    for (int i = 0; i < 11; ++i) { const int tl = tl0 - 3 + i; v[i] = (tl >= 0 || !seqstart) ? *(const unsigned*)(proj + (size_t)(row0 + tl) * NPROJ + pcol) : 0u; }
}
__device__ __forceinline__ void conv_apply(const unsigned (&v)[11], const float* cw, const float* cb, int xch, float (&o0)[8], float (&o1)[8]) {
    const f32x2 w0 = *(const f32x2*)(cw + xch), w1 = *(const f32x2*)(cw + 1024 + xch), w2 = *(const f32x2*)(cw + 2048 + xch), w3 = *(const f32x2*)(cw + 3072 + xch), bb = *(const f32x2*)(cb + xch);
#pragma unroll
    for (int i = 0; i < 8; ++i) {
        const float a = bb.x + w0.x * bf_lo(v[i]) + w1.x * bf_lo(v[i + 1]) + w2.x * bf_lo(v[i + 2]) + w3.x * bf_lo(v[i + 3]);
        const float b = bb.y + w0.y * bf_hi(v[i]) + w1.y * bf_hi(v[i + 1]) + w2.y * bf_hi(v[i + 2]) + w3.y * bf_hi(v[i + 3]);
        o0[i] = silu_f(a); o1[i] = silu_f(b); }
}
__device__ __forceinline__ float chunk_cumsum(LAS float* dtT, LAS float* acs, int wave, int lane, float Ah) {
    float last = 0.f;
    if (wave < 4) {
        const float a0 = dtT[wave * 128 + 2 * lane] * Ah, a1 = dtT[wave * 128 + 2 * lane + 1] * Ah; float v = a0 + a1;
#pragma unroll
        for (int o = 1; o < 64; o <<= 1) { const float t = __shfl_up(v, o); if (lane >= o) v += t; }
        acs[wave * 128 + 2 * lane] = v - a1; acs[wave * 128 + 2 * lane + 1] = v;
        last = __shfl(v, 63);
    }
    return last;
}
struct SsdCtx { const bf16_t* proj; const bf16_t* hb; const float* ss; const bf16_t* wdt; const float* cw; const float* cb; const float* dt_bias; const float* a_log; const float* d_skip; const float* norm_g;
                bf16_t* states; float* dtbuf; float* cdecay; bf16_t* mix; const bf16_t* pwt; };

__device__ __forceinline__ void ssd_s1_job(const SsdCtx& C, LAS unsigned char* lds, int b, int c, int g) {
    int tid_ = threadIdx.x; asm volatile("" : "+v"(tid_)); const int tid = tid_, lane = tid & 63, wave = tid >> 6;
    LAS bf16_t* XdT = (LAS bf16_t*)lds; LAS bf16_t* BT = (LAS bf16_t*)(lds + 256 * PIT * 2);
    LAS float* dtT = (LAS float*)(lds + 139264); LAS float* acs = dtT + 512;
    const long row0 = (long)b * SEQ + c * 128;
    {
        pg8::f32x4 acc = {0.f, 0.f, 0.f, 0.f};
        const bf16_t* ar = C.hb + (size_t)(row0 + 16 * wave + (lane & 15)) * D + 8 * (lane >> 4);
        const bf16_t* br = C.wdt + (size_t)(lane & 15) * D + 8 * (lane >> 4);
#pragma unroll 1
        for (int kb = 0; kb < 4; ++kb) {
            bf16x8 a[8], bb[8];
#pragma unroll
            for (int i = 0; i < 8; ++i) { a[i] = __builtin_nontemporal_load((const bf16x8*)(ar + 256 * kb + 32 * i)); bb[i] = *(const bf16x8*)(br + 256 * kb + 32 * i); }
#pragma unroll
            for (int i = 0; i < 8; ++i) acc = __builtin_amdgcn_mfma_f32_16x16x32_bf16(a[i], bb[i], acc, 0, 0, 0);
        }
        const int head = lane & 15;
        if (head >= 4 * g && head < 4 * g + 4) {
            const float bias = C.dt_bias[head];
#pragma unroll
            for (int rg = 0; rg < 4; ++rg) { const int tok = 16 * wave + 4 * (lane >> 4) + rg; const float rs = row_rstd(C.ss, (int)(row0 + tok));
                const float dt = softplus_f(acc[rg] * rs + bias); dtT[(head - 4 * g) * 128 + tok] = dt; C.dtbuf[(size_t)(row0 + tok) * 8 + head] = dt; } }
    }
    __syncthreads();
    {
        const float Ah = wave < 4 ? -__expf(C.a_log[4 * g + wave]) : 0.f;
        const float last = chunk_cumsum(dtT, acs, wave, lane, Ah);
        if (wave < 4 && lane == 0) C.cdecay[(size_t)(b * 128 + c) * 8 + 4 * g + wave] = __expf(last);
    }
    __syncthreads();
#pragma unroll 1
    for (int bt = 0; bt < 2; ++bt) {
        unsigned v[3][11];
#pragma unroll
        for (int k = 0; k < 3; ++k) { const int idx = tid + 512 * (3 * bt + k), cp = idx % 192, r = idx / 192; const int xch = cp < 128 ? g * 256 + 2 * cp : 512 + g * 128 + 2 * (cp - 128);
            conv_load(C.proj, row0, 8 * r, c == 0, 512 + xch, v[k]); }
#pragma unroll
        for (int k = 0; k < 3; ++k) { const int idx = tid + 512 * (3 * bt + k), cp = idx % 192, r = idx / 192; const bool isx = cp < 128;
            const int xch = isx ? g * 256 + 2 * cp : 512 + g * 128 + 2 * (cp - 128);
            float o0[8], o1[8];
            conv_apply(v[k], C.cw, C.cb, xch, o0, o1);
            if (isx) { const int hh = cp >> 5; const float al = acs[hh * 128 + 127];
#pragma unroll
                for (int i = 0; i < 8; ++i) { const float sc = dtT[hh * 128 + 8 * r + i] * __expf(al - acs[hh * 128 + 8 * r + i]); o0[i] *= sc; o1[i] *= sc; } }
            LAS bf16_t* dst = isx ? XdT + (2 * cp) * PIT + 8 * r : BT + (2 * (cp - 128)) * PIT + 8 * r;
            u32x4 w0, w1; w0.x = cvt_pk_bf16(o0[0], o0[1]); w0.y = cvt_pk_bf16(o0[2], o0[3]); w0.z = cvt_pk_bf16(o0[4], o0[5]); w0.w = cvt_pk_bf16(o0[6], o0[7]);
            w1.x = cvt_pk_bf16(o1[0], o1[1]); w1.y = cvt_pk_bf16(o1[2], o1[3]); w1.z = cvt_pk_bf16(o1[4], o1[5]); w1.w = cvt_pk_bf16(o1[6], o1[7]);
            *(LAS u32x4*)dst = w0; *(LAS u32x4*)(dst + PIT) = w1; }
    }
    __syncthreads();
    {
        const int hh = wave >> 1, nh = wave & 1, r = lane & 31, hq = lane >> 5;
        f32x16 acc[2][2];
#pragma unroll
        for (int i = 0; i < 2; ++i)
#pragma unroll
            for (int j = 0; j < 2; ++j)
#pragma unroll
                for (int e = 0; e < 16; ++e) acc[i][j][e] = 0.f;
#pragma unroll 2
        for (int ks = 0; ks < 8; ++ks) {
            bf16x8 a[2], bb[2];
#pragma unroll
            for (int i = 0; i < 2; ++i) { a[i] = *(const LAS bf16x8*)(XdT + (64 * hh + 32 * i + r) * PIT + 16 * ks + 8 * hq); bb[i] = *(const LAS bf16x8*)(BT + (64 * nh + 32 * i + r) * PIT + 16 * ks + 8 * hq); }
#pragma unroll
            for (int i = 0; i < 2; ++i)
#pragma unroll
                for (int j = 0; j < 2; ++j) acc[i][j] = MFMA32(a[i], bb[j], acc[i][j]);
        }
        bf16_t* st = C.states + ((size_t)(b * 128 + c) * 8 + 4 * g + hh) * 64 * 128;
#pragma unroll
        for (int i = 0; i < 2; ++i)
#pragma unroll
            for (int j = 0; j < 2; ++j)
#pragma unroll
                for (int e = 0; e < 16; ++e) { const int p = 32 * i + (e & 3) + 8 * (e >> 2) + 4 * hq, n = 64 * nh + 32 * j + r; st[p * 128 + n] = f2bf(acc[i][j][e]); }
    }
    __syncthreads();
}

template <int W> __device__ __forceinline__ void pool_fill(const bf16_t* proj, long row0, bool seqstart, int gi, LAS bf16_t* Pl, int tid) {
    const int cp = tid & 63, run = tid >> 6, pcol = 1536 + gi * 128 + 2 * cp;
    float u0[31], u1[31];
#pragma unroll
    for (int i = 0; i < 31; ++i) { const int tl = 16 * run - 15 + i; const unsigned v = (tl >= 0 || !seqstart) ? *(const unsigned*)(proj + (size_t)(row0 + tl) * NPROJ + pcol) : 0u; u0[i] = bf_lo(v); u1[i] = bf_hi(v); }
    float s0 = 0.f, s1 = 0.f;
#pragma unroll
    for (int j = 1; j < W; ++j) { s0 += u0[15 - j]; s1 += u1[15 - j]; }
#pragma unroll
    for (int i = 0; i < 16; ++i) {
        s0 += u0[15 + i]; s1 += u1[15 + i];
        const int tl = 16 * run + i; const float dv = seqstart ? (float)(tl + 1 < W ? tl + 1 : W) : (float)W; const float inv = 1.f / dv;
        *(LAS unsigned*)(Pl + tl * PIT + 2 * cp) = cvt_pk_bf16(s0 * inv - u0[15 + i], s1 * inv - u1[15 + i]);
        s0 -= u0[15 + i - (W - 1)]; s1 -= u1[15 + i - (W - 1)];
    }
}
__device__ __forceinline__ void pool_job(const SsdCtx& C, LAS unsigned char* lds, int tb, int gi) {
    int tid_ = threadIdx.x; asm volatile("" : "+v"(tid_)); const int tid = tid_, lane = tid & 63, wave = tid >> 6;
    LAS bf16_t* Pl = (LAS bf16_t*)lds; LAS bf16_t* Wp = (LAS bf16_t*)(lds + 128 * PIT * 2);
    const long row0 = (long)tb * 128; const bool seqstart = (tb & 127) == 0;
    for (int i = tid; i < 2048; i += 512) { const int d = i >> 4, c8 = i & 15; *(LAS u32x4*)(Wp + d * PIT + 8 * c8) = *(const u32x4*)(C.pwt + (size_t)gi * 16384 + d * 128 + 8 * c8); }
    if (gi == 0) pool_fill<2>(C.proj, row0, seqstart, gi, Pl, tid); else if (gi == 1) pool_fill<4>(C.proj, row0, seqstart, gi, Pl, tid);
    else if (gi == 2) pool_fill<8>(C.proj, row0, seqstart, gi, Pl, tid); else pool_fill<16>(C.proj, row0, seqstart, gi, Pl, tid);
    __syncthreads();
    {
        const int mi = wave >> 1, r = lane & 31, hq = lane >> 5;
        f32x16 acc[2];
#pragma unroll
        for (int j = 0; j < 2; ++j)
#pragma unroll
            for (int e = 0; e < 16; ++e) acc[j][e] = 0.f;
#pragma unroll 2
        for (int ks = 0; ks < 8; ++ks) {
            const bf16x8 a = *(const LAS bf16x8*)(Pl + (32 * mi + r) * PIT + 16 * ks + 8 * hq);
#pragma unroll
            for (int j = 0; j < 2; ++j) { const int ni = 2 * (wave & 1) + j; const bf16x8 bb = *(const LAS bf16x8*)(Wp + (32 * ni + r) * PIT + 16 * ks + 8 * hq); acc[j] = MFMA32(a, bb, acc[j]); }
        }
#pragma unroll
        for (int j = 0; j < 2; ++j) { const int ni = 2 * (wave & 1) + j;
#pragma unroll
            for (int e = 0; e < 16; ++e) { const int tl = 32 * mi + (e & 3) + 8 * (e >> 2) + 4 * hq; C.mix[(size_t)(row0 + tl) * D + 512 + gi * 128 + 32 * ni + r] = f2bf(acc[j][e]); } }
    }
    __syncthreads();
}

__device__ __forceinline__ void scan_phase(bf16_t* states, const float* cdecay, int G, int bid) {
    int tid_ = threadIdx.x; asm volatile("" : "+v"(tid_));
    for (int idx = bid * 512 + tid_; idx < 2 * 8 * 64 * 128; idx += G * 512) {
        const int n = idx & 127, p = (idx >> 7) & 63, h = (idx >> 13) & 7, b = idx >> 16;
        bf16_t* sp = states + ((size_t)b * 128 * 8 + h) * 8192 + p * 128 + n; const float* dp = cdecay + (size_t)b * 128 * 8 + h;
        float s = 0.f;
        for (int c0 = 0; c0 < 128; c0 += 16) {
            float v[16], d[16];
#pragma unroll
            for (int i = 0; i < 16; ++i) { v[i] = bf2f(sp[(size_t)(c0 + i) * 8 * 8192]); d[i] = dp[(c0 + i) * 8]; }
#pragma unroll
            for (int i = 0; i < 16; ++i) { sp[(size_t)(c0 + i) * 8 * 8192] = f2bf(s); s = s * d[i] + v[i]; }
        }
    }
}
__device__ __forceinline__ void ssd_s3_job(const SsdCtx& C, LAS unsigned char* lds, int b, int c, int g) {
    int tid_ = threadIdx.x; asm volatile("" : "+v"(tid_)); const int tid = tid_, lane = tid & 63, wave = tid >> 6;
    LAS bf16_t* Cn = (LAS bf16_t*)lds; LAS bf16_t* CBm = (LAS bf16_t*)(lds + 128 * PIT * 2); LAS bf16_t* Bn = (LAS bf16_t*)(lds + 256 * PIT * 2); LAS bf16_t* XT = Bn;
    LAS float* dtT = (LAS float*)(lds + 139264); LAS float* acs = dtT + 512; LAS float* red = dtT + 1024;
    const long row0 = (long)b * SEQ + c * 128;
    { const int tok = tid >> 2, hh = tid & 3; dtT[hh * 128 + tok] = C.dtbuf[(size_t)(row0 + tok) * 8 + 4 * g + hh]; }
    __syncthreads();
    { const float Ah = wave < 4 ? -__expf(C.a_log[4 * g + wave]) : 0.f; (void)chunk_cumsum(dtT, acs, wave, lane, Ah); }
    {
        unsigned v[4][11];
#pragma unroll
        for (int k = 0; k < 4; ++k) { const int idx = tid + 512 * k, cp = idx & 127, r = idx >> 7; const int xch = cp < 64 ? 512 + g * 128 + 2 * cp : 768 + g * 128 + 2 * (cp - 64);
            conv_load(C.proj, row0, 8 * r, c == 0, 512 + xch, v[k]); }
#pragma unroll
        for (int k = 0; k < 4; ++k) { const int idx = tid + 512 * k, cp = idx & 127, r = idx >> 7; const bool isB = cp < 64;
            const int xch = isB ? 512 + g * 128 + 2 * cp : 768 + g * 128 + 2 * (cp - 64);
            float o0[8], o1[8];
            conv_apply(v[k], C.cw, C.cb, xch, o0, o1);
            LAS bf16_t* dst = (isB ? Bn + 2 * cp : Cn + 2 * (cp - 64)) + (8 * r) * PIT;
#pragma unroll
            for (int i = 0; i < 8; ++i) *(LAS unsigned*)(dst + i * PIT) = cvt_pk_bf16(o0[i], o1[i]); }
    }
    unsigned vx[4][11];
#pragma unroll
    for (int k = 0; k < 4; ++k) { const int idx = tid + 512 * k, cp = idx & 127, r = idx >> 7; conv_load(C.proj, row0, 8 * r, c == 0, 512 + g * 256 + 2 * cp, vx[k]); }
    __syncthreads();
    {
        const int mi = wave >> 1, r = lane & 31, hq = lane >> 5;
        f32x16 acc[2];
#pragma unroll
        for (int j = 0; j < 2; ++j)
#pragma unroll
            for (int e = 0; e < 16; ++e) acc[j][e] = 0.f;
#pragma unroll 2
        for (int ks = 0; ks < 8; ++ks) {
            const bf16x8 a = *(const LAS bf16x8*)(Cn + (32 * mi + r) * PIT + 16 * ks + 8 * hq);
#pragma unroll
            for (int j = 0; j < 2; ++j) { const int ni = 2 * (wave & 1) + j; const bf16x8 bb = *(const LAS bf16x8*)(Bn + (32 * ni + r) * PIT + 16 * ks + 8 * hq); acc[j] = MFMA32(a, bb, acc[j]); }
        }
#pragma unroll
        for (int j = 0; j < 2; ++j) { const int ni = 2 * (wave & 1) + j;
#pragma unroll
            for (int e = 0; e < 16; ++e) { const int l = 32 * mi + (e & 3) + 8 * (e >> 2) + 4 * hq; CBm[l * PIT + 32 * ni + r] = f2bf(acc[j][e]); } }
    }
    __syncthreads();
#pragma unroll
    for (int k = 0; k < 4; ++k) { const int idx = tid + 512 * k, cp = idx & 127, r = idx >> 7; const int xch = g * 256 + 2 * cp;
        float o0[8], o1[8];
        conv_apply(vx[k], C.cw, C.cb, xch, o0, o1);
        LAS bf16_t* dst = XT + (2 * cp) * PIT + 8 * r;
        u32x4 w0, w1; w0.x = cvt_pk_bf16(o0[0], o0[1]); w0.y = cvt_pk_bf16(o0[2], o0[3]); w0.z = cvt_pk_bf16(o0[4], o0[5]); w0.w = cvt_pk_bf16(o0[6], o0[7]);
        w1.x = cvt_pk_bf16(o1[0], o1[1]); w1.y = cvt_pk_bf16(o1[2], o1[3]); w1.z = cvt_pk_bf16(o1[4], o1[5]); w1.w = cvt_pk_bf16(o1[6], o1[7]);
        *(LAS u32x4*)dst = w0; *(LAS u32x4*)(dst + PIT) = w1; }
    __syncthreads();
    const int hh = wave >> 1, lh = wave & 1, r = lane & 31, hq = lane >> 5, h = 4 * g + hh;
    f32x16 acc[2][2];
#pragma unroll
    for (int i = 0; i < 2; ++i)
#pragma unroll
        for (int j = 0; j < 2; ++j)
#pragma unroll
            for (int e = 0; e < 16; ++e) acc[i][j][e] = 0.f;
    {
        const bf16_t* pv = C.states + ((size_t)(b * 128 + c) * 8 + h) * 64 * 128;
        bf16x8 pa[8][2];
#pragma unroll
        for (int ks = 0; ks < 8; ++ks)
#pragma unroll
            for (int i = 0; i < 2; ++i) pa[ks][i] = *(const bf16x8*)(pv + (32 * i + r) * 128 + 16 * ks + 8 * hq);
#pragma unroll
        for (int ks = 0; ks < 8; ++ks) {
            bf16x8 bb[2];
#pragma unroll
            for (int i = 0; i < 2; ++i) bb[i] = *(const LAS bf16x8*)(Cn + (64 * lh + 32 * i + r) * PIT + 16 * ks + 8 * hq);
#pragma unroll
            for (int i = 0; i < 2; ++i)
#pragma unroll
                for (int j = 0; j < 2; ++j) acc[i][j] = MFMA32(pa[ks][i], bb[j], acc[i][j]);
        }
#pragma unroll
        for (int j = 0; j < 2; ++j) { const float el = __expf(acs[hh * 128 + 64 * lh + 32 * j + r]);
#pragma unroll
            for (int i = 0; i < 2; ++i)
#pragma unroll
                for (int e = 0; e < 16; ++e) acc[i][j][e] *= el; }
    }
#pragma unroll
    for (int li = 0; li < 2; ++li) {
        const int l = 64 * lh + 32 * li + r; const float al = acs[hh * 128 + l];
        const int nks = 4 * lh + 2 * li + 2;
        for (int ks = 0; ks < nks; ++ks) {
            const int s0 = 16 * ks + 8 * hq;
            const u32x4 cb = *(const LAS u32x4*)(CBm + l * PIT + s0);
            const f32x4 as0 = *(const LAS f32x4*)(acs + hh * 128 + s0), as1 = *(const LAS f32x4*)(acs + hh * 128 + s0 + 4);
            const f32x4 d0 = *(const LAS f32x4*)(dtT + hh * 128 + s0), d1 = *(const LAS f32x4*)(dtT + hh * 128 + s0 + 4);
            float m[8];
            m[0] = bf_lo(cb.x) * __expf(al - as0[0]) * d0[0]; m[1] = bf_hi(cb.x) * __expf(al - as0[1]) * d0[1];
            m[2] = bf_lo(cb.y) * __expf(al - as0[2]) * d0[2]; m[3] = bf_hi(cb.y) * __expf(al - as0[3]) * d0[3];
            m[4] = bf_lo(cb.z) * __expf(al - as1[0]) * d1[0]; m[5] = bf_hi(cb.z) * __expf(al - as1[1]) * d1[1];
            m[6] = bf_lo(cb.w) * __expf(al - as1[2]) * d1[2]; m[7] = bf_hi(cb.w) * __expf(al - as1[3]) * d1[3];
#pragma unroll
            for (int j = 0; j < 8; ++j) m[j] = (s0 + j <= l) ? m[j] : 0.f;
            u32x4 mw; mw.x = cvt_pk_bf16(m[0], m[1]); mw.y = cvt_pk_bf16(m[2], m[3]); mw.z = cvt_pk_bf16(m[4], m[5]); mw.w = cvt_pk_bf16(m[6], m[7]);
            const bf16x8 mf = __builtin_bit_cast(bf16x8, mw);
#pragma unroll
            for (int pi = 0; pi < 2; ++pi) { const bf16x8 a = *(const LAS bf16x8*)(XT + (64 * hh + 32 * pi + r) * PIT + s0); acc[pi][li] = MFMA32(a, mf, acc[pi][li]); }
        }
    }
    const float Dh = C.d_skip[h];
    float sq[2] = {0.f, 0.f};
#pragma unroll
    for (int li = 0; li < 2; ++li) { const int l = 64 * lh + 32 * li + r;
#pragma unroll
        for (int pi = 0; pi < 2; ++pi)
#pragma unroll
            for (int e4 = 0; e4 < 4; ++e4) { const int p0 = 32 * pi + 8 * e4 + 4 * hq;
                const u32x2 zz = *(const u32x2*)(C.proj + (size_t)(row0 + l) * NPROJ + g * 256 + hh * 64 + p0);
                const float zf[4] = {bf_lo(zz.x), bf_hi(zz.x), bf_lo(zz.y), bf_hi(zz.y)};
#pragma unroll
                for (int k = 0; k < 4; ++k) { const float xs = bf2f(XT[(64 * hh + p0 + k) * PIT + l]); float y = acc[pi][li][4 * e4 + k] + xs * Dh; y *= silu_f(zf[k]); acc[pi][li][4 * e4 + k] = y; sq[li] += y * y; } }
        sq[li] += __shfl_xor(sq[li], 32);
        if (hq == 0) red[hh * 128 + l] = sq[li]; }
    __syncthreads();
#pragma unroll
    for (int li = 0; li < 2; ++li) { const int l = 64 * lh + 32 * li + r;
        const float rstd = rsqrtf((red[l] + red[128 + l] + red[256 + l] + red[384 + l]) * (1.f / 256.f) + EPS);
#pragma unroll
        for (int pi = 0; pi < 2; ++pi)
#pragma unroll
            for (int e4 = 0; e4 < 4; ++e4) { const int p0 = 32 * pi + 8 * e4 + 4 * hq, ch = g * 256 + hh * 64 + p0;
                const f32x4 ng = *(const f32x4*)(C.norm_g + ch);
                u32x2 w; w.x = cvt_pk_bf16(acc[pi][li][4 * e4] * rstd * ng[0], acc[pi][li][4 * e4 + 1] * rstd * ng[1]); w.y = cvt_pk_bf16(acc[pi][li][4 * e4 + 2] * rstd * ng[2], acc[pi][li][4 * e4 + 3] * rstd * ng[3]);
                *(u32x2*)(C.mix + (size_t)(row0 + l) * D + ch) = w; } }
    __syncthreads();
}

struct FixIn { f32x2 tm2[2], tm1[2], h0[2], h1[2], w0[2], w1[2], w2[2], bb[2]; };
__device__ __forceinline__ void fix_load(const float* head, const float* tail, const float* cw, const float* cb, int s, int j, FixIn& f) {
    const bool first = (s & 255) == 0;
#pragma unroll
    for (int gv = 0; gv < 2; ++gv) { const int col = j + gv * DFF; const f32x2 z = {0.f, 0.f};
        f.tm2[gv] = first ? z : *(const f32x2*)(tail + (size_t)((s - 1) * 2) * DUP + col); f.tm1[gv] = first ? z : *(const f32x2*)(tail + (size_t)((s - 1) * 2 + 1) * DUP + col);
        f.h0[gv] = *(const f32x2*)(head + (size_t)(s * 2) * DUP + col); f.h1[gv] = *(const f32x2*)(head + (size_t)(s * 2 + 1) * DUP + col);
        f.w0[gv] = *(const f32x2*)(cw + col); f.w1[gv] = *(const f32x2*)(cw + DUP + col); f.w2[gv] = *(const f32x2*)(cw + 2 * DUP + col); f.bb[gv] = *(const f32x2*)(cb + col); }
}
__device__ __forceinline__ void fix_apply(const FixIn& f, bf16_t* act, int s, int j) {
    f32x2 c0[2], c1[2];
#pragma unroll
    for (int gv = 0; gv < 2; ++gv) { c0[gv] = f.bb[gv] + f.w0[gv] * f.tm2[gv] + f.w1[gv] * f.tm1[gv] + f.w2[gv] * f.h0[gv]; c1[gv] = f.bb[gv] + f.w0[gv] * f.tm1[gv] + f.w1[gv] * f.h0[gv] + f.w2[gv] * f.h1[gv]; }
    *(unsigned*)(act + (size_t)(64 * s) * DFF + j) = cvt_pk_bf16(gelu_tanh(c0[0].x) * c0[1].x, gelu_tanh(c0[0].y) * c0[1].y);
    *(unsigned*)(act + (size_t)(64 * s + 1) * DFF + j) = cvt_pk_bf16(gelu_tanh(c1[0].x) * c1[1].x, gelu_tanh(c1[0].y) * c1[1].y);
}
__device__ __forceinline__ void fixup_phase(const Params& P, int l, bf16_t* act, const float* head, const float* tail, int G, int bid) {
    const float* cw = P.fconv_w + (size_t)l * 3 * DUP; const float* cb = P.fconv_b + (size_t)l * DUP;
    int tid_ = threadIdx.x; asm volatile("" : "+v"(tid_)); const int gt = bid * 512 + tid_, NT = G * 512;
    constexpr int NI = 512 * (DFF / 2);
    for (int idx = gt; idx < NI; idx += 2 * NT) {
        const int i2 = idx + NT; const bool two = i2 < NI;
        FixIn f0, f1;
        fix_load(head, tail, cw, cb, idx / (DFF / 2), 2 * (idx % (DFF / 2)), f0);
        if (two) fix_load(head, tail, cw, cb, i2 / (DFF / 2), 2 * (i2 % (DFF / 2)), f1);
        fix_apply(f0, act, idx / (DFF / 2), 2 * (idx % (DFF / 2)));
        if (two) fix_apply(f1, act, i2 / (DFF / 2), 2 * (i2 % (DFF / 2)));
    }
}

#define XB_TMO      128
#define XB_XCNT(j)  (256  + 64 * (j))
#define XB_XSUB(j)  (1280 + 64 * (j))
#define XB_XGEN(j)  (2304 + 64 * (j))
#define XB_TOP      3328
#define XB_TOPGEN   3392
#define XCD_BAR_WORDS 3456
#define XB_SPIN_CAP (1u << 18)

__device__ __forceinline__ unsigned xb_ld(unsigned* p)              { return __hip_atomic_load(p, __ATOMIC_RELAXED, __HIP_MEMORY_SCOPE_AGENT); }
__device__ __forceinline__ unsigned xb_add(unsigned* p, unsigned v) { return __hip_atomic_fetch_add(p, v, __ATOMIC_RELAXED, __HIP_MEMORY_SCOPE_AGENT); }
__device__ __forceinline__ unsigned xb_xcc_id() { return (unsigned)__builtin_amdgcn_s_getreg((3 << 11) | 20) & 0xFu; }
#define XB_SPIN(cond, bar) do { unsigned _sp = 0; while (cond) { __builtin_amdgcn_s_sleep(1); \
    if ((++_sp & 255u) == 0u) { if (xb_ld(&(bar)[XB_TMO])) break; if (_sp > XB_SPIN_CAP) { atomicAdd(&(bar)[XB_TMO], 1u); break; } } } } while (0)

struct XcdBarrier {
    unsigned* bar; unsigned x;
    volatile LAS unsigned* st;
};

__device__ __forceinline__ XcdBarrier xcd_barrier_post(unsigned* bar, volatile LAS unsigned* st) {
    XcdBarrier b; b.bar = bar; b.x = xb_xcc_id(); b.st = st;
    if (threadIdx.x == 0) (void)xb_add(&bar[XB_XCNT(b.x)], 1u);
    return b;
}
__device__ __forceinline__ void xcd_barrier_complete(unsigned* bar, unsigned x, unsigned& nloc, unsigned& nx) {
    const unsigned G = gridDim.x * gridDim.y * gridDim.z;
    unsigned sum, cnt, mine, sp = 0u;
    for (;;) {
        sum = 0u; cnt = 0u; mine = 0u;
#pragma unroll
        for (unsigned j = 0; j < 16; ++j) { const unsigned c = xb_ld(&bar[XB_XCNT(j)]); sum += c; cnt += (c > 0u) ? 1u : 0u; mine = (j == x) ? c : mine; }
        if (sum == G) break;
        __builtin_amdgcn_s_sleep(1);
        if ((++sp & 255u) == 0u) { if (xb_ld(&bar[XB_TMO])) break; if (sp > XB_SPIN_CAP) { atomicAdd(&bar[XB_TMO], 1u); break; } }
    }
    nloc = mine > 0u ? mine : 1u; nx = cnt > 0u ? cnt : 1u;
}

__device__ __forceinline__ void xcd_barrier(const XcdBarrier& b) {
    asm volatile("s_waitcnt vmcnt(0)" ::: "memory");
    __syncthreads();
    if (threadIdx.x == 0) {
        unsigned* bar = b.bar;
        __builtin_amdgcn_s_waitcnt(0);
        unsigned nloc = b.st[0], nx = b.st[1];
        if (nloc == 0u) { xcd_barrier_complete(bar, b.x, nloc, nx); b.st[0] = nloc; b.st[1] = nx; }
        const unsigned old = xb_add(&bar[XB_XSUB(b.x)], 1u);
        const unsigned gen = old / nloc;
        if (old + 1u == (gen + 1u) * nloc) {
            __builtin_amdgcn_fence(__ATOMIC_RELEASE, "agent");
            asm volatile("s_waitcnt vmcnt(0)" ::: "memory");
            const unsigned og = xb_add(&bar[XB_TOP], 1u);
            const unsigned tg = og / nx;
            if (og + 1u == (tg + 1u) * nx) xb_add(&bar[XB_TOPGEN], 1u);
            else XB_SPIN(xb_ld(&bar[XB_TOPGEN]) == tg, bar);
            __builtin_amdgcn_fence(__ATOMIC_ACQUIRE, "agent");
            xb_add(&bar[XB_XGEN(b.x)], 1u);
            asm volatile("s_waitcnt vmcnt(0)" ::: "memory");
        } else {
            XB_SPIN(xb_ld(&bar[XB_XGEN(b.x)]) == gen, bar);
            __builtin_amdgcn_fence(__ATOMIC_ACQUIRE, "agent");
            asm volatile("s_waitcnt vmcnt(0)" ::: "memory");
        }
    }
    __syncthreads();
}


__global__ __launch_bounds__(512, 2) void hymba_fwd(Params P) {
    extern __shared__ __attribute__((aligned(16))) unsigned char shm[];
    LAS unsigned char* lds = (LAS unsigned char*)shm;
    cg::grid_group grid = cg::this_grid();
    const int G = (int)gridDim.x, bid = (int)blockIdx.x;
    bf16_t* hbuf[2] = {(bf16_t*)(P.ws + OFF_HB0), (bf16_t*)(P.ws + OFF_HB1)};
    float* ssbuf[2] = {(float*)(P.ws + OFF_SS), (float*)(P.ws + OFF_SS) + (size_t)T * 16};
    bf16_t* wt = (bf16_t*)(P.ws + OFF_WT);
    bf16_t* proj = (bf16_t*)(P.ws + OFF_R); bf16_t* act = proj; bf16_t* states = (bf16_t*)(P.ws + OFF_ST);
    bf16_t* mix = (bf16_t*)(P.ws + OFF_MIX); bf16_t* qb = mix; float* head = (float*)(P.ws + OFF_MIX); float* tail = (float*)(P.ws + OFF_TAIL);
    bf16_t* pball = (bf16_t*)P.out;
    float* dtbuf = (float*)(P.ws + OFF_DT); float* cdecay = (float*)(P.ws + OFF_CD);
    pg8::StaticOrder S;
    volatile LAS unsigned* xst = (volatile LAS unsigned*)(lds + LDS_BYTES - 16);
    if (threadIdx.x == 0) { xst[0] = 0u; xst[1] = 0u; }
    __syncthreads();
    const XcdBarrier xb = xcd_barrier_post((unsigned*)(P.ws + OFF_BAR), xst);

    phase0(P, lds, G, bid);
    grid.sync();
    int cur = 0;
#pragma unroll 1
    for (int l = 0; l < NL; ++l) {
        const bf16_t* wl = wt + (size_t)l * WLAYER;
        bf16_t* hb = cur ? hbuf[1] : hbuf[0]; bf16_t* hbn = cur ? hbuf[0] : hbuf[1];
        float* ss = cur ? ssbuf[1] : ssbuf[0]; float* ssn = cur ? ssbuf[0] : ssbuf[1];
        { RsOrder<false> SR; SR.init(T, NPROJ, G, bid); SR.ss = ss; SR.rsbuf = (LAS float*)(lds + 139264); SR.cw = nullptr; SR.cb = nullptr; SR.pbuf = nullptr; SR.na = 0;
          EpiIn E{proj, (const LAS float*)(lds + 139264), 0}; pg8::gemm_phase<EpiIn, RsOrder<false>, true, true>(lds, pg8::Gemm{hb, wl + WIN, T, NPROJ, D}, SR, E); }
        xcd_barrier(xb);
        SsdCtx C{proj, hb, ss, wl + WDT, P.conv_w + (size_t)l * 4 * 1024, P.conv_b + (size_t)l * 1024, P.dt_bias + l * 8, P.a_log + l * 8, P.d_skip + l * 8, P.norm_g + l * 512,
                 states, dtbuf, cdecay, mix, wl + WPOOL};
        for (int job = bid; job < 512 + 1024; job += G) {
            if (job < 512) ssd_s1_job(C, lds, job >> 8, (job >> 1) & 127, job & 1);
            else { const int j = job - 512; pool_job(C, lds, j >> 2, j & 3); }
        }
        xcd_barrier(xb);
        scan_phase(states, cdecay, G, bid);
        xcd_barrier(xb);
        for (int job = bid; job < 512; job += G) ssd_s3_job(C, lds, job >> 8, (job >> 1) & 127, job & 1);
        xcd_barrier(xb);
        { S.init(T, D, G, bid); EpiRes<false> E{hb, hb, ss, nullptr, nullptr}; pg8::gemm_phase<EpiRes<false>, pg8::StaticOrder, true, true>(lds, pg8::Gemm{mix, wl + WOUT, T, D, D}, S, E); }
        xcd_barrier(xb);
        { RsOrder<true> SU; SU.init(T, DUP, G, bid); SU.ss = ss; SU.rsbuf = (LAS float*)(lds + 139264); SU.cw = P.fconv_w + (size_t)l * 3 * DUP; SU.cb = P.fconv_b + (size_t)l * DUP; SU.pbuf = (LAS float*)(lds + 131072); SU.na = 0;
          EpiUp E{act, (const LAS float*)(lds + 139264), (const LAS float*)(lds + 131072), head, tail, 0}; pg8::gemm_phase<EpiUp, RsOrder<true>, true, true>(lds, pg8::Gemm{hb, wl + WUP, T, DUP, D}, SU, E); }
        xcd_barrier(xb);
        fixup_phase(P, l, act, head, tail, G, bid);
        xcd_barrier(xb);
        { S.init(T, D, G, bid); EpiRes<false> E{hb, hb, ss, nullptr, nullptr}; pg8::gemm_phase<EpiRes<false>, pg8::StaticOrder, true, true>(lds, pg8::Gemm{act, wl + WDOWN, T, D, DFF}, S, E); }
        { S.init(T, D, G, bid); EpiQ E{qb}; pg8::gemm_phase<EpiQ, pg8::StaticOrder, true, true>(lds, pg8::Gemm{pball + (size_t)l * T * DPLE, wl + WPLE, T, D, DPLE}, S, E); }
        xcd_barrier(xb);
        { S.init(T, D, G, bid); EpiRes<true> E{hb, hbn, ssn, ss, qb}; pg8::gemm_phase<EpiRes<true>, pg8::StaticOrder, true, true>(lds, pg8::Gemm{hb, wl + WGATE, T, D, D}, S, E); }
        xcd_barrier(xb);
        cur ^= 1;
    }
    {
        const int lane = threadIdx.x & 63, wave = threadIdx.x >> 6;
        const float* ss = cur ? ssbuf[1] : ssbuf[0]; const bf16_t* hb = cur ? hbuf[1] : hbuf[0];
        for (int row = bid * 8 + wave; row < T; row += G * 8) {
            const float rs = row_rstd(ss, row); const u32x2* hr = (const u32x2*)(hb + (size_t)row * D) + lane; f32x4* xr = (f32x4*)(P.out + (size_t)row * D) + lane; const f32x4* gr = (const f32x4*)P.final_g + lane;
#pragma unroll
            for (int j = 0; j < 4; ++j) { const u32x2 hh = hr[64 * j]; const f32x4 gg = gr[64 * j]; f32x4 v = {bf_lo(hh.x), bf_hi(hh.x), bf_lo(hh.y), bf_hi(hh.y)}; v = v * rs * gg; xr[64 * j] = v; }
        }
    }
}

extern "C" void kernel_launch(void* const* d_in, const int* in_sizes, int n_in, void* d_out, int out_size, void* d_ws, size_t ws_size, hipStream_t stream) {
    static int grid = 0;
    if (grid == 0) {
        if (n_in != 22 || ws_size < WS_END) { fprintf(stderr, "kernel_launch: unexpected inputs (n_in %d, ws %zu, need %zu)\n", n_in, ws_size, (size_t)WS_END); grid = -1; return; }
        int dev = 0, cus = 0, per_cu = 0;
        (void)hipGetDevice(&dev); (void)hipDeviceGetAttribute(&cus, hipDeviceAttributeMultiprocessorCount, dev);
        if (hipFuncSetAttribute((const void*)hymba_fwd, hipFuncAttributeMaxDynamicSharedMemorySize, LDS_BYTES) != hipSuccess) { fprintf(stderr, "kernel_launch: hipFuncSetAttribute failed\n"); grid = -1; return; }
        if (hipOccupancyMaxActiveBlocksPerMultiprocessor(&per_cu, (const void*)hymba_fwd, 512, LDS_BYTES) != hipSuccess || per_cu < 1) { fprintf(stderr, "kernel_launch: occupancy query says %d blocks per CU\n", per_cu); per_cu = 1; }
        (void)hipGetLastError();
        grid = cus;
    }
    if (grid < 0) return;
    Params p{};
    const float** pp = (const float**)&p;
    for (int i = 0; i < 22; ++i) pp[i] = (const float*)d_in[i];
    p.out = (float*)d_out; p.ws = (unsigned char*)d_ws;
    if (hipMemsetAsync((char*)d_ws + OFF_BAR, 0, 16384, stream) != hipSuccess) { fprintf(stderr, "kernel_launch: memset failed\n"); return; }
    void* args[] = {&p};
    hipError_t e = hipLaunchCooperativeKernel((const void*)hymba_fwd, dim3(grid), dim3(512), args, LDS_BYTES, stream);
    if (e != hipSuccess) fprintf(stderr, "cooperative launch failed: %s (grid %d)\n", hipGetErrorString(e), grid);
}
```

```cpp
#include <hip/hip_runtime.h>
#include <hip/hip_cooperative_groups.h>
#include <cstdio>
#include <cstdint>
namespace cg = cooperative_groups;
namespace pg8 {
#define PG8_LAS __attribute__((address_space(3)))
typedef unsigned short bf16_t;
typedef short bf16x8 __attribute__((ext_vector_type(8)));
typedef float f32x4 __attribute__((ext_vector_type(4)));
typedef unsigned u32x4 __attribute__((ext_vector_type(4)));
constexpr int BM = 256, BK = 64, HALF = 128, HTB = HALF * BK * 2  , STAGE_BYTES = 8 * HTB, NXCD = 8, WGM = 8;

__host__ __device__ __forceinline__ int lds_byte(int r, int c) { const int st = (r >> 4) * 2 + (c >> 5), rr = r & 15, cc = c & 31, ob = rr * 64 + cc * 2; return st * 1024 + (ob ^ (((ob >> 9) & 1) << 5)); }
__host__ __device__ __forceinline__ void stage_rc(int b, int& R, int& C) { const int st = b / 1024, sb = b % 1024, swz = sb ^ (((sb >> 9) & 1) << 5); R = (st >> 1) * 16 + swz / 64; C = (st & 1) * 32 + (swz % 64) / 2; }
__host__ __device__ __forceinline__ int perm32(int rho) { const int n = rho >> 4, i = rho & 15; return 8 * (i >> 2) + 4 * n + (i & 3); }

struct Unit { int pm, pn; };
struct Gemm { const bf16_t* A; const bf16_t* Bt; int M, N, K; };

struct StaticOrder {
    int nM, nN, nwg, G, c;
    __host__ __device__ void init(int M, int N, int G_, int c_) { nM = M / BM; nN = N / BM; nwg = nM * nN; G = G_; c = c_; }
    __host__ __device__ bool next(int i, Unit& u) const {
        const long L = (long)i * G + c; if (L >= nwg) return false;
        int wgid = (int)L; { const int q = nwg / NXCD, r = nwg % NXCD, xcd = wgid % NXCD, off = wgid / NXCD; wgid = (xcd < r ? xcd * (q + 1) : r * (q + 1) + (xcd - r) * q) + off; }
        const int nig = WGM * nN, gid = wgid / nig, fm = gid * WGM, gsz = (nM - fm) < WGM ? (nM - fm) : WGM;
        u.pm = fm + ((wgid % nig) % gsz); u.pn = (wgid % nig) / gsz; return true;
    }
    __device__ __forceinline__ void a_ready(const Unit&) const {}
    __device__ __forceinline__ void done(const Unit&) const {}
};
__device__ __forceinline__ unsigned cvt_pk_bf16(float lo, float hi) { unsigned r; asm volatile("v_cvt_pk_bf16_f32 %0, %1, %2" : "=v"(r) : "v"(lo), "v"(hi)); return r; }

template <class Epi, class Sched, bool ALIGN_EPI = false, bool SP2 = false>
__device__ __forceinline__ void gemm_phase(PG8_LAS unsigned char* lds, const Gemm g, const Sched& S, const Epi& E) {
    int tid_ = threadIdx.x; asm volatile("" : "+v"(tid_));
    const int tid = tid_, wid = __builtin_amdgcn_readfirstlane(tid >> 6), lane = tid & 63, wr = wid >> 2, wc = wid & 3, fr = lane & 15, fq = lane >> 4;
    int K_ = g.K; asm volatile("" : "+s"(K_));
    const int K = K_, nt = K / BK;
    unsigned voffA[2], voffB[2];
#pragma unroll
    for (int i = 0; i < 2; ++i) { int R, C; stage_rc(tid * 16 + i * 8192, R, C); const int Rb = Epi::PERM ? ((R & ~31) + perm32(R & 31)) : R;
        voffA[i] = (unsigned)(R * K + C) * 2u; voffB[i] = (unsigned)(Rb * K + C) * 2u; }
    const size_t kstep = (size_t)(BK * 2);
    const size_t hstep = (size_t)HALF * K * 2;
    const size_t tstep = 2 * hstep;
    const unsigned ldsw = (unsigned)wid * 1024u;
    const int aoff = lds_byte(wr * 64 + fr, fq * 8), boff = lds_byte(wc * 32 + fr, fq * 8);
#define PG8_SA(b, h) (((b) * 2 + (h)) * HTB)
#define PG8_SB(b, h) ((4 + (b) * 2 + (h)) * HTB)
#define PG8_STAGE(bufoff, gbase, voff) do { _Pragma("unroll") for (int _i = 0; _i < 2; ++_i) \
        __builtin_amdgcn_global_load_lds((const unsigned*)((const char*)(gbase) + (voff)[_i]), (PG8_LAS unsigned*)(lds + (bufoff) + ldsw + _i * 8192), 16, 0, 0); } while (0)
#define PG8_LDA(dst, b, h) do { _Pragma("unroll") for (int m = 0; m < 4; ++m) _Pragma("unroll") for (int k = 0; k < 2; ++k) dst[m][k] = *(const PG8_LAS bf16x8*)(lds + PG8_SA(b, h) + aoff + m * 2048 + k * 1024); } while (0)
#define PG8_LDB(dst, b, h) do { _Pragma("unroll") for (int n = 0; n < 2; ++n) _Pragma("unroll") for (int k = 0; k < 2; ++k) dst[n][k] = *(const PG8_LAS bf16x8*)(lds + PG8_SB(b, h) + boff + n * 2048 + k * 1024); } while (0)
#define PG8_MMA(ai, bj, At, Bt) do { __builtin_amdgcn_s_setprio(1); _Pragma("unroll") for (int m = 0; m < 4; ++m) _Pragma("unroll") for (int n = 0; n < 2; ++n) _Pragma("unroll") for (int k = 0; k < 2; ++k) \
        acc[ai][bj][m][n] = __builtin_amdgcn_mfma_f32_16x16x32_bf16(Bt[n][k], At[m][k], acc[ai][bj][m][n], 0, 0, 0); __builtin_amdgcn_s_setprio(0); } while (0)
#define PG8_WAIT_V(n) asm volatile("s_waitcnt vmcnt(" #n ")" ::: "memory")
#define PG8_WAIT_L(n) asm volatile("s_waitcnt lgkmcnt(" #n ")" ::: "memory")
#define PG8_BAR __builtin_amdgcn_s_barrier()
#define PG8_SCHED __builtin_amdgcn_sched_barrier(0)
    Unit cur, nxt; int ui = 0;
    if (!S.next(0, cur)) return;
    f32x4 acc[2][2][4][2];
#pragma unroll
    for (int a = 0; a < 2; ++a)
#pragma unroll
        for (int b = 0; b < 2; ++b)
#pragma unroll
            for (int m = 0; m < 4; ++m)
#pragma unroll
                for (int n = 0; n < 2; ++n) acc[a][b][m][n] = (f32x4){0.f, 0.f, 0.f, 0.f};
    bf16x8 At[4][2], B0[2][2], B1[2][2];
    const char* cA = (const char*)g.A + (size_t)cur.pm * tstep; const char* cB = (const char*)g.Bt + (size_t)cur.pn * tstep;
    S.a_ready(cur);
    if constexpr (SP2) {
        PG8_STAGE(PG8_SB(0, 0), cB, voffB); PG8_STAGE(PG8_SB(0, 1), cB + hstep, voffB); PG8_STAGE(PG8_SA(0, 0), cA, voffA); PG8_STAGE(PG8_SA(0, 1), cA + hstep, voffA);
        if (wr == 1) PG8_BAR;
        PG8_WAIT_V(2); PG8_BAR;
        PG8_STAGE(PG8_SB(1, 0), cB + kstep, voffB); PG8_STAGE(PG8_SA(1, 0), cA + kstep, voffA); PG8_STAGE(PG8_SB(1, 1), cB + hstep + kstep, voffB);
        PG8_WAIT_V(6); PG8_BAR;
    } else {
        PG8_STAGE(PG8_SB(0, 0), cB, voffB); PG8_STAGE(PG8_SA(0, 0), cA, voffA); PG8_STAGE(PG8_SB(0, 1), cB + hstep, voffB); PG8_STAGE(PG8_SA(0, 1), cA + hstep, voffA);
        if (wr == 1) PG8_BAR;
        PG8_WAIT_V(4); PG8_BAR;
        PG8_STAGE(PG8_SB(1, 0), cB + kstep, voffB); PG8_STAGE(PG8_SA(1, 0), cA + kstep, voffA); PG8_STAGE(PG8_SB(1, 1), cB + hstep + kstep, voffB);
        PG8_WAIT_V(6); PG8_BAR;
    }
    for (;;) {
        const bool has_next = S.next(ui + 1, nxt);
        const char* nA = has_next ? (const char*)g.A + (size_t)nxt.pm * tstep : cA; const char* nB = has_next ? (const char*)g.Bt + (size_t)nxt.pn * tstep : cB;
        for (int t = 0; t < nt; t += 2) {
            const bool last = (t == nt - 2);
            const char* a1 = cA + (size_t)(t + 1) * kstep;
            const char* a2 = last ? nA : cA + (size_t)(t + 2) * kstep; const char* b2 = last ? nB : cB + (size_t)(t + 2) * kstep;
            const char* a3 = a2 + kstep; const char* b3 = b2 + kstep;
            if (last && has_next) S.a_ready(nxt);
            if constexpr (SP2) {
            PG8_LDB(B0, 0, 0); PG8_LDB(B1, 0, 1); PG8_SCHED; PG8_LDA(At, 0, 0); PG8_STAGE(PG8_SA(1, 1), a1 + hstep, voffA);
            PG8_WAIT_V(8); PG8_WAIT_L(0); PG8_BAR; PG8_MMA(0, 0, At, B0); PG8_MMA(0, 1, At, B1); PG8_BAR; PG8_SCHED;
            PG8_LDA(At, 0, 1); PG8_STAGE(PG8_SB(0, 0), b2, voffB); PG8_STAGE(PG8_SB(0, 1), b2 + hstep, voffB); PG8_STAGE(PG8_SA(0, 0), a2, voffA);
            PG8_WAIT_V(8); PG8_WAIT_L(0); PG8_BAR; PG8_MMA(1, 0, At, B0); PG8_MMA(1, 1, At, B1); PG8_BAR; PG8_SCHED;
            PG8_LDB(B0, 1, 0); PG8_LDB(B1, 1, 1); PG8_SCHED; PG8_LDA(At, 1, 0); PG8_STAGE(PG8_SA(0, 1), a2 + hstep, voffA);
            PG8_WAIT_V(8); PG8_WAIT_L(0); PG8_BAR; PG8_MMA(0, 0, At, B0); PG8_MMA(0, 1, At, B1); PG8_BAR; PG8_SCHED;
            PG8_LDA(At, 1, 1); PG8_STAGE(PG8_SB(1, 0), b3, voffB); PG8_STAGE(PG8_SB(1, 1), b3 + hstep, voffB); PG8_STAGE(PG8_SA(1, 0), a3, voffA);
            PG8_WAIT_V(8); PG8_WAIT_L(0); PG8_BAR; PG8_MMA(1, 0, At, B0); PG8_MMA(1, 1, At, B1); PG8_BAR; PG8_SCHED;
            } else {
            PG8_LDB(B0, 0, 0); PG8_SCHED; PG8_LDA(At, 0, 0); PG8_STAGE(PG8_SA(1, 1), a1 + hstep, voffA);
            PG8_WAIT_L(8); PG8_BAR; PG8_WAIT_L(0); PG8_MMA(0, 0, At, B0); PG8_BAR; PG8_SCHED;
            PG8_LDB(B1, 0, 1); PG8_STAGE(PG8_SB(0, 0), b2, voffB);
            PG8_BAR; PG8_WAIT_L(0); PG8_MMA(0, 1, At, B1); PG8_BAR;
            PG8_LDA(At, 0, 1); PG8_STAGE(PG8_SA(0, 0), a2, voffA);
            PG8_BAR; PG8_WAIT_L(0); PG8_MMA(1, 0, At, B0); PG8_BAR; PG8_SCHED;
            PG8_STAGE(PG8_SB(0, 1), b2 + hstep, voffB);
            PG8_WAIT_V(6); PG8_BAR; PG8_MMA(1, 1, At, B1); PG8_BAR;
            PG8_LDB(B0, 1, 0); PG8_SCHED; PG8_LDA(At, 1, 0); PG8_STAGE(PG8_SA(0, 1), a2 + hstep, voffA);
            PG8_WAIT_L(8); PG8_BAR; PG8_WAIT_L(0); PG8_MMA(0, 0, At, B0); PG8_BAR; PG8_SCHED;
            PG8_LDB(B1, 1, 1); PG8_STAGE(PG8_SB(1, 0), b3, voffB);
            PG8_BAR; PG8_WAIT_L(0); PG8_MMA(0, 1, At, B1); PG8_BAR;
            PG8_LDA(At, 1, 1); PG8_STAGE(PG8_SA(1, 0), a3, voffA);
            PG8_BAR; PG8_WAIT_L(0); PG8_MMA(1, 0, At, B0); PG8_BAR; PG8_SCHED;
            PG8_STAGE(PG8_SB(1, 1), b3 + hstep, voffB);
            PG8_WAIT_V(6); PG8_BAR; PG8_MMA(1, 1, At, B1); PG8_BAR;
            }
        }
        if constexpr (ALIGN_EPI) { if (wr == 0) PG8_BAR; }
        if constexpr (!Epi::AFTER_DRAIN) { E(acc, cur, wr, wc, fr, fq); S.done(cur); }
        if (!has_next) break;
#pragma unroll
        for (int a = 0; a < 2; ++a)
#pragma unroll
            for (int b = 0; b < 2; ++b)
#pragma unroll
                for (int m = 0; m < 4; ++m)
#pragma unroll
                    for (int n = 0; n < 2; ++n) acc[a][b][m][n] = (f32x4){0.f, 0.f, 0.f, 0.f};
        cur = nxt; cA = nA; cB = nB; ++ui;
        if constexpr (ALIGN_EPI) { if (wr == 1) PG8_BAR; }
    }
    PG8_WAIT_V(0);
    if constexpr (!ALIGN_EPI) { if (wr == 0) PG8_BAR; }
    PG8_BAR;
    if constexpr (Epi::AFTER_DRAIN) { E.fused(acc, cur, wr, wc, fr, fq, lds, wid, lane); S.done(cur); }
#undef PG8_SA
#undef PG8_SB
#undef PG8_STAGE
#undef PG8_LDA
#undef PG8_LDB
#undef PG8_MMA
#undef PG8_WAIT_V
#undef PG8_WAIT_L
#undef PG8_BAR
#undef PG8_SCHED
}
}
#define LAS __attribute__((address_space(3)))
typedef pg8::bf16_t bf16_t; typedef pg8::bf16x8 bf16x8; typedef pg8::f32x4 f32x4; typedef pg8::u32x4 u32x4;
typedef float f32x16 __attribute__((ext_vector_type(16)));
typedef unsigned u32x2 __attribute__((ext_vector_type(2)));
typedef float f32x2 __attribute__((ext_vector_type(2)));
using pg8::cvt_pk_bf16;

constexpr int T = 32768, D = 1024, SEQ = 16384, NL = 4, NPROJ = 2048, DFF = 2816, DUP = 5632, DPLE = 256;
constexpr float EPS = 1e-6f;
constexpr size_t WIN = 0, WDT = WIN + (size_t)2048 * 1024, WOUT = WDT + (size_t)16 * 1024, WUP = WOUT + (size_t)1024 * 1024, WDOWN = WUP + (size_t)5632 * 1024,
                 WGATE = WDOWN + (size_t)1024 * 2816, WPLE = WGATE + (size_t)1024 * 1024, WPOOL = WPLE + (size_t)1024 * 256, WLAYER = WPOOL + (size_t)4 * 128 * 128;
constexpr size_t OFF_HB0 = 0, OFF_HB1 = OFF_HB0 + (size_t)T * D * 2, OFF_WT = OFF_HB1 + (size_t)T * D * 2, OFF_R = OFF_WT + WLAYER * 2 * NL,
                 OFF_ST = OFF_R + (size_t)T * NPROJ * 2, OFF_MIX = OFF_R + (size_t)T * DFF * 2, OFF_TAIL = OFF_MIX + (size_t)512 * 2 * DUP * 4,
                 OFF_PB = OFF_MIX + (size_t)T * D * 2, OFF_SS = OFF_PB + (size_t)T * DPLE * 2, OFF_DT = OFF_SS + (size_t)2 * T * 16 * 4,
                 OFF_CD = OFF_DT + (size_t)T * 8 * 4, OFF_BAR = OFF_CD + 8192, WS_END = OFF_BAR + 16384;
static_assert(OFF_ST + (size_t)2 * 128 * 8 * 64 * 128 * 2 <= OFF_MIX, "states must fit behind proj");
static_assert(WS_END <= (size_t)512 * 1024 * 1024, "workspace");
constexpr int LDS_BYTES = 147456;
constexpr int PIT = 136;

struct Params {
    const float *x, *p, *mix_g, *w_in, *conv_w, *conv_b, *dt_bias, *a_log, *d_skip, *norm_g, *pool_w, *pool_scale, *w_out, *ffn_g, *w_up, *fconv_w, *fconv_b, *w_down,
        *ple_g, *w_gate, *w_ple, *final_g;
    float* out; unsigned char* ws;
};

__device__ __forceinline__ float bf_lo(unsigned u) { return __uint_as_float(u << 16); }
__device__ __forceinline__ float bf_hi(unsigned u) { return __uint_as_float(u & 0xffff0000u); }
__device__ __forceinline__ float bf2f(bf16_t b) { return __uint_as_float(((unsigned)b) << 16); }
__device__ __forceinline__ bf16_t f2bf(float f) { return (bf16_t)(cvt_pk_bf16(f, 0.f) & 0xffffu); }
__device__ __forceinline__ float fast_sigmoid(float v) { return __builtin_amdgcn_rcpf(1.f + __builtin_amdgcn_exp2f(-1.4426950409f * v)); }
__device__ __forceinline__ float silu_f(float v) { return v * fast_sigmoid(v); }
__device__ __forceinline__ float gelu_tanh(float v) { const float t = v * (1.f + 0.044715f * v * v); return v * __builtin_amdgcn_rcpf(1.f + __builtin_amdgcn_exp2f(-2.302208198f * t)); }
__device__ __forceinline__ float softplus_f(float v) { return v > 20.f ? v : log1pf(__expf(v)); }
__device__ __forceinline__ float wave_sum(float v) {
#pragma unroll
    for (int o = 1; o < 64; o <<= 1) v += __shfl_xor(v, o);
    return v;
}
template <int CTRL> __device__ __forceinline__ float dppf(float v) { return __builtin_bit_cast(float, __builtin_amdgcn_update_dpp(0, __builtin_bit_cast(int, v), CTRL, 0xf, 0xf, true)); }
__device__ __forceinline__ float row_rstd(const float* ss, int row) {
    const f32x4* p = (const f32x4*)(ss + (size_t)row * 16);
    const f32x4 a = p[0], b = p[1], c = p[2], d = p[3];
    const float s = ((a.x + a.y) + (a.z + a.w)) + ((b.x + b.y) + (b.z + b.w)) + ((c.x + c.y) + (c.z + c.w)) + ((d.x + d.y) + (d.z + d.w));
    return rsqrtf(s * (1.f / 1024.f) + EPS);
}
__device__ __forceinline__ float row_rstd_coop(const float* ss, int row, int fq) {
    const f32x4 a = *(const f32x4*)(ss + (size_t)row * 16 + 4 * fq);
    float s = (a.x + a.y) + (a.z + a.w);
    s += __shfl_xor(s, 16); s += __shfl_xor(s, 32);
    return rsqrtf(s * (1.f / 1024.f) + EPS);
}
__device__ __forceinline__ void rstd8(const float* ss, int rbase, int fq, float (&rs)[2][4]) {
    f32x4 a[2][4];
#pragma unroll
    for (int ai = 0; ai < 2; ++ai)
#pragma unroll
        for (int m = 0; m < 4; ++m) a[ai][m] = *(const f32x4*)(ss + (size_t)(rbase + ai * 128 + m * 16) * 16 + 4 * fq);
#pragma unroll
    for (int ai = 0; ai < 2; ++ai)
#pragma unroll
        for (int m = 0; m < 4; ++m) { float s = (a[ai][m].x + a[ai][m].y) + (a[ai][m].z + a[ai][m].w); s += __shfl_xor(s, 16); s += __shfl_xor(s, 32); rs[ai][m] = rsqrtf(s * (1.f / 1024.f) + EPS); }
}
__device__ __forceinline__ void rstd4(const float* ss, int rbase, int fq, float (&rs)[4]) {
    f32x4 a[4];
#pragma unroll
    for (int m = 0; m < 4; ++m) a[m] = *(const f32x4*)(ss + (size_t)(rbase + m * 16) * 16 + 4 * fq);
#pragma unroll
    for (int m = 0; m < 4; ++m) { float s = (a[m].x + a[m].y) + (a[m].z + a[m].w); s += __shfl_xor(s, 16); s += __shfl_xor(s, 32); rs[m] = rsqrtf(s * (1.f / 1024.f) + EPS); }
}
#define LDS_FENCE() asm volatile("s_waitcnt lgkmcnt(0)" ::: "memory")

struct EpiIn {
    static constexpr bool PERM = true, AFTER_DRAIN = false;
    bf16_t* O; const LAS float* rsbuf; mutable int ne;
    __device__ __forceinline__ void operator()(const f32x4 (&acc)[2][2][4][2], const pg8::Unit& u, int wr, int wc, int fr, int fq) const {
        const int col0 = u.pn * 256 + wc * 32 + 8 * fq, rbase = u.pm * 256 + wr * 64 + fr;
        const LAS float* rp = rsbuf + (ne & 1) * 256 + wr * 64 + fr; ++ne;
#pragma unroll
        for (int ai = 0; ai < 2; ++ai)
#pragma unroll
            for (int m = 0; m < 4; ++m) {
                const int row = rbase + ai * 128 + m * 16; const float r1 = rp[ai * 128 + m * 16];
                bf16_t* rowp = O + (size_t)row * NPROJ + col0;
#pragma unroll
                for (int bj = 0; bj < 2; ++bj) { const f32x4 v0 = acc[ai][bj][m][0] * r1, v1 = acc[ai][bj][m][1] * r1;
                    u32x4 w; w.x = cvt_pk_bf16(v0[0], v0[1]); w.y = cvt_pk_bf16(v0[2], v0[3]); w.z = cvt_pk_bf16(v1[0], v1[1]); w.w = cvt_pk_bf16(v1[2], v1[3]);
                    *(u32x4*)(rowp + bj * 128) = w; } }
    }
};
struct EpiQ {
    static constexpr bool PERM = true, AFTER_DRAIN = false;
    bf16_t* O;
    __device__ __forceinline__ void operator()(const f32x4 (&acc)[2][2][4][2], const pg8::Unit& u, int wr, int wc, int fr, int fq) const {
        const int col0 = u.pn * 256 + wc * 32 + 8 * fq;
#pragma unroll
        for (int ai = 0; ai < 2; ++ai)
#pragma unroll
            for (int m = 0; m < 4; ++m) {
                const int row = u.pm * 256 + ai * 128 + wr * 64 + m * 16 + fr; bf16_t* rowp = O + (size_t)row * D + col0;
#pragma unroll
                for (int bj = 0; bj < 2; ++bj) { const f32x4 v0 = acc[ai][bj][m][0], v1 = acc[ai][bj][m][1];
                    u32x4 w; w.x = cvt_pk_bf16(v0[0], v0[1]); w.y = cvt_pk_bf16(v0[2], v0[3]); w.z = cvt_pk_bf16(v1[0], v1[1]); w.w = cvt_pk_bf16(v1[2], v1[3]);
                    *(u32x4*)(rowp + bj * 128) = w; } }
    }
};
template <bool GATE> struct EpiRes {
    static constexpr bool PERM = true, AFTER_DRAIN = false;
    const bf16_t* rin; bf16_t* hb; float* ssw; const float* ssr; const bf16_t* q;
    __device__ __forceinline__ void operator()(const f32x4 (&acc)[2][2][4][2], const pg8::Unit& u, int wr, int wc, int fr, int fq) const {
        constexpr int MB = GATE ? 2 : 4;
        const int col0 = u.pn * 256 + wc * 32 + 8 * fq, rbase = u.pm * 256 + wr * 64 + fr;
        float rs[2][4];
        if (GATE) rstd8(ssr, rbase, fq, rs);
#pragma unroll
        for (int ai = 0; ai < 2; ++ai)
#pragma unroll
            for (int mb = 0; mb < 4; mb += MB) {
                u32x4 hv[MB][2], qv[MB][2];
#pragma unroll
                for (int mm = 0; mm < MB; ++mm)
#pragma unroll
                    for (int bj = 0; bj < 2; ++bj) { const size_t off = (size_t)(rbase + ai * 128 + (mb + mm) * 16) * D + col0 + bj * 128;
                        hv[mm][bj] = *(const u32x4*)(rin + off); if (GATE) qv[mm][bj] = *(const u32x4*)(q + off); }
#pragma unroll
                for (int mm = 0; mm < MB; ++mm) { const int m = mb + mm, row = rbase + ai * 128 + m * 16; float sq = 0.f;
#pragma unroll
                    for (int bj = 0; bj < 2; ++bj) { const size_t off = (size_t)row * D + col0 + bj * 128;
                        const u32x4 hh = hv[mm][bj]; const f32x4 a0 = acc[ai][bj][m][0], a1 = acc[ai][bj][m][1];
                        float v[8] = {bf_lo(hh.x), bf_hi(hh.x), bf_lo(hh.y), bf_hi(hh.y), bf_lo(hh.z), bf_hi(hh.z), bf_lo(hh.w), bf_hi(hh.w)};
                        const float a[8] = {a0[0], a0[1], a0[2], a0[3], a1[0], a1[1], a1[2], a1[3]};
                        if (GATE) { const float r1 = rs[ai][m]; const u32x4 qq = qv[mm][bj];
                            const float qf[8] = {bf_lo(qq.x), bf_hi(qq.x), bf_lo(qq.y), bf_hi(qq.y), bf_lo(qq.z), bf_hi(qq.z), bf_lo(qq.w), bf_hi(qq.w)};
#pragma unroll
                            for (int k = 0; k < 8; ++k) v[k] += qf[k] * fast_sigmoid(a[k] * r1); }
                        else {
#pragma unroll
                            for (int k = 0; k < 8; ++k) v[k] += a[k]; }
                        u32x4 w; w.x = cvt_pk_bf16(v[0], v[1]); w.y = cvt_pk_bf16(v[2], v[3]); w.z = cvt_pk_bf16(v[4], v[5]); w.w = cvt_pk_bf16(v[6], v[7]);
                        *(u32x4*)(hb + off) = w;
                        const float r0 = bf_lo(w.x), r1v = bf_hi(w.x), r2 = bf_lo(w.y), r3 = bf_hi(w.y), r4 = bf_lo(w.z), r5 = bf_hi(w.z), r6 = bf_lo(w.w), r7 = bf_hi(w.w);
                        sq += ((r0 * r0 + r1v * r1v) + (r2 * r2 + r3 * r3)) + ((r4 * r4 + r5 * r5) + (r6 * r6 + r7 * r7)); }
                    sq += __shfl_xor(sq, 16); sq += __shfl_xor(sq, 32);
                    if (fq == 0) ssw[(size_t)row * 16 + u.pn * 4 + wc] = sq; } }
    }
};
template <bool UP> struct RsOrder : pg8::StaticOrder {
    const float* ss; LAS float* rsbuf; const float* cw; const float* cb; LAS float* pbuf; mutable int na;
    __device__ __forceinline__ void a_ready(const pg8::Unit& u) const {
        int t = threadIdx.x; asm volatile("" : "+v"(t));
        const int par = na & 1; ++na;
        if (UP) { const int qd = t >> 6, c = 2 * (t & 63);
            const float* src = ((qd & 3) == 3 ? cb : cw + (size_t)(qd & 3) * DUP) + (qd >> 2) * DFF + u.pn * 128 + c;
            const f32x2 v = *(const f32x2*)src;
            *(LAS f32x2*)(pbuf + par * 1024 + qd * 128 + c) = v; }
        if (t < 256) { rsbuf[par * 256 + t] = row_rstd(ss, u.pm * 256 + t); }
    }
};
__device__ __forceinline__ f32x2 gelu_tanh2(f32x2 v) {
    const f32x2 t = v * (v * v * 0.044715f + 1.0f), a = t * (-2.302208198f);
    f32x2 e; e.x = __builtin_amdgcn_exp2f(a.x); e.y = __builtin_amdgcn_exp2f(a.y);
    const f32x2 d = e + 1.0f; f32x2 r; r.x = __builtin_amdgcn_rcpf(d.x); r.y = __builtin_amdgcn_rcpf(d.y);
    return v * r;
}
struct EpiUp {
    static constexpr bool PERM = true, AFTER_DRAIN = false;
    bf16_t* act; const LAS float* rsbuf; const LAS float* pbuf; float* head; float* tail; mutable int ne;
    __device__ __forceinline__ void operator()(const f32x4 (&acc)[2][2][4][2], const pg8::Unit& u, int wr, int wc, int fr, int fq) const {
        const LAS float* pp = pbuf + (ne & 1) * 1024 + wc * 32 + 8 * fq; const LAS float* rp = rsbuf + (ne & 1) * 256 + wr * 64 + fr; ++ne;
        const int jg0 = u.pn * 128 + wc * 32 + 8 * fq, rb0 = u.pm * 256 + wr * 64 + fr;
#pragma unroll
        for (int ai = 0; ai < 2; ++ai) {
            const int rbase = rb0 + ai * 128, strip = u.pm * 4 + ai * 2 + wr;
            float rs[4];
#pragma unroll
            for (int m = 0; m < 4; ++m) rs[m] = rp[ai * 128 + m * 16];
            unsigned ow[4][4];
#pragma unroll
            for (int nj = 0; nj < 4; ++nj) {
                const int n = nj >> 1, j0 = 2 * (nj & 1), cl = 4 * n + j0, jg = jg0 + cl;
                const f32x2 w0g = *(const LAS f32x2*)(pp + cl), w1g = *(const LAS f32x2*)(pp + 128 + cl), w2g = *(const LAS f32x2*)(pp + 256 + cl), bg = *(const LAS f32x2*)(pp + 384 + cl);
                const f32x2 w0v = *(const LAS f32x2*)(pp + 512 + cl), w1v = *(const LAS f32x2*)(pp + 640 + cl), w2v = *(const LAS f32x2*)(pp + 768 + cl), bv = *(const LAS f32x2*)(pp + 896 + cl);
                f32x2 pg = {0.f, 0.f}, pv = {0.f, 0.f};
#pragma unroll
                for (int m = 0; m < 4; ++m) {
                    const float r1 = rs[m];
                    const f32x2 ag = {acc[ai][0][m][n][j0], acc[ai][0][m][n][j0 + 1]}, av = {acc[ai][1][m][n][j0], acc[ai][1][m][n][j0 + 1]};
                    const f32x2 xg = ag * r1, xv = av * r1;
                    if (m == 0 && fr < 2) { float* hp = head + ((size_t)(strip * 2 + fr)) * DUP + jg; *(f32x2*)hp = xg; *(f32x2*)(hp + DFF) = xv; }
                    if (m == 3 && fr >= 14) { float* tp = tail + ((size_t)(strip * 2 + fr - 14)) * DUP + jg; *(f32x2*)tp = xg; *(f32x2*)(tp + DFF) = xv; }
                    f32x2 g1, g2, v1, v2;
                    g1.x = dppf<0x111>(xg.x) + dppf<0x10F>(pg.x); g1.y = dppf<0x111>(xg.y) + dppf<0x10F>(pg.y);
                    g2.x = dppf<0x112>(xg.x) + dppf<0x10E>(pg.x); g2.y = dppf<0x112>(xg.y) + dppf<0x10E>(pg.y);
                    v1.x = dppf<0x111>(xv.x) + dppf<0x10F>(pv.x); v1.y = dppf<0x111>(xv.y) + dppf<0x10F>(pv.y);
                    v2.x = dppf<0x112>(xv.x) + dppf<0x10E>(pv.x); v2.y = dppf<0x112>(xv.y) + dppf<0x10E>(pv.y);
                    const f32x2 cgv = w2g * xg + (w1g * g1 + (w0g * g2 + bg));
                    const f32x2 cvv = w2v * xv + (w1v * v1 + (w0v * v2 + bv));
                    const f32x2 o = gelu_tanh2(cgv) * cvv;
                    ow[m][nj] = cvt_pk_bf16(o.x, o.y);
                    pg = xg; pv = xv; } }
#pragma unroll
            for (int m = 0; m < 4; ++m)
                if (!(m == 0 && fr < 2)) { u32x4 w; w.x = ow[m][0]; w.y = ow[m][1]; w.z = ow[m][2]; w.w = ow[m][3]; *(u32x4*)(act + (size_t)(rbase + 16 * m) * DFF + jg0) = w; } }
    }
};
__device__ __forceinline__ void tr_item(const float* W, int ldw, bf16_t* WT, int Kd, int k0, int n0, int sc0, const float* kscale, const float* nscale, LAS float* scr, int lane) {
#pragma unroll
    for (int i = 0; i < 32; ++i) { const int kk = 2 * i + (lane >> 5); float v = W[(size_t)(k0 + kk) * ldw + sc0 + (lane & 31)]; if (kscale) v *= kscale[k0 + kk]; scr[kk * 33 + (lane & 31)] = v; }
    LDS_FENCE();
    const int c = lane & 7;
#pragma unroll
    for (int j = 0; j < 4; ++j) { const int n = (lane >> 3) + 8 * j; const LAS float* s = scr + (8 * c) * 33 + n; const float ns = nscale ? nscale[sc0 + n] : 1.f;
        u32x4 o; o.x = cvt_pk_bf16(s[0] * ns, s[33] * ns); o.y = cvt_pk_bf16(s[2 * 33] * ns, s[3 * 33] * ns); o.z = cvt_pk_bf16(s[4 * 33] * ns, s[5 * 33] * ns); o.w = cvt_pk_bf16(s[6 * 33] * ns, s[7 * 33] * ns);
        *(u32x4*)(WT + (size_t)(n0 + n) * Kd + k0 + 8 * c) = o; }
    LDS_FENCE();
}
__device__ __forceinline__ void phase0(const Params& P, LAS unsigned char* lds, int G, int bid) {
    int tid_ = threadIdx.x; asm volatile("" : "+v"(tid_)); const int tid = tid_, lane = tid & 63, wave = tid >> 6;
    bf16_t* wt = (bf16_t*)(P.ws + OFF_WT);
    LAS float* scr = (LAS float*)(lds + wave * 8704);
    const int gw = bid * 8 + wave, NGW = G * 8;
    constexpr int IPL = 1024 + 512 + 2816 + 1408 + 512 + 128 + 32;
    for (int it = gw; it < NL * IPL; it += NGW) {
        const int l = it / IPL; int r = it % IPL;
        bf16_t* wl = wt + (size_t)l * WLAYER;
        const float* W; int ldw, Kd, kb, nb, sc0; bf16_t* WT; const float* ks = nullptr; const float* ns = nullptr;
        if (r < 1024) { W = P.w_in + (size_t)l * 1024 * 2056; ldw = 2056; Kd = 1024; WT = wl + WIN; ks = P.mix_g + l * 1024; kb = r / 64; nb = r % 64; sc0 = 32 * nb < 1536 ? 32 * nb : 32 * nb + 8; }
        else if ((r -= 1024) < 512) { W = P.w_out + (size_t)l * 1024 * 1024; ldw = 1024; Kd = 1024; WT = wl + WOUT; kb = r / 32; nb = r % 32; sc0 = 32 * nb; }
        else if ((r -= 512) < 2816) { W = P.w_up + (size_t)l * 1024 * DUP; ldw = DUP; Kd = 1024; WT = wl + WUP; ks = P.ffn_g + l * 1024; kb = r / 176; nb = r % 176;
            const int n0 = 32 * nb, pn = n0 >> 8, rr = n0 & 255; sc0 = rr < 128 ? 128 * pn + rr : DFF + 128 * pn + (rr - 128); }
        else if ((r -= 2816) < 1408) { W = P.w_down + (size_t)l * DFF * 1024; ldw = 1024; Kd = DFF; WT = wl + WDOWN; kb = r / 32; nb = r % 32; sc0 = 32 * nb; }
        else if ((r -= 1408) < 512) { W = P.w_gate + (size_t)l * 1024 * 1024; ldw = 1024; Kd = 1024; WT = wl + WGATE; ks = P.ple_g + l * 1024; kb = r / 32; nb = r % 32; sc0 = 32 * nb; }
        else if ((r -= 512) < 128) { W = P.w_ple + (size_t)l * DPLE * 1024; ldw = 1024; Kd = DPLE; WT = wl + WPLE; kb = r / 32; nb = r % 32; sc0 = 32 * nb; }
        else { r -= 128; const int gi = r >> 3, rr = r & 7; kb = rr >> 2; nb = rr & 3; W = P.pool_w + (size_t)(l * 4 + gi) * 128 * 128; ldw = 128; Kd = 128; WT = wl + WPOOL + gi * 128 * 128;
            ns = P.pool_scale + l * 512 + gi * 128; sc0 = 32 * nb; }
        tr_item(W, ldw, WT, Kd, 64 * kb, 32 * nb, sc0, ks, ns, scr, lane);
    }
    for (int idx = bid * 512 + tid; idx < NL * 16 * 1024; idx += G * 512) {
        const int l = idx >> 14, j = (idx >> 10) & 15, k = idx & 1023;
        const float v = j < 8 ? P.w_in[(size_t)l * 1024 * 2056 + (size_t)k * 2056 + 1536 + j] * P.mix_g[l * 1024 + k] : 0.f;
        wt[(size_t)l * WLAYER + WDT + j * 1024 + k] = f2bf(v);
    }
    {
        const f32x4* ps = (const f32x4*)P.p; bf16_t* pb = (bf16_t*)P.out; const int NT = G * 512; constexpr int NV = NL * T * DPLE / 4;
        for (int idx = bid * 512 + tid; idx < NV; idx += 8 * NT) {
            f32x4 v[8];
#pragma unroll
            for (int k = 0; k < 8; ++k) if (idx + k * NT < NV) v[k] = __builtin_nontemporal_load(ps + idx + k * NT);
#pragma unroll
            for (int k = 0; k < 8; ++k) if (idx + k * NT < NV) { u32x2 w; w.x = cvt_pk_bf16(v[k].x, v[k].y); w.y = cvt_pk_bf16(v[k].z, v[k].w); *(u32x2*)(pb + (size_t)(idx + k * NT) * 4) = w; }
        }
    }
    bf16_t* hb0 = (bf16_t*)(P.ws + OFF_HB0); float* ss0 = (float*)(P.ws + OFF_SS);
    for (int row = gw; row < T; row += NGW) {
        const f32x4* xr = (const f32x4*)(P.x + (size_t)row * D) + lane; float s = 0.f;
#pragma unroll
        for (int j = 0; j < 4; ++j) { const f32x4 v = xr[64 * j]; s += (v.x * v.x + v.y * v.y) + (v.z * v.z + v.w * v.w);
            u32x2 w; w.x = cvt_pk_bf16(v.x, v.y); w.y = cvt_pk_bf16(v.z, v.w); *(u32x2*)(hb0 + (size_t)row * D + 4 * lane + 256 * j) = w; }
        s = wave_sum(s);
        if (lane < 16) ss0[(size_t)row * 16 + lane] = lane == 0 ? s : 0.f;
    }
}

#define MFMA32(a, b, c) __builtin_amdgcn_mfma_f32_32x32x16_bf16((a), (b), (c), 0, 0, 0)
__device__ __forceinline__ void conv_load(const bf16_t* proj, long row0, int tl0, bool seqstart, int pcol, unsigned (&v)[11]) {
#pragma unroll
    for (int i = 0; i < 11; ++i) { const int tl = tl0 - 3 + i; v[i] = (tl >= 0 || !seqstart) ? *(const unsigned*)(proj + (size_t)(row0 + tl) * NPROJ + pcol) : 0u; }
}
__device__ __forceinline__ void conv_apply(const unsigned (&v)[11], const float* cw, const float* cb, int xch, float (&o0)[8], float (&o1)[8]) {
    const f32x2 w0 = *(const f32x2*)(cw + xch), w1 = *(const f32x2*)(cw + 1024 + xch), w2 = *(const f32x2*)(cw + 2048 + xch), w3 = *(const f32x2*)(cw + 3072 + xch), bb = *(const f32x2*)(cb + xch);
#pragma unroll
    for (int i = 0; i < 8; ++i) {
        const float a = bb.x + w0.x * bf_lo(v[i]) + w1.x * bf_lo(v[i + 1]) + w2.x * bf_lo(v[i + 2]) + w3.x * bf_lo(v[i + 3]);
        const float b = bb.y + w0.y * bf_hi(v[i]) + w1.y * bf_hi(v[i + 1]) + w2.y * bf_hi(v[i + 2]) + w3.y * bf_hi(v[i + 3]);
        o0[i] = silu_f(a); o1[i] = silu_f(b); }
}
__device__ __forceinline__ float chunk_cumsum(LAS float* dtT, LAS float* acs, int wave, int lane, float Ah) {
    float last = 0.f;
    if (wave < 4) {
        const float a0 = dtT[wave * 128 + 2 * lane] * Ah, a1 = dtT[wave * 128 + 2 * lane + 1] * Ah; float v = a0 + a1;
#pragma unroll
        for (int o = 1; o < 64; o <<= 1) { const float t = __shfl_up(v, o); if (lane >= o) v += t; }
        acs[wave * 128 + 2 * lane] = v - a1; acs[wave * 128 + 2 * lane + 1] = v;
        last = __shfl(v, 63);
    }
    return last;
}
struct SsdCtx { const bf16_t* proj; const bf16_t* hb; const float* ss; const bf16_t* wdt; const float* cw; const float* cb; const float* dt_bias; const float* a_log; const float* d_skip; const float* norm_g;
                bf16_t* states; float* dtbuf; float* cdecay; bf16_t* mix; const bf16_t* pwt; };

__device__ __forceinline__ void ssd_s1_job(const SsdCtx& C, LAS unsigned char* lds, int b, int c, int g) {
    int tid_ = threadIdx.x; asm volatile("" : "+v"(tid_)); const int tid = tid_, lane = tid & 63, wave = tid >> 6;
    LAS bf16_t* XdT = (LAS bf16_t*)lds; LAS bf16_t* BT = (LAS bf16_t*)(lds + 256 * PIT * 2);
    LAS float* dtT = (LAS float*)(lds + 139264); LAS float* acs = dtT + 512;
    const long row0 = (long)b * SEQ + c * 128;
    {
        pg8::f32x4 acc = {0.f, 0.f, 0.f, 0.f};
        const bf16_t* ar = C.hb + (size_t)(row0 + 16 * wave + (lane & 15)) * D + 8 * (lane >> 4);
        const bf16_t* br = C.wdt + (size_t)(lane & 15) * D + 8 * (lane >> 4);
#pragma unroll 1
        for (int kb = 0; kb < 4; ++kb) {
            bf16x8 a[8], bb[8];
#pragma unroll
            for (int i = 0; i < 8; ++i) { a[i] = __builtin_nontemporal_load((const bf16x8*)(ar + 256 * kb + 32 * i)); bb[i] = *(const bf16x8*)(br + 256 * kb + 32 * i); }
#pragma unroll
            for (int i = 0; i < 8; ++i) acc = __builtin_amdgcn_mfma_f32_16x16x32_bf16(a[i], bb[i], acc, 0, 0, 0);
        }
        const int head = lane & 15;
        if (head >= 4 * g && head < 4 * g + 4) {
            const float bias = C.dt_bias[head];
#pragma unroll
            for (int rg = 0; rg < 4; ++rg) { const int tok = 16 * wave + 4 * (lane >> 4) + rg; const float rs = row_rstd(C.ss, (int)(row0 + tok));
                const float dt = softplus_f(acc[rg] * rs + bias); dtT[(head - 4 * g) * 128 + tok] = dt; C.dtbuf[(size_t)(row0 + tok) * 8 + head] = dt; } }
    }
    __syncthreads();
    {
        const float Ah = wave < 4 ? -__expf(C.a_log[4 * g + wave]) : 0.f;
        const float last = chunk_cumsum(dtT, acs, wave, lane, Ah);
        if (wave < 4 && lane == 0) C.cdecay[(size_t)(b * 128 + c) * 8 + 4 * g + wave] = __expf(last);
    }
    __syncthreads();
#pragma unroll 1
    for (int bt = 0; bt < 2; ++bt) {
        unsigned v[3][11];
#pragma unroll
        for (int k = 0; k < 3; ++k) { const int idx = tid + 512 * (3 * bt + k), cp = idx % 192, r = idx / 192; const int xch = cp < 128 ? g * 256 + 2 * cp : 512 + g * 128 + 2 * (cp - 128);
            conv_load(C.proj, row0, 8 * r, c == 0, 512 + xch, v[k]); }
#pragma unroll
        for (int k = 0; k < 3; ++k) { const int idx = tid + 512 * (3 * bt + k), cp = idx % 192, r = idx / 192; const bool isx = cp < 128;
            const int xch = isx ? g * 256 + 2 * cp : 512 + g * 128 + 2 * (cp - 128);
            float o0[8], o1[8];
            conv_apply(v[k], C.cw, C.cb, xch, o0, o1);
            if (isx) { const int hh = cp >> 5; const float al = acs[hh * 128 + 127];
#pragma unroll
                for (int i = 0; i < 8; ++i) { const float sc = dtT[hh * 128 + 8 * r + i] * __expf(al - acs[hh * 128 + 8 * r + i]); o0[i] *= sc; o1[i] *= sc; } }
            LAS bf16_t* dst = isx ? XdT + (2 * cp) * PIT + 8 * r : BT + (2 * (cp - 128)) * PIT + 8 * r;
            u32x4 w0, w1; w0.x = cvt_pk_bf16(o0[0], o0[1]); w0.y = cvt_pk_bf16(o0[2], o0[3]); w0.z = cvt_pk_bf16(o0[4], o0[5]); w0.w = cvt_pk_bf16(o0[6], o0[7]);
            w1.x = cvt_pk_bf16(o1[0], o1[1]); w1.y = cvt_pk_bf16(o1[2], o1[3]); w1.z = cvt_pk_bf16(o1[4], o1[5]); w1.w = cvt_pk_bf16(o1[6], o1[7]);
            *(LAS u32x4*)dst = w0; *(LAS u32x4*)(dst + PIT) = w1; }
    }
    __syncthreads();
    {
        const int hh = wave >> 1, nh = wave & 1, r = lane & 31, hq = lane >> 5;
        f32x16 acc[2][2];
#pragma unroll
        for (int i = 0; i < 2; ++i)
#pragma unroll
            for (int j = 0; j < 2; ++j)
#pragma unroll
                for (int e = 0; e < 16; ++e) acc[i][j][e] = 0.f;
#pragma unroll 2
        for (int ks = 0; ks < 8; ++ks) {
            bf16x8 a[2], bb[2];
#pragma unroll
            for (int i = 0; i < 2; ++i) { a[i] = *(const LAS bf16x8*)(XdT + (64 * hh + 32 * i + r) * PIT + 16 * ks + 8 * hq); bb[i] = *(const LAS bf16x8*)(BT + (64 * nh + 32 * i + r) * PIT + 16 * ks + 8 * hq); }
#pragma unroll
            for (int i = 0; i < 2; ++i)
#pragma unroll
                for (int j = 0; j < 2; ++j) acc[i][j] = MFMA32(a[i], bb[j], acc[i][j]);
        }
        bf16_t* st = C.states + ((size_t)(b * 128 + c) * 8 + 4 * g + hh) * 64 * 128;
#pragma unroll
        for (int i = 0; i < 2; ++i)
#pragma unroll
            for (int j = 0; j < 2; ++j)
#pragma unroll
                for (int e = 0; e < 16; ++e) { const int p = 32 * i + (e & 3) + 8 * (e >> 2) + 4 * hq, n = 64 * nh + 32 * j + r; st[p * 128 + n] = f2bf(acc[i][j][e]); }
    }
    __syncthreads();
}

template <int W> __device__ __forceinline__ void pool_fill(const bf16_t* proj, long row0, bool seqstart, int gi, LAS bf16_t* Pl, int tid) {
    const int cp = tid & 63, run = tid >> 6, pcol = 1536 + gi * 128 + 2 * cp;
    float u0[31], u1[31];
#pragma unroll
    for (int i = 0; i < 31; ++i) { const int tl = 16 * run - 15 + i; const unsigned v = (tl >= 0 || !seqstart) ? *(const unsigned*)(proj + (size_t)(row0 + tl) * NPROJ + pcol) : 0u; u0[i] = bf_lo(v); u1[i] = bf_hi(v); }
    float s0 = 0.f, s1 = 0.f;
#pragma unroll
    for (int j = 1; j < W; ++j) { s0 += u0[15 - j]; s1 += u1[15 - j]; }
#pragma unroll
    for (int i = 0; i < 16; ++i) {
        s0 += u0[15 + i]; s1 += u1[15 + i];
        const int tl = 16 * run + i; const float dv = seqstart ? (float)(tl + 1 < W ? tl + 1 : W) : (float)W; const float inv = 1.f / dv;
        *(LAS unsigned*)(Pl + tl * PIT + 2 * cp) = cvt_pk_bf16(s0 * inv - u0[15 + i], s1 * inv - u1[15 + i]);
        s0 -= u0[15 + i - (W - 1)]; s1 -= u1[15 + i - (W - 1)];
    }
}
__device__ __forceinline__ void pool_job(const SsdCtx& C, LAS unsigned char* lds, int tb, int gi) {
    int tid_ = threadIdx.x; asm volatile("" : "+v"(tid_)); const int tid = tid_, lane = tid & 63, wave = tid >> 6;
    LAS bf16_t* Pl = (LAS bf16_t*)lds; LAS bf16_t* Wp = (LAS bf16_t*)(lds + 128 * PIT * 2);
    const long row0 = (long)tb * 128; const bool seqstart = (tb & 127) == 0;
    for (int i = tid; i < 2048; i += 512) { const int d = i >> 4, c8 = i & 15; *(LAS u32x4*)(Wp + d * PIT + 8 * c8) = *(const u32x4*)(C.pwt + (size_t)gi * 16384 + d * 128 + 8 * c8); }
    if (gi == 0) pool_fill<2>(C.proj, row0, seqstart, gi, Pl, tid); else if (gi == 1) pool_fill<4>(C.proj, row0, seqstart, gi, Pl, tid);
    else if (gi == 2) pool_fill<8>(C.proj, row0, seqstart, gi, Pl, tid); else pool_fill<16>(C.proj, row0, seqstart, gi, Pl, tid);
    __syncthreads();
    {
        const int mi = wave >> 1, r = lane & 31, hq = lane >> 5;
        f32x16 acc[2];
#pragma unroll
        for (int j = 0; j < 2; ++j)
#pragma unroll
            for (int e = 0; e < 16; ++e) acc[j][e] = 0.f;
#pragma unroll 2
        for (int ks = 0; ks < 8; ++ks) {
            const bf16x8 a = *(const LAS bf16x8*)(Pl + (32 * mi + r) * PIT + 16 * ks + 8 * hq);
#pragma unroll
            for (int j = 0; j < 2; ++j) { const int ni = 2 * (wave & 1) + j; const bf16x8 bb = *(const LAS bf16x8*)(Wp + (32 * ni + r) * PIT + 16 * ks + 8 * hq); acc[j] = MFMA32(a, bb, acc[j]); }
        }
#pragma unroll
        for (int j = 0; j < 2; ++j) { const int ni = 2 * (wave & 1) + j;
#pragma unroll
            for (int e = 0; e < 16; ++e) { const int tl = 32 * mi + (e & 3) + 8 * (e >> 2) + 4 * hq; C.mix[(size_t)(row0 + tl) * D + 512 + gi * 128 + 32 * ni + r] = f2bf(acc[j][e]); } }
    }
    __syncthreads();
}

__device__ __forceinline__ void scan_phase(bf16_t* states, const float* cdecay, int G, int bid) {
    int tid_ = threadIdx.x; asm volatile("" : "+v"(tid_));
    for (int idx = bid * 512 + tid_; idx < 2 * 8 * 64 * 128; idx += G * 512) {
        const int n = idx & 127, p = (idx >> 7) & 63, h = (idx >> 13) & 7, b = idx >> 16;
        bf16_t* sp = states + ((size_t)b * 128 * 8 + h) * 8192 + p * 128 + n; const float* dp = cdecay + (size_t)b * 128 * 8 + h;
        float s = 0.f;
        for (int c0 = 0; c0 < 128; c0 += 16) {
            float v[16], d[16];
#pragma unroll
            for (int i = 0; i < 16; ++i) { v[i] = bf2f(sp[(size_t)(c0 + i) * 8 * 8192]); d[i] = dp[(c0 + i) * 8]; }
#pragma unroll
            for (int i = 0; i < 16; ++i) { sp[(size_t)(c0 + i) * 8 * 8192] = f2bf(s); s = s * d[i] + v[i]; }
        }
    }
}
__device__ __forceinline__ void ssd_s3_job(const SsdCtx& C, LAS unsigned char* lds, int b, int c, int g) {
    int tid_ = threadIdx.x; asm volatile("" : "+v"(tid_)); const int tid = tid_, lane = tid & 63, wave = tid >> 6;
    LAS bf16_t* Cn = (LAS bf16_t*)lds; LAS bf16_t* CBm = (LAS bf16_t*)(lds + 128 * PIT * 2); LAS bf16_t* Bn = (LAS bf16_t*)(lds + 256 * PIT * 2); LAS bf16_t* XT = Bn;
    LAS float* dtT = (LAS float*)(lds + 139264); LAS float* acs = dtT + 512; LAS float* red = dtT + 1024;
    const long row0 = (long)b * SEQ + c * 128;
    { const int tok = tid >> 2, hh = tid & 3; dtT[hh * 128 + tok] = C.dtbuf[(size_t)(row0 + tok) * 8 + 4 * g + hh]; }
    __syncthreads();
    { const float Ah = wave < 4 ? -__expf(C.a_log[4 * g + wave]) : 0.f; (void)chunk_cumsum(dtT, acs, wave, lane, Ah); }
    {
        unsigned v[4][11];
#pragma unroll
        for (int k = 0; k < 4; ++k) { const int idx = tid + 512 * k, cp = idx & 127, r = idx >> 7; const int xch = cp < 64 ? 512 + g * 128 + 2 * cp : 768 + g * 128 + 2 * (cp - 64);
            conv_load(C.proj, row0, 8 * r, c == 0, 512 + xch, v[k]); }
#pragma unroll
        for (int k = 0; k < 4; ++k) { const int idx = tid + 512 * k, cp = idx & 127, r = idx >> 7; const bool isB = cp < 64;
            const int xch = isB ? 512 + g * 128 + 2 * cp : 768 + g * 128 + 2 * (cp - 64);
            float o0[8], o1[8];
            conv_apply(v[k], C.cw, C.cb, xch, o0, o1);
            LAS bf16_t* dst = (isB ? Bn + 2 * cp : Cn + 2 * (cp - 64)) + (8 * r) * PIT;
#pragma unroll
            for (int i = 0; i < 8; ++i) *(LAS unsigned*)(dst + i * PIT) = cvt_pk_bf16(o0[i], o1[i]); }
    }
    unsigned vx[4][11];
#pragma unroll
    for (int k = 0; k < 4; ++k) { const int idx = tid + 512 * k, cp = idx & 127, r = idx >> 7; conv_load(C.proj, row0, 8 * r, c == 0, 512 + g * 256 + 2 * cp, vx[k]); }
    __syncthreads();
    {
        const int mi = wave >> 1, r = lane & 31, hq = lane >> 5;
        f32x16 acc[2];
#pragma unroll
        for (int j = 0; j < 2; ++j)
#pragma unroll
            for (int e = 0; e < 16; ++e) acc[j][e] = 0.f;
#pragma unroll 2
        for (int ks = 0; ks < 8; ++ks) {
            const bf16x8 a = *(const LAS bf16x8*)(Cn + (32 * mi + r) * PIT + 16 * ks + 8 * hq);
#pragma unroll
            for (int j = 0; j < 2; ++j) { const int ni = 2 * (wave & 1) + j; const bf16x8 bb = *(const LAS bf16x8*)(Bn + (32 * ni + r) * PIT + 16 * ks + 8 * hq); acc[j] = MFMA32(a, bb, acc[j]); }
        }
#pragma unroll
        for (int j = 0; j < 2; ++j) { const int ni = 2 * (wave & 1) + j;
#pragma unroll
            for (int e = 0; e < 16; ++e) { const int l = 32 * mi + (e & 3) + 8 * (e >> 2) + 4 * hq; CBm[l * PIT + 32 * ni + r] = f2bf(acc[j][e]); } }
    }
    __syncthreads();
#pragma unroll
    for (int k = 0; k < 4; ++k) { const int idx = tid + 512 * k, cp = idx & 127, r = idx >> 7; const int xch = g * 256 + 2 * cp;
        float o0[8], o1[8];
        conv_apply(vx[k], C.cw, C.cb, xch, o0, o1);
        LAS bf16_t* dst = XT + (2 * cp) * PIT + 8 * r;
        u32x4 w0, w1; w0.x = cvt_pk_bf16(o0[0], o0[1]); w0.y = cvt_pk_bf16(o0[2], o0[3]); w0.z = cvt_pk_bf16(o0[4], o0[5]); w0.w = cvt_pk_bf16(o0[6], o0[7]);
        w1.x = cvt_pk_bf16(o1[0], o1[1]); w1.y = cvt_pk_bf16(o1[2], o1[3]); w1.z = cvt_pk_bf16(o1[4], o1[5]); w1.w = cvt_pk_bf16(o1[6], o1[7]);
        *(LAS u32x4*)dst = w0; *(LAS u32x4*)(dst + PIT) = w1; }
    __syncthreads();
    const int hh = wave >> 1, lh = wave & 1, r = lane & 31, hq = lane >> 5, h = 4 * g + hh;
    f32x16 acc[2][2];
#pragma unroll
    for (int i = 0; i < 2; ++i)
#pragma unroll
        for (int j = 0; j < 2; ++j)
#pragma unroll
            for (int e = 0; e < 16; ++e) acc[i][j][e] = 0.f;
    constexpr int ZP = 264;
    LAS bf16_t* zbuf = (LAS bf16_t*)lds;
    u32x4 zr[8];
#pragma unroll
    for (int k = 0; k < 8; ++k) { const int pc = tid + 512 * k, zrow = pc >> 5, c16 = pc & 31; zr[k] = *(const u32x4*)(C.proj + (size_t)(row0 + zrow) * NPROJ + g * 256 + c16 * 8); }
    {
        const bf16_t* pv = C.states + ((size_t)(b * 128 + c) * 8 + h) * 64 * 128;
        bf16x8 pa[8][2];
#pragma unroll
        for (int ks = 0; ks < 8; ++ks)
#pragma unroll
            for (int i = 0; i < 2; ++i) pa[ks][i] = *(const bf16x8*)(pv + (32 * i + r) * 128 + 16 * ks + 8 * hq);
#pragma unroll
        for (int ks = 0; ks < 8; ++ks) {
            bf16x8 bb[2];
#pragma unroll
            for (int i = 0; i < 2; ++i) bb[i] = *(const LAS bf16x8*)(Cn + (64 * lh + 32 * i + r) * PIT + 16 * ks + 8 * hq);
#pragma unroll
            for (int i = 0; i < 2; ++i)
#pragma unroll
                for (int j = 0; j < 2; ++j) acc[i][j] = MFMA32(pa[ks][i], bb[j], acc[i][j]);
        }
#pragma unroll
        for (int j = 0; j < 2; ++j) { const float el = __expf(acs[hh * 128 + 64 * lh + 32 * j + r]);
#pragma unroll
            for (int i = 0; i < 2; ++i)
#pragma unroll
                for (int e = 0; e < 16; ++e) acc[i][j][e] *= el; }
    }
#pragma unroll
    for (int li = 0; li < 2; ++li) {
        const int l = 64 * lh + 32 * li + r; const float al = acs[hh * 128 + l];
        const int nks = 4 * lh + 2 * li + 2;
        for (int ks = 0; ks < nks; ++ks) {
            const int s0 = 16 * ks + 8 * hq;
            const u32x4 cb = *(const LAS u32x4*)(CBm + l * PIT + s0);
            const f32x4 as0 = *(const LAS f32x4*)(acs + hh * 128 + s0), as1 = *(const LAS f32x4*)(acs + hh * 128 + s0 + 4);
            const f32x4 d0 = *(const LAS f32x4*)(dtT + hh * 128 + s0), d1 = *(const LAS f32x4*)(dtT + hh * 128 + s0 + 4);
            float m[8];
            m[0] = bf_lo(cb.x) * __expf(al - as0[0]) * d0[0]; m[1] = bf_hi(cb.x) * __expf(al - as0[1]) * d0[1];
            m[2] = bf_lo(cb.y) * __expf(al - as0[2]) * d0[2]; m[3] = bf_hi(cb.y) * __expf(al - as0[3]) * d0[3];
            m[4] = bf_lo(cb.z) * __expf(al - as1[0]) * d1[0]; m[5] = bf_hi(cb.z) * __expf(al - as1[1]) * d1[1];
            m[6] = bf_lo(cb.w) * __expf(al - as1[2]) * d1[2]; m[7] = bf_hi(cb.w) * __expf(al - as1[3]) * d1[3];
#pragma unroll
            for (int j = 0; j < 8; ++j) m[j] = (s0 + j <= l) ? m[j] : 0.f;
            u32x4 mw; mw.x = cvt_pk_bf16(m[0], m[1]); mw.y = cvt_pk_bf16(m[2], m[3]); mw.z = cvt_pk_bf16(m[4], m[5]); mw.w = cvt_pk_bf16(m[6], m[7]);
            const bf16x8 mf = __builtin_bit_cast(bf16x8, mw);
#pragma unroll
            for (int pi = 0; pi < 2; ++pi) { const bf16x8 a = *(const LAS bf16x8*)(XT + (64 * hh + 32 * pi + r) * PIT + s0); acc[pi][li] = MFMA32(a, mf, acc[pi][li]); }
        }
    }
    __syncthreads();
#pragma unroll
    for (int k = 0; k < 8; ++k) { const int pc = tid + 512 * k, zrow = pc >> 5, c16 = pc & 31; *(LAS u32x4*)(zbuf + zrow * ZP + c16 * 8) = zr[k]; }
    __syncthreads();
    const float Dh = C.d_skip[h];
    float sq[2] = {0.f, 0.f};
#pragma unroll
    for (int li = 0; li < 2; ++li) { const int l = 64 * lh + 32 * li + r;
#pragma unroll
        for (int pi = 0; pi < 2; ++pi)
#pragma unroll
            for (int e4 = 0; e4 < 4; ++e4) { const int p0 = 32 * pi + 8 * e4 + 4 * hq;
                const u32x2 zz = *(const LAS u32x2*)(zbuf + l * ZP + hh * 64 + p0);
                const float zf[4] = {bf_lo(zz.x), bf_hi(zz.x), bf_lo(zz.y), bf_hi(zz.y)};
#pragma unroll
                for (int k = 0; k < 4; ++k) { const float xs = bf2f(XT[(64 * hh + p0 + k) * PIT + l]); float y = acc[pi][li][4 * e4 + k] + xs * Dh; y *= silu_f(zf[k]); acc[pi][li][4 * e4 + k] = y; sq[li] += y * y; } }
        sq[li] += __shfl_xor(sq[li], 32);
        if (hq == 0) red[hh * 128 + l] = sq[li]; }
    __syncthreads();
#pragma unroll
    for (int li = 0; li < 2; ++li) { const int l = 64 * lh + 32 * li + r;
        const float rstd = rsqrtf((red[l] + red[128 + l] + red[256 + l] + red[384 + l]) * (1.f / 256.f) + EPS);
#pragma unroll
        for (int pi = 0; pi < 2; ++pi)
#pragma unroll
            for (int e4 = 0; e4 < 4; ++e4) { const int p0 = 32 * pi + 8 * e4 + 4 * hq, ch = g * 256 + hh * 64 + p0;
                const f32x4 ng = *(const f32x4*)(C.norm_g + ch);
                u32x2 w; w.x = cvt_pk_bf16(acc[pi][li][4 * e4] * rstd * ng[0], acc[pi][li][4 * e4 + 1] * rstd * ng[1]); w.y = cvt_pk_bf16(acc[pi][li][4 * e4 + 2] * rstd * ng[2], acc[pi][li][4 * e4 + 3] * rstd * ng[3]);
                *(LAS u32x2*)(zbuf + l * ZP + hh * 64 + p0) = w; } }
    __syncthreads();
#pragma unroll
    for (int k = 0; k < 8; ++k) { const int pc = tid + 512 * k, zrow = pc >> 5, c16 = pc & 31; *(u32x4*)(C.mix + (size_t)(row0 + zrow) * D + g * 256 + c16 * 8) = *(const LAS u32x4*)(zbuf + zrow * ZP + c16 * 8); }
    __syncthreads();
}

struct FixIn { f32x2 tm2[2], tm1[2], h0[2], h1[2], w0[2], w1[2], w2[2], bb[2]; };
__device__ __forceinline__ void fix_load(const float* head, const float* tail, const float* cw, const float* cb, int s, int j, FixIn& f) {
    const bool first = (s & 255) == 0;
#pragma unroll
    for (int gv = 0; gv < 2; ++gv) { const int col = j + gv * DFF; const f32x2 z = {0.f, 0.f};
        f.tm2[gv] = first ? z : *(const f32x2*)(tail + (size_t)((s - 1) * 2) * DUP + col); f.tm1[gv] = first ? z : *(const f32x2*)(tail + (size_t)((s - 1) * 2 + 1) * DUP + col);
        f.h0[gv] = *(const f32x2*)(head + (size_t)(s * 2) * DUP + col); f.h1[gv] = *(const f32x2*)(head + (size_t)(s * 2 + 1) * DUP + col);
        f.w0[gv] = *(const f32x2*)(cw + col); f.w1[gv] = *(const f32x2*)(cw + DUP + col); f.w2[gv] = *(const f32x2*)(cw + 2 * DUP + col); f.bb[gv] = *(const f32x2*)(cb + col); }
}
__device__ __forceinline__ void fix_apply(const FixIn& f, bf16_t* act, int s, int j) {
    f32x2 c0[2], c1[2];
#pragma unroll
    for (int gv = 0; gv < 2; ++gv) { c0[gv] = f.bb[gv] + f.w0[gv] * f.tm2[gv] + f.w1[gv] * f.tm1[gv] + f.w2[gv] * f.h0[gv]; c1[gv] = f.bb[gv] + f.w0[gv] * f.tm1[gv] + f.w1[gv] * f.h0[gv] + f.w2[gv] * f.h1[gv]; }
    *(unsigned*)(act + (size_t)(64 * s) * DFF + j) = cvt_pk_bf16(gelu_tanh(c0[0].x) * c0[1].x, gelu_tanh(c0[0].y) * c0[1].y);
    *(unsigned*)(act + (size_t)(64 * s + 1) * DFF + j) = cvt_pk_bf16(gelu_tanh(c1[0].x) * c1[1].x, gelu_tanh(c1[0].y) * c1[1].y);
}
__device__ __forceinline__ void fixup_phase(const Params& P, int l, bf16_t* act, const float* head, const float* tail, int G, int bid) {
    const float* cw = P.fconv_w + (size_t)l * 3 * DUP; const float* cb = P.fconv_b + (size_t)l * DUP;
    int tid_ = threadIdx.x; asm volatile("" : "+v"(tid_)); const int gt = bid * 512 + tid_, NT = G * 512;
    constexpr int NI = 512 * (DFF / 2);
    for (int idx = gt; idx < NI; idx += 2 * NT) {
        const int i2 = idx + NT; const bool two = i2 < NI;
        FixIn f0, f1;
        fix_load(head, tail, cw, cb, idx / (DFF / 2), 2 * (idx % (DFF / 2)), f0);
        if (two) fix_load(head, tail, cw, cb, i2 / (DFF / 2), 2 * (i2 % (DFF / 2)), f1);
        fix_apply(f0, act, idx / (DFF / 2), 2 * (idx % (DFF / 2)));
        if (two) fix_apply(f1, act, i2 / (DFF / 2), 2 * (i2 % (DFF / 2)));
    }
}

#define XB_TMO      128
#define XB_XCNT(j)  (256  + 64 * (j))
#define XB_XSUB(j)  (1280 + 64 * (j))
#define XB_XGEN(j)  (2304 + 64 * (j))
#define XB_TOP      3328
#define XB_TOPGEN   3392
#define XCD_BAR_WORDS 3456
#define XB_SPIN_CAP (1u << 18)

__device__ __forceinline__ unsigned xb_ld(unsigned* p)              { return __hip_atomic_load(p, __ATOMIC_RELAXED, __HIP_MEMORY_SCOPE_AGENT); }
__device__ __forceinline__ unsigned xb_add(unsigned* p, unsigned v) { return __hip_atomic_fetch_add(p, v, __ATOMIC_RELAXED, __HIP_MEMORY_SCOPE_AGENT); }
__device__ __forceinline__ unsigned xb_xcc_id() { return (unsigned)__builtin_amdgcn_s_getreg((3 << 11) | 20) & 0xFu; }
#define XB_SPIN(cond, bar) do { unsigned _sp = 0; while (cond) { __builtin_amdgcn_s_sleep(1); \
    if ((++_sp & 255u) == 0u) { if (xb_ld(&(bar)[XB_TMO])) break; if (_sp > XB_SPIN_CAP) { atomicAdd(&(bar)[XB_TMO], 1u); break; } } } } while (0)

struct XcdBarrier {
    unsigned* bar; unsigned x;
    volatile LAS unsigned* st;
};

__device__ __forceinline__ XcdBarrier xcd_barrier_post(unsigned* bar, volatile LAS unsigned* st) {
    XcdBarrier b; b.bar = bar; b.x = xb_xcc_id(); b.st = st;
    if (threadIdx.x == 0) (void)xb_add(&bar[XB_XCNT(b.x)], 1u);
    return b;
}
__device__ __forceinline__ void xcd_barrier_complete(unsigned* bar, unsigned x, unsigned& nloc, unsigned& nx) {
    const unsigned G = gridDim.x * gridDim.y * gridDim.z;
    unsigned sum, cnt, mine, sp = 0u;
    for (;;) {
        sum = 0u; cnt = 0u; mine = 0u;
#pragma unroll
        for (unsigned j = 0; j < 16; ++j) { const unsigned c = xb_ld(&bar[XB_XCNT(j)]); sum += c; cnt += (c > 0u) ? 1u : 0u; mine = (j == x) ? c : mine; }
        if (sum == G) break;
        __builtin_amdgcn_s_sleep(1);
        if ((++sp & 255u) == 0u) { if (xb_ld(&bar[XB_TMO])) break; if (sp > XB_SPIN_CAP) { atomicAdd(&bar[XB_TMO], 1u); break; } }
    }
    nloc = mine > 0u ? mine : 1u; nx = cnt > 0u ? cnt : 1u;
}

__device__ __forceinline__ void xcd_barrier(const XcdBarrier& b) {
    asm volatile("s_waitcnt vmcnt(0)" ::: "memory");
    __syncthreads();
    if (threadIdx.x == 0) {
        unsigned* bar = b.bar;
        __builtin_amdgcn_s_waitcnt(0);
        unsigned nloc = b.st[0], nx = b.st[1];
        if (nloc == 0u) { xcd_barrier_complete(bar, b.x, nloc, nx); b.st[0] = nloc; b.st[1] = nx; }
        const unsigned old = xb_add(&bar[XB_XSUB(b.x)], 1u);
        const unsigned gen = old / nloc;
        if (old + 1u == (gen + 1u) * nloc) {
            __builtin_amdgcn_fence(__ATOMIC_RELEASE, "agent");
            asm volatile("s_waitcnt vmcnt(0)" ::: "memory");
            const unsigned og = xb_add(&bar[XB_TOP], 1u);
            const unsigned tg = og / nx;
            if (og + 1u == (tg + 1u) * nx) xb_add(&bar[XB_TOPGEN], 1u);
            else XB_SPIN(xb_ld(&bar[XB_TOPGEN]) == tg, bar);
            __builtin_amdgcn_fence(__ATOMIC_ACQUIRE, "agent");
            xb_add(&bar[XB_XGEN(b.x)], 1u);
            asm volatile("s_waitcnt vmcnt(0)" ::: "memory");
        } else {
            XB_SPIN(xb_ld(&bar[XB_XGEN(b.x)]) == gen, bar);
            __builtin_amdgcn_fence(__ATOMIC_ACQUIRE, "agent");
            asm volatile("s_waitcnt vmcnt(0)" ::: "memory");
        }
    }
    __syncthreads();
}


__global__ __launch_bounds__(512, 2) void hymba_fwd(Params P) {
    extern __shared__ __attribute__((aligned(16))) unsigned char shm[];
    LAS unsigned char* lds = (LAS unsigned char*)shm;
    cg::grid_group grid = cg::this_grid();
    const int G = (int)gridDim.x, bid = (int)blockIdx.x;
    bf16_t* hbuf[2] = {(bf16_t*)(P.ws + OFF_HB0), (bf16_t*)(P.ws + OFF_HB1)};
    float* ssbuf[2] = {(float*)(P.ws + OFF_SS), (float*)(P.ws + OFF_SS) + (size_t)T * 16};
    bf16_t* wt = (bf16_t*)(P.ws + OFF_WT);
    bf16_t* proj = (bf16_t*)(P.ws + OFF_R); bf16_t* act = proj; bf16_t* states = (bf16_t*)(P.ws + OFF_ST);
    bf16_t* mix = (bf16_t*)(P.ws + OFF_MIX); bf16_t* qb = mix; float* head = (float*)(P.ws + OFF_MIX); float* tail = (float*)(P.ws + OFF_TAIL);
    bf16_t* pball = (bf16_t*)P.out;
    float* dtbuf = (float*)(P.ws + OFF_DT); float* cdecay = (float*)(P.ws + OFF_CD);
    pg8::StaticOrder S;
    volatile LAS unsigned* xst = (volatile LAS unsigned*)(lds + LDS_BYTES - 16);
    if (threadIdx.x == 0) { xst[0] = 0u; xst[1] = 0u; }
    __syncthreads();
    const XcdBarrier xb = xcd_barrier_post((unsigned*)(P.ws + OFF_BAR), xst);

    phase0(P, lds, G, bid);
    grid.sync();
    int cur = 0;
#pragma unroll 1
    for (int l = 0; l < NL; ++l) {
        const bf16_t* wl = wt + (size_t)l * WLAYER;
        bf16_t* hb = cur ? hbuf[1] : hbuf[0]; bf16_t* hbn = cur ? hbuf[0] : hbuf[1];
        float* ss = cur ? ssbuf[1] : ssbuf[0]; float* ssn = cur ? ssbuf[0] : ssbuf[1];
        { RsOrder<false> SR; SR.init(T, NPROJ, G, bid); SR.ss = ss; SR.rsbuf = (LAS float*)(lds + 139264); SR.cw = nullptr; SR.cb = nullptr; SR.pbuf = nullptr; SR.na = 0;
          EpiIn E{proj, (const LAS float*)(lds + 139264), 0}; pg8::gemm_phase<EpiIn, RsOrder<false>, true, true>(lds, pg8::Gemm{hb, wl + WIN, T, NPROJ, D}, SR, E); }
        xcd_barrier(xb);
        SsdCtx C{proj, hb, ss, wl + WDT, P.conv_w + (size_t)l * 4 * 1024, P.conv_b + (size_t)l * 1024, P.dt_bias + l * 8, P.a_log + l * 8, P.d_skip + l * 8, P.norm_g + l * 512,
                 states, dtbuf, cdecay, mix, wl + WPOOL};
        for (int job = bid; job < 512 + 1024; job += G) {
            if (job < 512) ssd_s1_job(C, lds, job >> 8, (job >> 1) & 127, job & 1);
            else { const int j = job - 512; pool_job(C, lds, j >> 2, j & 3); }
        }
        xcd_barrier(xb);
        scan_phase(states, cdecay, G, bid);
        xcd_barrier(xb);
        for (int job = bid; job < 512; job += G) ssd_s3_job(C, lds, job >> 8, (job >> 1) & 127, job & 1);
        xcd_barrier(xb);
        { S.init(T, D, G, bid); EpiRes<false> E{hb, hb, ss, nullptr, nullptr}; pg8::gemm_phase<EpiRes<false>, pg8::StaticOrder, true, true>(lds, pg8::Gemm{mix, wl + WOUT, T, D, D}, S, E); }
        xcd_barrier(xb);
        { RsOrder<true> SU; SU.init(T, DUP, G, bid); SU.ss = ss; SU.rsbuf = (LAS float*)(lds + 139264); SU.cw = P.fconv_w + (size_t)l * 3 * DUP; SU.cb = P.fconv_b + (size_t)l * DUP; SU.pbuf = (LAS float*)(lds + 131072); SU.na = 0;
          EpiUp E{act, (const LAS float*)(lds + 139264), (const LAS float*)(lds + 131072), head, tail, 0}; pg8::gemm_phase<EpiUp, RsOrder<true>, true, true>(lds, pg8::Gemm{hb, wl + WUP, T, DUP, D}, SU, E); }
        xcd_barrier(xb);
        fixup_phase(P, l, act, head, tail, G, bid);
        xcd_barrier(xb);
        { S.init(T, D, G, bid); EpiRes<false> E{hb, hb, ss, nullptr, nullptr}; pg8::gemm_phase<EpiRes<false>, pg8::StaticOrder, true, true>(lds, pg8::Gemm{act, wl + WDOWN, T, D, DFF}, S, E); }
        { S.init(T, D, G, bid); EpiQ E{qb}; pg8::gemm_phase<EpiQ, pg8::StaticOrder, true, true>(lds, pg8::Gemm{pball + (size_t)l * T * DPLE, wl + WPLE, T, D, DPLE}, S, E); }
        xcd_barrier(xb);
        { S.init(T, D, G, bid); EpiRes<true> E{hb, hbn, ssn, ss, qb}; pg8::gemm_phase<EpiRes<true>, pg8::StaticOrder, true, true>(lds, pg8::Gemm{hb, wl + WGATE, T, D, D}, S, E); }
        xcd_barrier(xb);
        cur ^= 1;
    }
    {
        const int lane = threadIdx.x & 63, wave = threadIdx.x >> 6;
        const float* ss = cur ? ssbuf[1] : ssbuf[0]; const bf16_t* hb = cur ? hbuf[1] : hbuf[0];
        for (int row = bid * 8 + wave; row < T; row += G * 8) {
            const float rs = row_rstd(ss, row); const u32x2* hr = (const u32x2*)(hb + (size_t)row * D) + lane; f32x4* xr = (f32x4*)(P.out + (size_t)row * D) + lane; const f32x4* gr = (const f32x4*)P.final_g + lane;
#pragma unroll
            for (int j = 0; j < 4; ++j) { const u32x2 hh = hr[64 * j]; const f32x4 gg = gr[64 * j]; f32x4 v = {bf_lo(hh.x), bf_hi(hh.x), bf_lo(hh.y), bf_hi(hh.y)}; v = v * rs * gg; xr[64 * j] = v; }
        }
    }
}

extern "C" void kernel_launch(void* const* d_in, const int* in_sizes, int n_in, void* d_out, int out_size, void* d_ws, size_t ws_size, hipStream_t stream) {
    static int grid = 0;
    if (grid == 0) {
        if (n_in != 22 || ws_size < WS_END) { fprintf(stderr, "kernel_launch: unexpected inputs (n_in %d, ws %zu, need %zu)\n", n_in, ws_size, (size_t)WS_END); grid = -1; return; }
        int dev = 0, cus = 0, per_cu = 0;
        (void)hipGetDevice(&dev); (void)hipDeviceGetAttribute(&cus, hipDeviceAttributeMultiprocessorCount, dev);
        if (hipFuncSetAttribute((const void*)hymba_fwd, hipFuncAttributeMaxDynamicSharedMemorySize, LDS_BYTES) != hipSuccess) { fprintf(stderr, "kernel_launch: hipFuncSetAttribute failed\n"); grid = -1; return; }
        if (hipOccupancyMaxActiveBlocksPerMultiprocessor(&per_cu, (const void*)hymba_fwd, 512, LDS_BYTES) != hipSuccess || per_cu < 1) { fprintf(stderr, "kernel_launch: occupancy query says %d blocks per CU\n", per_cu); per_cu = 1; }
        (void)hipGetLastError();
        grid = cus;
    }
    if (grid < 0) return;
    Params p{};
    const float** pp = (const float**)&p;
    for (int i = 0; i < 22; ++i) pp[i] = (const float*)d_in[i];
    p.out = (float*)d_out; p.ws = (unsigned char*)d_ws;
    if (hipMemsetAsync((char*)d_ws + OFF_BAR, 0, 16384, stream) != hipSuccess) { fprintf(stderr, "kernel_launch: memset failed\n"); return; }
    void* args[] = {&p};
    hipError_t e = hipLaunchCooperativeKernel((const void*)hymba_fwd, dim3(grid), dim3(512), args, LDS_BYTES, stream);
    if (e != hipSuccess) fprintf(stderr, "cooperative launch failed: %s (grid %d)\n", hipGetErrorString(e), grid);
}
```

```cpp
#include <hip/hip_runtime.h>
#include <hip/hip_cooperative_groups.h>
#include <cstdio>
#include <cstdint>
namespace cg = cooperative_groups;
namespace pg8 {
#define PG8_LAS __attribute__((address_space(3)))
typedef unsigned short bf16_t;
typedef short bf16x8 __attribute__((ext_vector_type(8)));
typedef float f32x4 __attribute__((ext_vector_type(4)));
typedef unsigned u32x4 __attribute__((ext_vector_type(4)));
constexpr int BM = 256, BK = 64, HALF = 128, HTB = HALF * BK * 2  , STAGE_BYTES = 8 * HTB, NXCD = 8, WGM = 8;

__host__ __device__ __forceinline__ int lds_byte(int r, int c) { const int st = (r >> 4) * 2 + (c >> 5), rr = r & 15, cc = c & 31, ob = rr * 64 + cc * 2; return st * 1024 + (ob ^ (((ob >> 9) & 1) << 5)); }
__host__ __device__ __forceinline__ void stage_rc(int b, int& R, int& C) { const int st = b / 1024, sb = b % 1024, swz = sb ^ (((sb >> 9) & 1) << 5); R = (st >> 1) * 16 + swz / 64; C = (st & 1) * 32 + (swz % 64) / 2; }
__host__ __device__ __forceinline__ int perm32(int rho) { const int n = rho >> 4, i = rho & 15; return 8 * (i >> 2) + 4 * n + (i & 3); }

struct Unit { int pm, pn; };
struct Gemm { const bf16_t* A; const bf16_t* Bt; int M, N, K; };

struct StaticOrder {
    int nM, nN, nwg, G, c;
    __host__ __device__ void init(int M, int N, int G_, int c_) { nM = M / BM; nN = N / BM; nwg = nM * nN; G = G_; c = c_; }
    __host__ __device__ bool next(int i, Unit& u) const {
        const long L = (long)i * G + c; if (L >= nwg) return false;
        int wgid = (int)L; { const int q = nwg / NXCD, r = nwg % NXCD, xcd = wgid % NXCD, off = wgid / NXCD; wgid = (xcd < r ? xcd * (q + 1) : r * (q + 1) + (xcd - r) * q) + off; }
        const int nig = WGM * nN, gid = wgid / nig, fm = gid * WGM, gsz = (nM - fm) < WGM ? (nM - fm) : WGM;
        u.pm = fm + ((wgid % nig) % gsz); u.pn = (wgid % nig) / gsz; return true;
    }
    __device__ __forceinline__ void a_ready(const Unit&) const {}
    __device__ __forceinline__ void done(const Unit&) const {}
};
__device__ __forceinline__ unsigned cvt_pk_bf16(float lo, float hi) { unsigned r; asm volatile("v_cvt_pk_bf16_f32 %0, %1, %2" : "=v"(r) : "v"(lo), "v"(hi)); return r; }

template <class Epi, class Sched, bool ALIGN_EPI = false, bool SP2 = false>
__device__ __forceinline__ void gemm_phase(PG8_LAS unsigned char* lds, const Gemm g, const Sched& S, const Epi& E) {
    int tid_ = threadIdx.x; asm volatile("" : "+v"(tid_));
    const int tid = tid_, wid = __builtin_amdgcn_readfirstlane(tid >> 6), lane = tid & 63, wr = wid >> 2, wc = wid & 3, fr = lane & 15, fq = lane >> 4;
    int K_ = g.K; asm volatile("" : "+s"(K_));
    const int K = K_, nt = K / BK;
    unsigned voffA[2], voffB[2];
#pragma unroll
    for (int i = 0; i < 2; ++i) { int R, C; stage_rc(tid * 16 + i * 8192, R, C); const int Rb = Epi::PERM ? ((R & ~31) + perm32(R & 31)) : R;
        voffA[i] = (unsigned)(R * K + C) * 2u; voffB[i] = (unsigned)(Rb * K + C) * 2u; }
    const size_t kstep = (size_t)(BK * 2);
    const size_t hstep = (size_t)HALF * K * 2;
    const size_t tstep = 2 * hstep;
    const unsigned ldsw = (unsigned)wid * 1024u;
    const int aoff = lds_byte(wr * 64 + fr, fq * 8), boff = lds_byte(wc * 32 + fr, fq * 8);
#define PG8_SA(b, h) (((b) * 2 + (h)) * HTB)
#define PG8_SB(b, h) ((4 + (b) * 2 + (h)) * HTB)
#define PG8_STAGE(bufoff, gbase, voff) do { _Pragma("unroll") for (int _i = 0; _i < 2; ++_i) \
        __builtin_amdgcn_global_load_lds((const unsigned*)((const char*)(gbase) + (voff)[_i]), (PG8_LAS unsigned*)(lds + (bufoff) + ldsw + _i * 8192), 16, 0, 0); } while (0)
#define PG8_LDA(dst, b, h) do { _Pragma("unroll") for (int m = 0; m < 4; ++m) _Pragma("unroll") for (int k = 0; k < 2; ++k) dst[m][k] = *(const PG8_LAS bf16x8*)(lds + PG8_SA(b, h) + aoff + m * 2048 + k * 1024); } while (0)
#define PG8_LDB(dst, b, h) do { _Pragma("unroll") for (int n = 0; n < 2; ++n) _Pragma("unroll") for (int k = 0; k < 2; ++k) dst[n][k] = *(const PG8_LAS bf16x8*)(lds + PG8_SB(b, h) + boff + n * 2048 + k * 1024); } while (0)
#define PG8_MMA(ai, bj, At, Bt) do { __builtin_amdgcn_s_setprio(1); _Pragma("unroll") for (int m = 0; m < 4; ++m) _Pragma("unroll") for (int n = 0; n < 2; ++n) _Pragma("unroll") for (int k = 0; k < 2; ++k) \
        acc[ai][bj][m][n] = __builtin_amdgcn_mfma_f32_16x16x32_bf16(Bt[n][k], At[m][k], acc[ai][bj][m][n], 0, 0, 0); __builtin_amdgcn_s_setprio(0); } while (0)
#define PG8_WAIT_V(n) asm volatile("s_waitcnt vmcnt(" #n ")" ::: "memory")
#define PG8_WAIT_L(n) asm volatile("s_waitcnt lgkmcnt(" #n ")" ::: "memory")
#define PG8_BAR __builtin_amdgcn_s_barrier()
#define PG8_SCHED __builtin_amdgcn_sched_barrier(0)
    Unit cur, nxt; int ui = 0;
    if (!S.next(0, cur)) return;
    f32x4 acc[2][2][4][2];
#pragma unroll
    for (int a = 0; a < 2; ++a)
#pragma unroll
        for (int b = 0; b < 2; ++b)
#pragma unroll
            for (int m = 0; m < 4; ++m)
#pragma unroll
                for (int n = 0; n < 2; ++n) acc[a][b][m][n] = (f32x4){0.f, 0.f, 0.f, 0.f};
    bf16x8 At[4][2], B0[2][2], B1[2][2];
    const char* cA = (const char*)g.A + (size_t)cur.pm * tstep; const char* cB = (const char*)g.Bt + (size_t)cur.pn * tstep;
    S.a_ready(cur);
    if constexpr (SP2) {
        PG8_STAGE(PG8_SB(0, 0), cB, voffB); PG8_STAGE(PG8_SB(0, 1), cB + hstep, voffB); PG8_STAGE(PG8_SA(0, 0), cA, voffA); PG8_STAGE(PG8_SA(0, 1), cA + hstep, voffA);
        if (wr == 1) PG8_BAR;
        PG8_WAIT_V(2); PG8_BAR;
        PG8_STAGE(PG8_SB(1, 0), cB + kstep, voffB); PG8_STAGE(PG8_SA(1, 0), cA + kstep, voffA); PG8_STAGE(PG8_SB(1, 1), cB + hstep + kstep, voffB);
        PG8_WAIT_V(6); PG8_BAR;
    } else {
        PG8_STAGE(PG8_SB(0, 0), cB, voffB); PG8_STAGE(PG8_SA(0, 0), cA, voffA); PG8_STAGE(PG8_SB(0, 1), cB + hstep, voffB); PG8_STAGE(PG8_SA(0, 1), cA + hstep, voffA);
        if (wr == 1) PG8_BAR;
        PG8_WAIT_V(4); PG8_BAR;
        PG8_STAGE(PG8_SB(1, 0), cB + kstep, voffB); PG8_STAGE(PG8_SA(1, 0), cA + kstep, voffA); PG8_STAGE(PG8_SB(1, 1), cB + hstep + kstep, voffB);
        PG8_WAIT_V(6); PG8_BAR;
    }
    for (;;) {
        const bool has_next = S.next(ui + 1, nxt);
        const char* nA = has_next ? (const char*)g.A + (size_t)nxt.pm * tstep : cA; const char* nB = has_next ? (const char*)g.Bt + (size_t)nxt.pn * tstep : cB;
        for (int t = 0; t < nt; t += 2) {
            const bool last = (t == nt - 2);
            const char* a1 = cA + (size_t)(t + 1) * kstep;
            const char* a2 = last ? nA : cA + (size_t)(t + 2) * kstep; const char* b2 = last ? nB : cB + (size_t)(t + 2) * kstep;
            const char* a3 = a2 + kstep; const char* b3 = b2 + kstep;
            if (last && has_next) S.a_ready(nxt);
            if constexpr (SP2) {
            PG8_LDB(B0, 0, 0); PG8_LDB(B1, 0, 1); PG8_SCHED; PG8_LDA(At, 0, 0); PG8_STAGE(PG8_SA(1, 1), a1 + hstep, voffA);
            PG8_WAIT_V(8); PG8_WAIT_L(0); PG8_BAR; PG8_MMA(0, 0, At, B0); PG8_MMA(0, 1, At, B1); PG8_BAR; PG8_SCHED;
            PG8_LDA(At, 0, 1); PG8_STAGE(PG8_SB(0, 0), b2, voffB); PG8_STAGE(PG8_SB(0, 1), b2 + hstep, voffB); PG8_STAGE(PG8_SA(0, 0), a2, voffA);
            PG8_WAIT_V(8); PG8_WAIT_L(0); PG8_BAR; PG8_MMA(1, 0, At, B0); PG8_MMA(1, 1, At, B1); PG8_BAR; PG8_SCHED;
            PG8_LDB(B0, 1, 0); PG8_LDB(B1, 1, 1); PG8_SCHED; PG8_LDA(At, 1, 0); PG8_STAGE(PG8_SA(0, 1), a2 + hstep, voffA);
            PG8_WAIT_V(8); PG8_WAIT_L(0); PG8_BAR; PG8_MMA(0, 0, At, B0); PG8_MMA(0, 1, At, B1); PG8_BAR; PG8_SCHED;
            PG8_LDA(At, 1, 1); PG8_STAGE(PG8_SB(1, 0), b3, voffB); PG8_STAGE(PG8_SB(1, 1), b3 + hstep, voffB); PG8_STAGE(PG8_SA(1, 0), a3, voffA);
            PG8_WAIT_V(8); PG8_WAIT_L(0); PG8_BAR; PG8_MMA(1, 0, At, B0); PG8_MMA(1, 1, At, B1); PG8_BAR; PG8_SCHED;
            } else {
            PG8_LDB(B0, 0, 0); PG8_SCHED; PG8_LDA(At, 0, 0); PG8_STAGE(PG8_SA(1, 1), a1 + hstep, voffA);
            PG8_WAIT_L(8); PG8_BAR; PG8_WAIT_L(0); PG8_MMA(0, 0, At, B0); PG8_BAR; PG8_SCHED;
            PG8_LDB(B1, 0, 1); PG8_STAGE(PG8_SB(0, 0), b2, voffB);
            PG8_BAR; PG8_WAIT_L(0); PG8_MMA(0, 1, At, B1); PG8_BAR;
            PG8_LDA(At, 0, 1); PG8_STAGE(PG8_SA(0, 0), a2, voffA);
            PG8_BAR; PG8_WAIT_L(0); PG8_MMA(1, 0, At, B0); PG8_BAR; PG8_SCHED;
            PG8_STAGE(PG8_SB(0, 1), b2 + hstep, voffB);
            PG8_WAIT_V(6); PG8_BAR; PG8_MMA(1, 1, At, B1); PG8_BAR;
            PG8_LDB(B0, 1, 0); PG8_SCHED; PG8_LDA(At, 1, 0); PG8_STAGE(PG8_SA(0, 1), a2 + hstep, voffA);
            PG8_WAIT_L(8); PG8_BAR; PG8_WAIT_L(0); PG8_MMA(0, 0, At, B0); PG8_BAR; PG8_SCHED;
            PG8_LDB(B1, 1, 1); PG8_STAGE(PG8_SB(1, 0), b3, voffB);
            PG8_BAR; PG8_WAIT_L(0); PG8_MMA(0, 1, At, B1); PG8_BAR;
            PG8_LDA(At, 1, 1); PG8_STAGE(PG8_SA(1, 0), a3, voffA);
            PG8_BAR; PG8_WAIT_L(0); PG8_MMA(1, 0, At, B0); PG8_BAR; PG8_SCHED;
            PG8_STAGE(PG8_SB(1, 1), b3 + hstep, voffB);
            PG8_WAIT_V(6); PG8_BAR; PG8_MMA(1, 1, At, B1); PG8_BAR;
            }
        }
        if constexpr (ALIGN_EPI) { if (wr == 0) PG8_BAR; }
        if constexpr (!Epi::AFTER_DRAIN) { E(acc, cur, wr, wc, fr, fq); S.done(cur); }
        if (!has_next) break;
#pragma unroll
        for (int a = 0; a < 2; ++a)
#pragma unroll
            for (int b = 0; b < 2; ++b)
#pragma unroll
                for (int m = 0; m < 4; ++m)
#pragma unroll
                    for (int n = 0; n < 2; ++n) acc[a][b][m][n] = (f32x4){0.f, 0.f, 0.f, 0.f};
        cur = nxt; cA = nA; cB = nB; ++ui;
        if constexpr (ALIGN_EPI) { if (wr == 1) PG8_BAR; }
    }
    PG8_WAIT_V(0);
    if constexpr (!ALIGN_EPI) { if (wr == 0) PG8_BAR; }
    PG8_BAR;
    if constexpr (Epi::AFTER_DRAIN) { E.fused(acc, cur, wr, wc, fr, fq, lds, wid, lane); S.done(cur); }
#undef PG8_SA
#undef PG8_SB
#undef PG8_STAGE
#undef PG8_LDA
#undef PG8_LDB
#undef PG8_MMA
#undef PG8_WAIT_V
#undef PG8_WAIT_L
#undef PG8_BAR
#undef PG8_SCHED
}
}
#define LAS __attribute__((address_space(3)))
typedef pg8::bf16_t bf16_t; typedef pg8::bf16x8 bf16x8; typedef pg8::f32x4 f32x4; typedef pg8::u32x4 u32x4;
typedef float f32x16 __attribute__((ext_vector_type(16)));
typedef unsigned u32x2 __attribute__((ext_vector_type(2)));
typedef float f32x2 __attribute__((ext_vector_type(2)));
using pg8::cvt_pk_bf16;

constexpr int T = 32768, D = 1024, SEQ = 16384, NL = 4, NPROJ = 2048, DFF = 2816, DUP = 5632, DPLE = 256;
constexpr float EPS = 1e-6f;
constexpr size_t WIN = 0, WDT = WIN + (size_t)2048 * 1024, WOUT = WDT + (size_t)16 * 1024, WUP = WOUT + (size_t)1024 * 1024, WDOWN = WUP + (size_t)5632 * 1024,
                 WGATE = WDOWN + (size_t)1024 * 2816, WPLE = WGATE + (size_t)1024 * 1024, WPOOL = WPLE + (size_t)1024 * 256, WLAYER = WPOOL + (size_t)4 * 128 * 128;
constexpr size_t OFF_HB0 = 0, OFF_HB1 = OFF_HB0 + (size_t)T * D * 2, OFF_WT = OFF_HB1 + (size_t)T * D * 2, OFF_R = OFF_WT + WLAYER * 2 * NL,
                 OFF_ST = OFF_R + (size_t)T * NPROJ * 2, OFF_MIX = OFF_R + (size_t)T * DFF * 2, OFF_TAIL = OFF_MIX + (size_t)512 * 2 * DUP * 4,
                 OFF_PB = OFF_MIX + (size_t)T * D * 2, OFF_SS = OFF_PB + (size_t)T * DPLE * 2, OFF_DT = OFF_SS + (size_t)2 * T * 16 * 4,
                 OFF_CD = OFF_DT + (size_t)T * 8 * 4, OFF_BAR = OFF_CD + 8192, WS_END = OFF_BAR + 16384;
static_assert(OFF_ST + (size_t)2 * 128 * 8 * 64 * 128 * 2 <= OFF_MIX, "states must fit behind proj");
static_assert(WS_END <= (size_t)512 * 1024 * 1024, "workspace");
constexpr int LDS_BYTES = 147456;
constexpr int PIT = 136;

struct Params {
    const float *x, *p, *mix_g, *w_in, *conv_w, *conv_b, *dt_bias, *a_log, *d_skip, *norm_g, *pool_w, *pool_scale, *w_out, *ffn_g, *w_up, *fconv_w, *fconv_b, *w_down,
        *ple_g, *w_gate, *w_ple, *final_g;
    float* out; unsigned char* ws;
};

__device__ __forceinline__ float bf_lo(unsigned u) { return __uint_as_float(u << 16); }
__device__ __forceinline__ float bf_hi(unsigned u) { return __uint_as_float(u & 0xffff0000u); }
__device__ __forceinline__ float bf2f(bf16_t b) { return __uint_as_float(((unsigned)b) << 16); }
__device__ __forceinline__ bf16_t f2bf(float f) { return (bf16_t)(cvt_pk_bf16(f, 0.f) & 0xffffu); }
__device__ __forceinline__ float fast_sigmoid(float v) { return __builtin_amdgcn_rcpf(1.f + __builtin_amdgcn_exp2f(-1.4426950409f * v)); }
__device__ __forceinline__ float silu_f(float v) { return v * fast_sigmoid(v); }
__device__ __forceinline__ float gelu_tanh(float v) { const float t = v * (1.f + 0.044715f * v * v); return v * __builtin_amdgcn_rcpf(1.f + __builtin_amdgcn_exp2f(-2.302208198f * t)); }
__device__ __forceinline__ float softplus_f(float v) { return v > 20.f ? v : log1pf(__expf(v)); }
__device__ __forceinline__ float wave_sum(float v) {
#pragma unroll
    for (int o = 1; o < 64; o <<= 1) v += __shfl_xor(v, o);
    return v;
}
template <int CTRL> __device__ __forceinline__ float dppf(float v) { return __builtin_bit_cast(float, __builtin_amdgcn_update_dpp(0, __builtin_bit_cast(int, v), CTRL, 0xf, 0xf, true)); }
__device__ __forceinline__ float row_rstd(const float* ss, int row) {
    const f32x4* p = (const f32x4*)(ss + (size_t)row * 16);
    const f32x4 a = p[0], b = p[1], c = p[2], d = p[3];
    const float s = ((a.x + a.y) + (a.z + a.w)) + ((b.x + b.y) + (b.z + b.w)) + ((c.x + c.y) + (c.z + c.w)) + ((d.x + d.y) + (d.z + d.w));
    return rsqrtf(s * (1.f / 1024.f) + EPS);
}
__device__ __forceinline__ float row_rstd_coop(const float* ss, int row, int fq) {
    const f32x4 a = *(const f32x4*)(ss + (size_t)row * 16 + 4 * fq);
    float s = (a.x + a.y) + (a.z + a.w);
    s += __shfl_xor(s, 16); s += __shfl_xor(s, 32);
    return rsqrtf(s * (1.f / 1024.f) + EPS);
}
__device__ __forceinline__ void rstd8(const float* ss, int rbase, int fq, float (&rs)[2][4]) {
    f32x4 a[2][4];
#pragma unroll
    for (int ai = 0; ai < 2; ++ai)
#pragma unroll
        for (int m = 0; m < 4; ++m) a[ai][m] = *(const f32x4*)(ss + (size_t)(rbase + ai * 128 + m * 16) * 16 + 4 * fq);
#pragma unroll
    for (int ai = 0; ai < 2; ++ai)
#pragma unroll
        for (int m = 0; m < 4; ++m) { float s = (a[ai][m].x + a[ai][m].y) + (a[ai][m].z + a[ai][m].w); s += __shfl_xor(s, 16); s += __shfl_xor(s, 32); rs[ai][m] = rsqrtf(s * (1.f / 1024.f) + EPS); }
}
__device__ __forceinline__ void rstd4(const float* ss, int rbase, int fq, float (&rs)[4]) {
    f32x4 a[4];
#pragma unroll
    for (int m = 0; m < 4; ++m) a[m] = *(const f32x4*)(ss + (size_t)(rbase + m * 16) * 16 + 4 * fq);
#pragma unroll
    for (int m = 0; m < 4; ++m) { float s = (a[m].x + a[m].y) + (a[m].z + a[m].w); s += __shfl_xor(s, 16); s += __shfl_xor(s, 32); rs[m] = rsqrtf(s * (1.f / 1024.f) + EPS); }
}
#define LDS_FENCE() asm volatile("s_waitcnt lgkmcnt(0)" ::: "memory")

struct EpiIn {
    static constexpr bool PERM = true, AFTER_DRAIN = false;
    bf16_t* O; const LAS float* rsbuf; mutable int ne;
    __device__ __forceinline__ void operator()(const f32x4 (&acc)[2][2][4][2], const pg8::Unit& u, int wr, int wc, int fr, int fq) const {
        const int col0 = u.pn * 256 + wc * 32 + 8 * fq, rbase = u.pm * 256 + wr * 64 + fr;
        const LAS float* rp = rsbuf + (ne & 1) * 256 + wr * 64 + fr; ++ne;
#pragma unroll
        for (int ai = 0; ai < 2; ++ai)
#pragma unroll
            for (int m = 0; m < 4; ++m) {
                const int row = rbase + ai * 128 + m * 16; const float r1 = rp[ai * 128 + m * 16];
                bf16_t* rowp = O + (size_t)row * NPROJ + col0;
#pragma unroll
                for (int bj = 0; bj < 2; ++bj) { const f32x4 v0 = acc[ai][bj][m][0] * r1, v1 = acc[ai][bj][m][1] * r1;
                    u32x4 w; w.x = cvt_pk_bf16(v0[0], v0[1]); w.y = cvt_pk_bf16(v0[2], v0[3]); w.z = cvt_pk_bf16(v1[0], v1[1]); w.w = cvt_pk_bf16(v1[2], v1[3]);
                    *(u32x4*)(rowp + bj * 128) = w; } }
    }
};
struct EpiQ {
    static constexpr bool PERM = true, AFTER_DRAIN = false;
    bf16_t* O;
    __device__ __forceinline__ void operator()(const f32x4 (&acc)[2][2][4][2], const pg8::Unit& u, int wr, int wc, int fr, int fq) const {
        const int col0 = u.pn * 256 + wc * 32 + 8 * fq;
#pragma unroll
        for (int ai = 0; ai < 2; ++ai)
#pragma unroll
            for (int m = 0; m < 4; ++m) {
                const int row = u.pm * 256 + ai * 128 + wr * 64 + m * 16 + fr; bf16_t* rowp = O + (size_t)row * D + col0;
#pragma unroll
                for (int bj = 0; bj < 2; ++bj) { const f32x4 v0 = acc[ai][bj][m][0], v1 = acc[ai][bj][m][1];
                    u32x4 w; w.x = cvt_pk_bf16(v0[0], v0[1]); w.y = cvt_pk_bf16(v0[2], v0[3]); w.z = cvt_pk_bf16(v1[0], v1[1]); w.w = cvt_pk_bf16(v1[2], v1[3]);
                    *(u32x4*)(rowp + bj * 128) = w; } }
    }
};
template <bool GATE> struct EpiRes {
    static constexpr bool PERM = true, AFTER_DRAIN = false;
    const bf16_t* rin; bf16_t* hb; float* ssw; const float* ssr; const bf16_t* q;
    __device__ __forceinline__ void operator()(const f32x4 (&acc)[2][2][4][2], const pg8::Unit& u, int wr, int wc, int fr, int fq) const {
        constexpr int MB = GATE ? 2 : 4;
        const int col0 = u.pn * 256 + wc * 32 + 8 * fq, rbase = u.pm * 256 + wr * 64 + fr;
        float rs[2][4];
        if (GATE) rstd8(ssr, rbase, fq, rs);
#pragma unroll
        for (int ai = 0; ai < 2; ++ai)
#pragma unroll
            for (int mb = 0; mb < 4; mb += MB) {
                u32x4 hv[MB][2], qv[MB][2];
#pragma unroll
                for (int mm = 0; mm < MB; ++mm)
#pragma unroll
                    for (int bj = 0; bj < 2; ++bj) { const size_t off = (size_t)(rbase + ai * 128 + (mb + mm) * 16) * D + col0 + bj * 128;
                        hv[mm][bj] = *(const u32x4*)(rin + off); if (GATE) qv[mm][bj] = *(const u32x4*)(q + off); }
#pragma unroll
                for (int mm = 0; mm < MB; ++mm) { const int m = mb + mm, row = rbase + ai * 128 + m * 16; float sq = 0.f;
#pragma unroll
                    for (int bj = 0; bj < 2; ++bj) { const size_t off = (size_t)row * D + col0 + bj * 128;
                        const u32x4 hh = hv[mm][bj]; const f32x4 a0 = acc[ai][bj][m][0], a1 = acc[ai][bj][m][1];
                        float v[8] = {bf_lo(hh.x), bf_hi(hh.x), bf_lo(hh.y), bf_hi(hh.y), bf_lo(hh.z), bf_hi(hh.z), bf_lo(hh.w), bf_hi(hh.w)};
                        const float a[8] = {a0[0], a0[1], a0[2], a0[3], a1[0], a1[1], a1[2], a1[3]};
                        if (GATE) { const float r1 = rs[ai][m]; const u32x4 qq = qv[mm][bj];
                            const float qf[8] = {bf_lo(qq.x), bf_hi(qq.x), bf_lo(qq.y), bf_hi(qq.y), bf_lo(qq.z), bf_hi(qq.z), bf_lo(qq.w), bf_hi(qq.w)};
#pragma unroll
                            for (int k = 0; k < 8; ++k) v[k] += qf[k] * fast_sigmoid(a[k] * r1); }
                        else {
#pragma unroll
                            for (int k = 0; k < 8; ++k) v[k] += a[k]; }
                        u32x4 w; w.x = cvt_pk_bf16(v[0], v[1]); w.y = cvt_pk_bf16(v[2], v[3]); w.z = cvt_pk_bf16(v[4], v[5]); w.w = cvt_pk_bf16(v[6], v[7]);
                        *(u32x4*)(hb + off) = w;
                        const float r0 = bf_lo(w.x), r1v = bf_hi(w.x), r2 = bf_lo(w.y), r3 = bf_hi(w.y), r4 = bf_lo(w.z), r5 = bf_hi(w.z), r6 = bf_lo(w.w), r7 = bf_hi(w.w);
                        sq += ((r0 * r0 + r1v * r1v) + (r2 * r2 + r3 * r3)) + ((r4 * r4 + r5 * r5) + (r6 * r6 + r7 * r7)); }
                    sq += __shfl_xor(sq, 16); sq += __shfl_xor(sq, 32);
                    if (fq == 0) ssw[(size_t)row * 16 + u.pn * 4 + wc] = sq; } }
    }
};
template <bool UP> struct RsOrder : pg8::StaticOrder {
    const float* ss; LAS float* rsbuf; const float* cw; const float* cb; LAS float* pbuf; mutable int na;
    __device__ __forceinline__ void a_ready(const pg8::Unit& u) const {
        int t = threadIdx.x; asm volatile("" : "+v"(t));
        const int par = na & 1; ++na;
        if (UP) { const int qd = t >> 6, c = 2 * (t & 63);
            const float* src = ((qd & 3) == 3 ? cb : cw + (size_t)(qd & 3) * DUP) + (qd >> 2) * DFF + u.pn * 128 + c;
            const f32x2 v = *(const f32x2*)src;
            *(LAS f32x2*)(pbuf + par * 1024 + qd * 128 + c) = v; }
        if (t < 256) { rsbuf[par * 256 + t] = row_rstd(ss, u.pm * 256 + t); }
    }
};
__device__ __forceinline__ f32x2 gelu_tanh2(f32x2 v) {
    const f32x2 t = v * (v * v * 0.044715f + 1.0f), a = t * (-2.302208198f);
    f32x2 e; e.x = __builtin_amdgcn_exp2f(a.x); e.y = __builtin_amdgcn_exp2f(a.y);
    const f32x2 d = e + 1.0f; f32x2 r; r.x = __builtin_amdgcn_rcpf(d.x); r.y = __builtin_amdgcn_rcpf(d.y);
    return v * r;
}
struct EpiUp {
    static constexpr bool PERM = true, AFTER_DRAIN = false;
    bf16_t* act; const LAS float* rsbuf; const LAS float* pbuf; float* head; float* tail; mutable int ne;
    __device__ __forceinline__ void operator()(const f32x4 (&acc)[2][2][4][2], const pg8::Unit& u, int wr, int wc, int fr, int fq) const {
        const LAS float* pp = pbuf + (ne & 1) * 1024 + wc * 32 + 8 * fq; const LAS float* rp = rsbuf + (ne & 1) * 256 + wr * 64 + fr; ++ne;
        const int jg0 = u.pn * 128 + wc * 32 + 8 * fq, rb0 = u.pm * 256 + wr * 64 + fr;
#pragma unroll
        for (int ai = 0; ai < 2; ++ai) {
            const int rbase = rb0 + ai * 128, strip = u.pm * 4 + ai * 2 + wr;
            float rs[4];
#pragma unroll
            for (int m = 0; m < 4; ++m) rs[m] = rp[ai * 128 + m * 16];
            unsigned ow[4][4];
#pragma unroll
            for (int nj = 0; nj < 4; ++nj) {
                const int n = nj >> 1, j0 = 2 * (nj & 1), cl = 4 * n + j0, jg = jg0 + cl;
                const f32x2 w0g = *(const LAS f32x2*)(pp + cl), w1g = *(const LAS f32x2*)(pp + 128 + cl), w2g = *(const LAS f32x2*)(pp + 256 + cl), bg = *(const LAS f32x2*)(pp + 384 + cl);
                const f32x2 w0v = *(const LAS f32x2*)(pp + 512 + cl), w1v = *(const LAS f32x2*)(pp + 640 + cl), w2v = *(const LAS f32x2*)(pp + 768 + cl), bv = *(const LAS f32x2*)(pp + 896 + cl);
                f32x2 pg = {0.f, 0.f}, pv = {0.f, 0.f};
#pragma unroll
                for (int m = 0; m < 4; ++m) {
                    const float r1 = rs[m];
                    const f32x2 ag = {acc[ai][0][m][n][j0], acc[ai][0][m][n][j0 + 1]}, av = {acc[ai][1][m][n][j0], acc[ai][1][m][n][j0 + 1]};
                    const f32x2 xg = ag * r1, xv = av * r1;
                    if (m == 0 && fr < 2) { float* hp = head + ((size_t)(strip * 2 + fr)) * DUP + jg; *(f32x2*)hp = xg; *(f32x2*)(hp + DFF) = xv; }
                    if (m == 3 && fr >= 14) { float* tp = tail + ((size_t)(strip * 2 + fr - 14)) * DUP + jg; *(f32x2*)tp = xg; *(f32x2*)(tp + DFF) = xv; }
                    f32x2 g1, g2, v1, v2;
                    g1.x = dppf<0x111>(xg.x) + dppf<0x10F>(pg.x); g1.y = dppf<0x111>(xg.y) + dppf<0x10F>(pg.y);
                    g2.x = dppf<0x112>(xg.x) + dppf<0x10E>(pg.x); g2.y = dppf<0x112>(xg.y) + dppf<0x10E>(pg.y);
                    v1.x = dppf<0x111>(xv.x) + dppf<0x10F>(pv.x); v1.y = dppf<0x111>(xv.y) + dppf<0x10F>(pv.y);
                    v2.x = dppf<0x112>(xv.x) + dppf<0x10E>(pv.x); v2.y = dppf<0x112>(xv.y) + dppf<0x10E>(pv.y);
                    const f32x2 cgv = w2g * xg + (w1g * g1 + (w0g * g2 + bg));
                    const f32x2 cvv = w2v * xv + (w1v * v1 + (w0v * v2 + bv));
                    const f32x2 o = gelu_tanh2(cgv) * cvv;
                    ow[m][nj] = cvt_pk_bf16(o.x, o.y);
                    pg = xg; pv = xv; } }
#pragma unroll
            for (int m = 0; m < 4; ++m)
                if (!(m == 0 && fr < 2)) { u32x4 w; w.x = ow[m][0]; w.y = ow[m][1]; w.z = ow[m][2]; w.w = ow[m][3]; *(u32x4*)(act + (size_t)(rbase + 16 * m) * DFF + jg0) = w; } }
    }
};
__device__ __forceinline__ void tr_item(const float* W, int ldw, bf16_t* WT, int Kd, int k0, int n0, int sc0, const float* kscale, const float* nscale, LAS float* scr, int lane) {
#pragma unroll
    for (int i = 0; i < 32; ++i) { const int kk = 2 * i + (lane >> 5); float v = W[(size_t)(k0 + kk) * ldw + sc0 + (lane & 31)]; if (kscale) v *= kscale[k0 + kk]; scr[kk * 33 + (lane & 31)] = v; }
    LDS_FENCE();
    const int c = lane & 7;
#pragma unroll
    for (int j = 0; j < 4; ++j) { const int n = (lane >> 3) + 8 * j; const LAS float* s = scr + (8 * c) * 33 + n; const float ns = nscale ? nscale[sc0 + n] : 1.f;
        u32x4 o; o.x = cvt_pk_bf16(s[0] * ns, s[33] * ns); o.y = cvt_pk_bf16(s[2 * 33] * ns, s[3 * 33] * ns); o.z = cvt_pk_bf16(s[4 * 33] * ns, s[5 * 33] * ns); o.w = cvt_pk_bf16(s[6 * 33] * ns, s[7 * 33] * ns);
        *(u32x4*)(WT + (size_t)(n0 + n) * Kd + k0 + 8 * c) = o; }
    LDS_FENCE();
}
__device__ __forceinline__ void phase0(const Params& P, LAS unsigned char* lds, int G, int bid) {
    int tid_ = threadIdx.x; asm volatile("" : "+v"(tid_)); const int tid = tid_, lane = tid & 63, wave = tid >> 6;
    bf16_t* wt = (bf16_t*)(P.ws + OFF_WT);
    LAS float* scr = (LAS float*)(lds + wave * 8704);
    const int gw = bid * 8 + wave, NGW = G * 8;
    constexpr int IPL = 1024 + 256 + 2816 + 1408 + 512 + 128;
    for (int it = gw; it < NL * IPL; it += NGW) {
        const int l = it / IPL; int r = it % IPL;
        bf16_t* wl = wt + (size_t)l * WLAYER;
        const float* W; int ldw, Kd, kb, nb, sc0; bf16_t* WT; const float* ks = nullptr; const float* ns = nullptr;
        if (r < 1024) { W = P.w_in + (size_t)l * 1024 * 2056; ldw = 2056; Kd = 1024; WT = wl + WIN; ks = P.mix_g + l * 1024; kb = r / 64; nb = r % 64; sc0 = 32 * nb < 1536 ? 32 * nb : 32 * nb + 8; }
        else if ((r -= 1024) < 256) { W = P.w_out + (size_t)l * 1024 * 1024; ldw = 1024; Kd = 1024; WT = wl + WOUT; kb = r / 32; nb = r % 32; sc0 = 32 * nb; }
        else if ((r -= 256) < 2816) { W = P.w_up + (size_t)l * 1024 * DUP; ldw = DUP; Kd = 1024; WT = wl + WUP; ks = P.ffn_g + l * 1024; kb = r / 176; nb = r % 176;
            const int n0 = 32 * nb, pn = n0 >> 8, rr = n0 & 255; sc0 = rr < 128 ? 128 * pn + rr : DFF + 128 * pn + (rr - 128); }
        else if ((r -= 2816) < 1408) { W = P.w_down + (size_t)l * DFF * 1024; ldw = 1024; Kd = DFF; WT = wl + WDOWN; kb = r / 32; nb = r % 32; sc0 = 32 * nb; }
        else if ((r -= 1408) < 512) { W = P.w_gate + (size_t)l * 1024 * 1024; ldw = 1024; Kd = 1024; WT = wl + WGATE; ks = P.ple_g + l * 1024; kb = r / 32; nb = r % 32; sc0 = 32 * nb; }
        else { r -= 512; W = P.w_ple + (size_t)l * DPLE * 1024; ldw = 1024; Kd = DPLE; WT = wl + WPLE; kb = r / 32; nb = r % 32; sc0 = 32 * nb; }
        tr_item(W, ldw, WT, Kd, 64 * kb, 32 * nb, sc0, ks, ns, scr, lane);
    }
    __syncthreads();
    for (int job = bid; job < NL * 64; job += G) {
        const int l = job >> 6, gi = (job >> 4) & 3, nc = job & 15;
        LAS float* pwl = (LAS float*)lds;
        const float* pw = P.pool_w + (size_t)(l * 4 + gi) * 128 * 128; const float* sc = P.pool_scale + l * 512 + gi * 128;
        for (int i = tid; i < 4096; i += 512) { f32x4 v = *(const f32x4*)(pw + 4 * i); const f32x4 s4 = *(const f32x4*)(sc + ((4 * i) & 127)); v = v * s4; *(LAS f32x4*)(pwl + 4 * i) = v; }
        __syncthreads();
        const int n = nc * 64 + lane, cg = wave;
        const float* wo = P.w_out + (size_t)l * 1024 * 1024 + (size_t)(512 + gi * 128) * 1024 + n;
        float a[16];
#pragma unroll
        for (int jj = 0; jj < 16; ++jj) a[jj] = 0.f;
#pragma unroll 2
        for (int d4 = 0; d4 < 32; ++d4) {
            const float w0 = wo[(size_t)(4 * d4) * 1024], w1 = wo[(size_t)(4 * d4 + 1) * 1024], w2 = wo[(size_t)(4 * d4 + 2) * 1024], w3 = wo[(size_t)(4 * d4 + 3) * 1024];
#pragma unroll
            for (int jj = 0; jj < 16; ++jj) { const f32x4 p4 = *(const LAS f32x4*)(pwl + (cg * 16 + jj) * 128 + 4 * d4); a[jj] += (p4.x * w0 + p4.y * w1) + (p4.z * w2 + p4.w * w3); }
        }
        u32x4 o0, o1; o0.x = cvt_pk_bf16(a[0], a[1]); o0.y = cvt_pk_bf16(a[2], a[3]); o0.z = cvt_pk_bf16(a[4], a[5]); o0.w = cvt_pk_bf16(a[6], a[7]);
        o1.x = cvt_pk_bf16(a[8], a[9]); o1.y = cvt_pk_bf16(a[10], a[11]); o1.z = cvt_pk_bf16(a[12], a[13]); o1.w = cvt_pk_bf16(a[14], a[15]);
        bf16_t* dst = wt + (size_t)l * WLAYER + WOUT + (size_t)n * 1024 + 512 + gi * 128 + cg * 16;
        *(u32x4*)dst = o0; *(u32x4*)(dst + 8) = o1;
        __syncthreads();
    }
    for (int idx = bid * 512 + tid; idx < NL * 16 * 1024; idx += G * 512) {
        const int l = idx >> 14, j = (idx >> 10) & 15, k = idx & 1023;
        const float v = j < 8 ? P.w_in[(size_t)l * 1024 * 2056 + (size_t)k * 2056 + 1536 + j] * P.mix_g[l * 1024 + k] : 0.f;
        wt[(size_t)l * WLAYER + WDT + j * 1024 + k] = f2bf(v);
    }
    {
        const f32x4* ps = (const f32x4*)P.p; bf16_t* pb = (bf16_t*)P.out; const int NT = G * 512; constexpr int NV = NL * T * DPLE / 4;
        for (int idx = bid * 512 + tid; idx < NV; idx += 8 * NT) {
            f32x4 v[8];
#pragma unroll
            for (int k = 0; k < 8; ++k) if (idx + k * NT < NV) v[k] = __builtin_nontemporal_load(ps + idx + k * NT);
#pragma unroll
            for (int k = 0; k < 8; ++k) if (idx + k * NT < NV) { u32x2 w; w.x = cvt_pk_bf16(v[k].x, v[k].y); w.y = cvt_pk_bf16(v[k].z, v[k].w); *(u32x2*)(pb + (size_t)(idx + k * NT) * 4) = w; }
        }
    }
    bf16_t* hb0 = (bf16_t*)(P.ws + OFF_HB0); float* ss0 = (float*)(P.ws + OFF_SS);
    for (int row = gw; row < T; row += NGW) {
        const f32x4* xr = (const f32x4*)(P.x + (size_t)row * D) + lane; float s = 0.f;
#pragma unroll
        for (int j = 0; j < 4; ++j) { const f32x4 v = xr[64 * j]; s += (v.x * v.x + v.y * v.y) + (v.z * v.z + v.w * v.w);
            u32x2 w; w.x = cvt_pk_bf16(v.x, v.y); w.y = cvt_pk_bf16(v.z, v.w); *(u32x2*)(hb0 + (size_t)row * D + 4 * lane + 256 * j) = w; }
        s = wave_sum(s);
        if (lane < 16) ss0[(size_t)row * 16 + lane] = lane == 0 ? s : 0.f;
    }
}

#define MFMA32(a, b, c) __builtin_amdgcn_mfma_f32_32x32x16_bf16((a), (b), (c), 0, 0, 0)
__device__ __forceinline__ void conv_load(const bf16_t* proj, long row0, int tl0, bool seqstart, int pcol, unsigned (&v)[11]) {
#pragma unroll
    for (int i = 0; i < 11; ++i) { const int tl = tl0 - 3 + i; v[i] = (tl >= 0 || !seqstart) ? *(const unsigned*)(proj + (size_t)(row0 + tl) * NPROJ + pcol) : 0u; }
}
__device__ __forceinline__ void conv_apply(const unsigned (&v)[11], const float* cw, const float* cb, int xch, float (&o0)[8], float (&o1)[8]) {
    const f32x2 w0 = *(const f32x2*)(cw + xch), w1 = *(const f32x2*)(cw + 1024 + xch), w2 = *(const f32x2*)(cw + 2048 + xch), w3 = *(const f32x2*)(cw + 3072 + xch), bb = *(const f32x2*)(cb + xch);
#pragma unroll
    for (int i = 0; i < 8; ++i) {
        const float a = bb.x + w0.x * bf_lo(v[i]) + w1.x * bf_lo(v[i + 1]) + w2.x * bf_lo(v[i + 2]) + w3.x * bf_lo(v[i + 3]);
        const float b = bb.y + w0.y * bf_hi(v[i]) + w1.y * bf_hi(v[i + 1]) + w2.y * bf_hi(v[i + 2]) + w3.y * bf_hi(v[i + 3]);
        o0[i] = silu_f(a); o1[i] = silu_f(b); }
}
__device__ __forceinline__ float chunk_cumsum(LAS float* dtT, LAS float* acs, int wave, int lane, float Ah) {
    float last = 0.f;
    if (wave < 4) {
        const float a0 = dtT[wave * 128 + 2 * lane] * Ah, a1 = dtT[wave * 128 + 2 * lane + 1] * Ah; float v = a0 + a1;
#pragma unroll
        for (int o = 1; o < 64; o <<= 1) { const float t = __shfl_up(v, o); if (lane >= o) v += t; }
        acs[wave * 128 + 2 * lane] = v - a1; acs[wave * 128 + 2 * lane + 1] = v;
        last = __shfl(v, 63);
    }
    return last;
}
struct SsdCtx { const bf16_t* proj; const bf16_t* hb; const float* ss; const bf16_t* wdt; const float* cw; const float* cb; const float* dt_bias; const float* a_log; const float* d_skip; const float* norm_g;
                bf16_t* states; float* dtbuf; float* cdecay; bf16_t* mix; const bf16_t* pwt; };

__device__ __forceinline__ void ssd_s1_job(const SsdCtx& C, LAS unsigned char* lds, int b, int c, int g) {
    int tid_ = threadIdx.x; asm volatile("" : "+v"(tid_)); const int tid = tid_, lane = tid & 63, wave = tid >> 6;
    LAS bf16_t* XdT = (LAS bf16_t*)lds; LAS bf16_t* BT = (LAS bf16_t*)(lds + 256 * PIT * 2);
    LAS float* dtT = (LAS float*)(lds + 139264); LAS float* acs = dtT + 512;
    const long row0 = (long)b * SEQ + c * 128;
    {
        pg8::f32x4 acc = {0.f, 0.f, 0.f, 0.f};
        const bf16_t* ar = C.hb + (size_t)(row0 + 16 * wave + (lane & 15)) * D + 8 * (lane >> 4);
        const bf16_t* br = C.wdt + (size_t)(lane & 15) * D + 8 * (lane >> 4);
#pragma unroll 1
        for (int kb = 0; kb < 4; ++kb) {
            bf16x8 a[8], bb[8];
#pragma unroll
            for (int i = 0; i < 8; ++i) { a[i] = __builtin_nontemporal_load((const bf16x8*)(ar + 256 * kb + 32 * i)); bb[i] = *(const bf16x8*)(br + 256 * kb + 32 * i); }
#pragma unroll
            for (int i = 0; i < 8; ++i) acc = __builtin_amdgcn_mfma_f32_16x16x32_bf16(a[i], bb[i], acc, 0, 0, 0);
        }
        const int head = lane & 15;
        if (head >= 4 * g && head < 4 * g + 4) {
            const float bias = C.dt_bias[head];
#pragma unroll
            for (int rg = 0; rg < 4; ++rg) { const int tok = 16 * wave + 4 * (lane >> 4) + rg; const float rs = row_rstd(C.ss, (int)(row0 + tok));
                const float dt = softplus_f(acc[rg] * rs + bias); dtT[(head - 4 * g) * 128 + tok] = dt; C.dtbuf[(size_t)(row0 + tok) * 8 + head] = dt; } }
    }
    __syncthreads();
    {
        const float Ah = wave < 4 ? -__expf(C.a_log[4 * g + wave]) : 0.f;
        const float last = chunk_cumsum(dtT, acs, wave, lane, Ah);
        if (wave < 4 && lane == 0) C.cdecay[(size_t)(b * 128 + c) * 8 + 4 * g + wave] = __expf(last);
    }
    __syncthreads();
#pragma unroll 1
    for (int bt = 0; bt < 2; ++bt) {
        unsigned v[3][11];
#pragma unroll
        for (int k = 0; k < 3; ++k) { const int idx = tid + 512 * (3 * bt + k), cp = idx % 192, r = idx / 192; const int xch = cp < 128 ? g * 256 + 2 * cp : 512 + g * 128 + 2 * (cp - 128);
            conv_load(C.proj, row0, 8 * r, c == 0, 512 + xch, v[k]); }
#pragma unroll
        for (int k = 0; k < 3; ++k) { const int idx = tid + 512 * (3 * bt + k), cp = idx % 192, r = idx / 192; const bool isx = cp < 128;
            const int xch = isx ? g * 256 + 2 * cp : 512 + g * 128 + 2 * (cp - 128);
            float o0[8], o1[8];
            conv_apply(v[k], C.cw, C.cb, xch, o0, o1);
            if (isx) { const int hh = cp >> 5; const float al = acs[hh * 128 + 127];
#pragma unroll
                for (int i = 0; i < 8; ++i) { const float sc = dtT[hh * 128 + 8 * r + i] * __expf(al - acs[hh * 128 + 8 * r + i]); o0[i] *= sc; o1[i] *= sc; } }
            LAS bf16_t* dst = isx ? XdT + (2 * cp) * PIT + 8 * r : BT + (2 * (cp - 128)) * PIT + 8 * r;
            u32x4 w0, w1; w0.x = cvt_pk_bf16(o0[0], o0[1]); w0.y = cvt_pk_bf16(o0[2], o0[3]); w0.z = cvt_pk_bf16(o0[4], o0[5]); w0.w = cvt_pk_bf16(o0[6], o0[7]);
            w1.x = cvt_pk_bf16(o1[0], o1[1]); w1.y = cvt_pk_bf16(o1[2], o1[3]); w1.z = cvt_pk_bf16(o1[4], o1[5]); w1.w = cvt_pk_bf16(o1[6], o1[7]);
            *(LAS u32x4*)dst = w0; *(LAS u32x4*)(dst + PIT) = w1; }
    }
    __syncthreads();
    {
        const int hh = wave >> 1, nh = wave & 1, r = lane & 31, hq = lane >> 5;
        f32x16 acc[2][2];
#pragma unroll
        for (int i = 0; i < 2; ++i)
#pragma unroll
            for (int j = 0; j < 2; ++j)
#pragma unroll
                for (int e = 0; e < 16; ++e) acc[i][j][e] = 0.f;
#pragma unroll 2
        for (int ks = 0; ks < 8; ++ks) {
            bf16x8 a[2], bb[2];
#pragma unroll
            for (int i = 0; i < 2; ++i) { a[i] = *(const LAS bf16x8*)(XdT + (64 * hh + 32 * i + r) * PIT + 16 * ks + 8 * hq); bb[i] = *(const LAS bf16x8*)(BT + (64 * nh + 32 * i + r) * PIT + 16 * ks + 8 * hq); }
#pragma unroll
            for (int i = 0; i < 2; ++i)
#pragma unroll
                for (int j = 0; j < 2; ++j) acc[i][j] = MFMA32(a[i], bb[j], acc[i][j]);
        }
        bf16_t* st = C.states + ((size_t)(b * 128 + c) * 8 + 4 * g + hh) * 64 * 128;
#pragma unroll
        for (int i = 0; i < 2; ++i)
#pragma unroll
            for (int j = 0; j < 2; ++j)
#pragma unroll
                for (int e = 0; e < 16; ++e) { const int p = 32 * i + (e & 3) + 8 * (e >> 2) + 4 * hq, n = 64 * nh + 32 * j + r; st[p * 128 + n] = f2bf(acc[i][j][e]); }
    }
    __syncthreads();
}

template <int W> __device__ __forceinline__ void pool_fill(const bf16_t* proj, long row0, bool seqstart, int gi, bf16_t* mix, int tid) {
    const int cp = tid & 63, run = tid >> 6, pcol = 1536 + gi * 128 + 2 * cp;
    float u0[31], u1[31];
#pragma unroll
    for (int i = 0; i < 31; ++i) { const int tl = 16 * run - 15 + i; const unsigned v = (tl >= 0 || !seqstart) ? *(const unsigned*)(proj + (size_t)(row0 + tl) * NPROJ + pcol) : 0u; u0[i] = bf_lo(v); u1[i] = bf_hi(v); }
    float s0 = 0.f, s1 = 0.f;
#pragma unroll
    for (int j = 1; j < W; ++j) { s0 += u0[15 - j]; s1 += u1[15 - j]; }
#pragma unroll
    for (int i = 0; i < 16; ++i) {
        s0 += u0[15 + i]; s1 += u1[15 + i];
        const int tl = 16 * run + i; const float dv = seqstart ? (float)(tl + 1 < W ? tl + 1 : W) : (float)W; const float inv = 1.f / dv;
        *(unsigned*)(mix + (size_t)(row0 + tl) * D + 512 + gi * 128 + 2 * cp) = cvt_pk_bf16(s0 * inv - u0[15 + i], s1 * inv - u1[15 + i]);
        s0 -= u0[15 + i - (W - 1)]; s1 -= u1[15 + i - (W - 1)];
    }
}
__device__ __forceinline__ void pool_job(const SsdCtx& C, int tb) {
    int tid_ = threadIdx.x; asm volatile("" : "+v"(tid_)); const int tid = tid_;
    const long row0 = (long)tb * 128; const bool seqstart = (tb & 127) == 0;
    pool_fill<2>(C.proj, row0, seqstart, 0, C.mix, tid); pool_fill<4>(C.proj, row0, seqstart, 1, C.mix, tid);
    pool_fill<8>(C.proj, row0, seqstart, 2, C.mix, tid); pool_fill<16>(C.proj, row0, seqstart, 3, C.mix, tid);
}

__device__ __forceinline__ void scan_phase(bf16_t* states, const float* cdecay, int G, int bid) {
    int tid_ = threadIdx.x; asm volatile("" : "+v"(tid_));
    for (int idx = bid * 512 + tid_; idx < 2 * 8 * 64 * 128; idx += G * 512) {
        const int n = idx & 127, p = (idx >> 7) & 63, h = (idx >> 13) & 7, b = idx >> 16;
        bf16_t* sp = states + ((size_t)b * 128 * 8 + h) * 8192 + p * 128 + n; const float* dp = cdecay + (size_t)b * 128 * 8 + h;
        float s = 0.f;
        for (int c0 = 0; c0 < 128; c0 += 16) {
            float v[16], d[16];
#pragma unroll
            for (int i = 0; i < 16; ++i) { v[i] = bf2f(sp[(size_t)(c0 + i) * 8 * 8192]); d[i] = dp[(c0 + i) * 8]; }
#pragma unroll
            for (int i = 0; i < 16; ++i) { sp[(size_t)(c0 + i) * 8 * 8192] = f2bf(s); s = s * d[i] + v[i]; }
        }
    }
}
__device__ __forceinline__ void ssd_s3_job(const SsdCtx& C, LAS unsigned char* lds, int b, int c, int g) {
    int tid_ = threadIdx.x; asm volatile("" : "+v"(tid_)); const int tid = tid_, lane = tid & 63, wave = tid >> 6;
    LAS bf16_t* Cn = (LAS bf16_t*)lds; LAS bf16_t* CBm = (LAS bf16_t*)(lds + 128 * PIT * 2); LAS bf16_t* Bn = (LAS bf16_t*)(lds + 256 * PIT * 2); LAS bf16_t* XT = Bn;
    LAS float* dtT = (LAS float*)(lds + 139264); LAS float* acs = dtT + 512; LAS float* red = dtT + 1024;
    const long row0 = (long)b * SEQ + c * 128;
    { const int tok = tid >> 2, hh = tid & 3; dtT[hh * 128 + tok] = C.dtbuf[(size_t)(row0 + tok) * 8 + 4 * g + hh]; }
    __syncthreads();
    { const float Ah = wave < 4 ? -__expf(C.a_log[4 * g + wave]) : 0.f; (void)chunk_cumsum(dtT, acs, wave, lane, Ah); }
    {
        unsigned v[4][11];
#pragma unroll
        for (int k = 0; k < 4; ++k) { const int idx = tid + 512 * k, cp = idx & 127, r = idx >> 7; const int xch = cp < 64 ? 512 + g * 128 + 2 * cp : 768 + g * 128 + 2 * (cp - 64);
            conv_load(C.proj, row0, 8 * r, c == 0, 512 + xch, v[k]); }
#pragma unroll
        for (int k = 0; k < 4; ++k) { const int idx = tid + 512 * k, cp = idx & 127, r = idx >> 7; const bool isB = cp < 64;
            const int xch = isB ? 512 + g * 128 + 2 * cp : 768 + g * 128 + 2 * (cp - 64);
            float o0[8], o1[8];
            conv_apply(v[k], C.cw, C.cb, xch, o0, o1);
            LAS bf16_t* dst = (isB ? Bn + 2 * cp : Cn + 2 * (cp - 64)) + (8 * r) * PIT;
#pragma unroll
            for (int i = 0; i < 8; ++i) *(LAS unsigned*)(dst + i * PIT) = cvt_pk_bf16(o0[i], o1[i]); }
    }
    unsigned vx[4][11];
#pragma unroll
    for (int k = 0; k < 4; ++k) { const int idx = tid + 512 * k, cp = idx & 127, r = idx >> 7; conv_load(C.proj, row0, 8 * r, c == 0, 512 + g * 256 + 2 * cp, vx[k]); }
    __syncthreads();
    {
        const int mi = wave >> 1, r = lane & 31, hq = lane >> 5;
        f32x16 acc[2];
#pragma unroll
        for (int j = 0; j < 2; ++j)
#pragma unroll
            for (int e = 0; e < 16; ++e) acc[j][e] = 0.f;
#pragma unroll 2
        for (int ks = 0; ks < 8; ++ks) {
            const bf16x8 a = *(const LAS bf16x8*)(Cn + (32 * mi + r) * PIT + 16 * ks + 8 * hq);
#pragma unroll
            for (int j = 0; j < 2; ++j) { const int ni = 2 * (wave & 1) + j; const bf16x8 bb = *(const LAS bf16x8*)(Bn + (32 * ni + r) * PIT + 16 * ks + 8 * hq); acc[j] = MFMA32(a, bb, acc[j]); }
        }
#pragma unroll
        for (int j = 0; j < 2; ++j) { const int ni = 2 * (wave & 1) + j;
#pragma unroll
            for (int e = 0; e < 16; ++e) { const int l = 32 * mi + (e & 3) + 8 * (e >> 2) + 4 * hq; CBm[l * PIT + 32 * ni + r] = f2bf(acc[j][e]); } }
    }
    __syncthreads();
#pragma unroll
    for (int k = 0; k < 4; ++k) { const int idx = tid + 512 * k, cp = idx & 127, r = idx >> 7; const int xch = g * 256 + 2 * cp;
        float o0[8], o1[8];
        conv_apply(vx[k], C.cw, C.cb, xch, o0, o1);
        LAS bf16_t* dst = XT + (2 * cp) * PIT + 8 * r;
        u32x4 w0, w1; w0.x = cvt_pk_bf16(o0[0], o0[1]); w0.y = cvt_pk_bf16(o0[2], o0[3]); w0.z = cvt_pk_bf16(o0[4], o0[5]); w0.w = cvt_pk_bf16(o0[6], o0[7]);
        w1.x = cvt_pk_bf16(o1[0], o1[1]); w1.y = cvt_pk_bf16(o1[2], o1[3]); w1.z = cvt_pk_bf16(o1[4], o1[5]); w1.w = cvt_pk_bf16(o1[6], o1[7]);
        *(LAS u32x4*)dst = w0; *(LAS u32x4*)(dst + PIT) = w1; }
    __syncthreads();
    const int hh = wave >> 1, lh = wave & 1, r = lane & 31, hq = lane >> 5, h = 4 * g + hh;
    f32x16 acc[2][2];
#pragma unroll
    for (int i = 0; i < 2; ++i)
#pragma unroll
        for (int j = 0; j < 2; ++j)
#pragma unroll
            for (int e = 0; e < 16; ++e) acc[i][j][e] = 0.f;
    constexpr int ZP = 264;
    LAS bf16_t* zbuf = (LAS bf16_t*)lds;
    u32x4 zr[8];
#pragma unroll
    for (int k = 0; k < 8; ++k) { const int pc = tid + 512 * k, zrow = pc >> 5, c16 = pc & 31; zr[k] = *(const u32x4*)(C.proj + (size_t)(row0 + zrow) * NPROJ + g * 256 + c16 * 8); }
    {
        const bf16_t* pv = C.states + ((size_t)(b * 128 + c) * 8 + h) * 64 * 128;
        bf16x8 pa[8][2];
#pragma unroll
        for (int ks = 0; ks < 8; ++ks)
#pragma unroll
            for (int i = 0; i < 2; ++i) pa[ks][i] = *(const bf16x8*)(pv + (32 * i + r) * 128 + 16 * ks + 8 * hq);
#pragma unroll
        for (int ks = 0; ks < 8; ++ks) {
            bf16x8 bb[2];
#pragma unroll
            for (int i = 0; i < 2; ++i) bb[i] = *(const LAS bf16x8*)(Cn + (64 * lh + 32 * i + r) * PIT + 16 * ks + 8 * hq);
#pragma unroll
            for (int i = 0; i < 2; ++i)
#pragma unroll
                for (int j = 0; j < 2; ++j) acc[i][j] = MFMA32(pa[ks][i], bb[j], acc[i][j]);
        }
#pragma unroll
        for (int j = 0; j < 2; ++j) { const float el = __expf(acs[hh * 128 + 64 * lh + 32 * j + r]);
#pragma unroll
            for (int i = 0; i < 2; ++i)
#pragma unroll
                for (int e = 0; e < 16; ++e) acc[i][j][e] *= el; }
    }
#pragma unroll
    for (int li = 0; li < 2; ++li) {
        const int l = 64 * lh + 32 * li + r; const float al = acs[hh * 128 + l];
        const int nks = 4 * lh + 2 * li + 2;
        for (int ks = 0; ks < nks; ++ks) {
            const int s0 = 16 * ks + 8 * hq;
            const u32x4 cb = *(const LAS u32x4*)(CBm + l * PIT + s0);
            const f32x4 as0 = *(const LAS f32x4*)(acs + hh * 128 + s0), as1 = *(const LAS f32x4*)(acs + hh * 128 + s0 + 4);
            const f32x4 d0 = *(const LAS f32x4*)(dtT + hh * 128 + s0), d1 = *(const LAS f32x4*)(dtT + hh * 128 + s0 + 4);
            float m[8];
            m[0] = bf_lo(cb.x) * __expf(al - as0[0]) * d0[0]; m[1] = bf_hi(cb.x) * __expf(al - as0[1]) * d0[1];
            m[2] = bf_lo(cb.y) * __expf(al - as0[2]) * d0[2]; m[3] = bf_hi(cb.y) * __expf(al - as0[3]) * d0[3];
            m[4] = bf_lo(cb.z) * __expf(al - as1[0]) * d1[0]; m[5] = bf_hi(cb.z) * __expf(al - as1[1]) * d1[1];
            m[6] = bf_lo(cb.w) * __expf(al - as1[2]) * d1[2]; m[7] = bf_hi(cb.w) * __expf(al - as1[3]) * d1[3];
#pragma unroll
            for (int j = 0; j < 8; ++j) m[j] = (s0 + j <= l) ? m[j] : 0.f;
            u32x4 mw; mw.x = cvt_pk_bf16(m[0], m[1]); mw.y = cvt_pk_bf16(m[2], m[3]); mw.z = cvt_pk_bf16(m[4], m[5]); mw.w = cvt_pk_bf16(m[6], m[7]);
            const bf16x8 mf = __builtin_bit_cast(bf16x8, mw);
#pragma unroll
            for (int pi = 0; pi < 2; ++pi) { const bf16x8 a = *(const LAS bf16x8*)(XT + (64 * hh + 32 * pi + r) * PIT + s0); acc[pi][li] = MFMA32(a, mf, acc[pi][li]); }
        }
    }
    __syncthreads();
#pragma unroll
    for (int k = 0; k < 8; ++k) { const int pc = tid + 512 * k, zrow = pc >> 5, c16 = pc & 31; *(LAS u32x4*)(zbuf + zrow * ZP + c16 * 8) = zr[k]; }
    __syncthreads();
    const float Dh = C.d_skip[h];
    float sq[2] = {0.f, 0.f};
#pragma unroll
    for (int li = 0; li < 2; ++li) { const int l = 64 * lh + 32 * li + r;
#pragma unroll
        for (int pi = 0; pi < 2; ++pi)
#pragma unroll
            for (int e4 = 0; e4 < 4; ++e4) { const int p0 = 32 * pi + 8 * e4 + 4 * hq;
                const u32x2 zz = *(const LAS u32x2*)(zbuf + l * ZP + hh * 64 + p0);
                const float zf[4] = {bf_lo(zz.x), bf_hi(zz.x), bf_lo(zz.y), bf_hi(zz.y)};
#pragma unroll
                for (int k = 0; k < 4; ++k) { const float xs = bf2f(XT[(64 * hh + p0 + k) * PIT + l]); float y = acc[pi][li][4 * e4 + k] + xs * Dh; y *= silu_f(zf[k]); acc[pi][li][4 * e4 + k] = y; sq[li] += y * y; } }
        sq[li] += __shfl_xor(sq[li], 32);
        if (hq == 0) red[hh * 128 + l] = sq[li]; }
    __syncthreads();
#pragma unroll
    for (int li = 0; li < 2; ++li) { const int l = 64 * lh + 32 * li + r;
        const float rstd = rsqrtf((red[l] + red[128 + l] + red[256 + l] + red[384 + l]) * (1.f / 256.f) + EPS);
#pragma unroll
        for (int pi = 0; pi < 2; ++pi)
#pragma unroll
            for (int e4 = 0; e4 < 4; ++e4) { const int p0 = 32 * pi + 8 * e4 + 4 * hq, ch = g * 256 + hh * 64 + p0;
                const f32x4 ng = *(const f32x4*)(C.norm_g + ch);
                u32x2 w; w.x = cvt_pk_bf16(acc[pi][li][4 * e4] * rstd * ng[0], acc[pi][li][4 * e4 + 1] * rstd * ng[1]); w.y = cvt_pk_bf16(acc[pi][li][4 * e4 + 2] * rstd * ng[2], acc[pi][li][4 * e4 + 3] * rstd * ng[3]);
                *(LAS u32x2*)(zbuf + l * ZP + hh * 64 + p0) = w; } }
    __syncthreads();
#pragma unroll
    for (int k = 0; k < 8; ++k) { const int pc = tid + 512 * k, zrow = pc >> 5, c16 = pc & 31; *(u32x4*)(C.mix + (size_t)(row0 + zrow) * D + g * 256 + c16 * 8) = *(const LAS u32x4*)(zbuf + zrow * ZP + c16 * 8); }
    __syncthreads();
}

struct FixIn { f32x2 tm2[2], tm1[2], h0[2], h1[2], w0[2], w1[2], w2[2], bb[2]; };
__device__ __forceinline__ void fix_load(const float* head, const float* tail, const float* cw, const float* cb, int s, int j, FixIn& f) {
    const bool first = (s & 255) == 0;
#pragma unroll
    for (int gv = 0; gv < 2; ++gv) { const int col = j + gv * DFF; const f32x2 z = {0.f, 0.f};
        f.tm2[gv] = first ? z : *(const f32x2*)(tail + (size_t)((s - 1) * 2) * DUP + col); f.tm1[gv] = first ? z : *(const f32x2*)(tail + (size_t)((s - 1) * 2 + 1) * DUP + col);
        f.h0[gv] = *(const f32x2*)(head + (size_t)(s * 2) * DUP + col); f.h1[gv] = *(const f32x2*)(head + (size_t)(s * 2 + 1) * DUP + col);
        f.w0[gv] = *(const f32x2*)(cw + col); f.w1[gv] = *(const f32x2*)(cw + DUP + col); f.w2[gv] = *(const f32x2*)(cw + 2 * DUP + col); f.bb[gv] = *(const f32x2*)(cb + col); }
}
__device__ __forceinline__ void fix_apply(const FixIn& f, bf16_t* act, int s, int j) {
    f32x2 c0[2], c1[2];
#pragma unroll
    for (int gv = 0; gv < 2; ++gv) { c0[gv] = f.bb[gv] + f.w0[gv] * f.tm2[gv] + f.w1[gv] * f.tm1[gv] + f.w2[gv] * f.h0[gv]; c1[gv] = f.bb[gv] + f.w0[gv] * f.tm1[gv] + f.w1[gv] * f.h0[gv] + f.w2[gv] * f.h1[gv]; }
    *(unsigned*)(act + (size_t)(64 * s) * DFF + j) = cvt_pk_bf16(gelu_tanh(c0[0].x) * c0[1].x, gelu_tanh(c0[0].y) * c0[1].y);
    *(unsigned*)(act + (size_t)(64 * s + 1) * DFF + j) = cvt_pk_bf16(gelu_tanh(c1[0].x) * c1[1].x, gelu_tanh(c1[0].y) * c1[1].y);
}
__device__ __forceinline__ void fixup_phase(const Params& P, int l, bf16_t* act, const float* head, const float* tail, int G, int bid) {
    const float* cw = P.fconv_w + (size_t)l * 3 * DUP; const float* cb = P.fconv_b + (size_t)l * DUP;
    int tid_ = threadIdx.x; asm volatile("" : "+v"(tid_)); const int gt = bid * 512 + tid_, NT = G * 512;
    constexpr int NI = 512 * (DFF / 2);
    for (int idx = gt; idx < NI; idx += 2 * NT) {
        const int i2 = idx + NT; const bool two = i2 < NI;
        FixIn f0, f1;
        fix_load(head, tail, cw, cb, idx / (DFF / 2), 2 * (idx % (DFF / 2)), f0);
        if (two) fix_load(head, tail, cw, cb, i2 / (DFF / 2), 2 * (i2 % (DFF / 2)), f1);
        fix_apply(f0, act, idx / (DFF / 2), 2 * (idx % (DFF / 2)));
        if (two) fix_apply(f1, act, i2 / (DFF / 2), 2 * (i2 % (DFF / 2)));
    }
}

#define XB_TMO      128
#define XB_XCNT(j)  (256  + 64 * (j))
#define XB_XSUB(j)  (1280 + 64 * (j))
#define XB_XGEN(j)  (2304 + 64 * (j))
#define XB_TOP      3328
#define XB_TOPGEN   3392
#define XCD_BAR_WORDS 3456
#define XB_SPIN_CAP (1u << 18)

__device__ __forceinline__ unsigned xb_ld(unsigned* p)              { return __hip_atomic_load(p, __ATOMIC_RELAXED, __HIP_MEMORY_SCOPE_AGENT); }
__device__ __forceinline__ unsigned xb_add(unsigned* p, unsigned v) { return __hip_atomic_fetch_add(p, v, __ATOMIC_RELAXED, __HIP_MEMORY_SCOPE_AGENT); }
__device__ __forceinline__ unsigned xb_xcc_id() { return (unsigned)__builtin_amdgcn_s_getreg((3 << 11) | 20) & 0xFu; }
#define XB_SPIN(cond, bar) do { unsigned _sp = 0; while (cond) { __builtin_amdgcn_s_sleep(1); \
    if ((++_sp & 255u) == 0u) { if (xb_ld(&(bar)[XB_TMO])) break; if (_sp > XB_SPIN_CAP) { atomicAdd(&(bar)[XB_TMO], 1u); break; } } } } while (0)

struct XcdBarrier {
    unsigned* bar; unsigned x;
    volatile LAS unsigned* st;
};

__device__ __forceinline__ XcdBarrier xcd_barrier_post(unsigned* bar, volatile LAS unsigned* st) {
    XcdBarrier b; b.bar = bar; b.x = xb_xcc_id(); b.st = st;
    if (threadIdx.x == 0) (void)xb_add(&bar[XB_XCNT(b.x)], 1u);
    return b;
}
__device__ __forceinline__ void xcd_barrier_complete(unsigned* bar, unsigned x, unsigned& nloc, unsigned& nx) {
    const unsigned G = gridDim.x * gridDim.y * gridDim.z;
    unsigned sum, cnt, mine, sp = 0u;
    for (;;) {
        sum = 0u; cnt = 0u; mine = 0u;
#pragma unroll
        for (unsigned j = 0; j < 16; ++j) { const unsigned c = xb_ld(&bar[XB_XCNT(j)]); sum += c; cnt += (c > 0u) ? 1u : 0u; mine = (j == x) ? c : mine; }
        if (sum == G) break;
        __builtin_amdgcn_s_sleep(1);
        if ((++sp & 255u) == 0u) { if (xb_ld(&bar[XB_TMO])) break; if (sp > XB_SPIN_CAP) { atomicAdd(&bar[XB_TMO], 1u); break; } }
    }
    nloc = mine > 0u ? mine : 1u; nx = cnt > 0u ? cnt : 1u;
}

__device__ __forceinline__ void xcd_barrier(const XcdBarrier& b) {
    asm volatile("s_waitcnt vmcnt(0)" ::: "memory");
    __syncthreads();
    if (threadIdx.x == 0) {
        unsigned* bar = b.bar;
        __builtin_amdgcn_s_waitcnt(0);
        unsigned nloc = b.st[0], nx = b.st[1];
        if (nloc == 0u) { xcd_barrier_complete(bar, b.x, nloc, nx); b.st[0] = nloc; b.st[1] = nx; }
        const unsigned old = xb_add(&bar[XB_XSUB(b.x)], 1u);
        const unsigned gen = old / nloc;
        if (old + 1u == (gen + 1u) * nloc) {
            __builtin_amdgcn_fence(__ATOMIC_RELEASE, "agent");
            asm volatile("s_waitcnt vmcnt(0)" ::: "memory");
            const unsigned og = xb_add(&bar[XB_TOP], 1u);
            const unsigned tg = og / nx;
            if (og + 1u == (tg + 1u) * nx) xb_add(&bar[XB_TOPGEN], 1u);
            else XB_SPIN(xb_ld(&bar[XB_TOPGEN]) == tg, bar);
            __builtin_amdgcn_fence(__ATOMIC_ACQUIRE, "agent");
            xb_add(&bar[XB_XGEN(b.x)], 1u);
            asm volatile("s_waitcnt vmcnt(0)" ::: "memory");
        } else {
            XB_SPIN(xb_ld(&bar[XB_XGEN(b.x)]) == gen, bar);
            __builtin_amdgcn_fence(__ATOMIC_ACQUIRE, "agent");
            asm volatile("s_waitcnt vmcnt(0)" ::: "memory");
        }
    }
    __syncthreads();
}


__global__ __launch_bounds__(512, 2) void hymba_fwd(Params P) {
    extern __shared__ __attribute__((aligned(16))) unsigned char shm[];
    LAS unsigned char* lds = (LAS unsigned char*)shm;
    cg::grid_group grid = cg::this_grid();
    const int G = (int)gridDim.x, bid = (int)blockIdx.x;
    bf16_t* hbuf[2] = {(bf16_t*)(P.ws + OFF_HB0), (bf16_t*)(P.ws + OFF_HB1)};
    float* ssbuf[2] = {(float*)(P.ws + OFF_SS), (float*)(P.ws + OFF_SS) + (size_t)T * 16};
    bf16_t* wt = (bf16_t*)(P.ws + OFF_WT);
    bf16_t* proj = (bf16_t*)(P.ws + OFF_R); bf16_t* act = proj; bf16_t* states = (bf16_t*)(P.ws + OFF_ST);
    bf16_t* mix = (bf16_t*)(P.ws + OFF_MIX); bf16_t* qb = mix; float* head = (float*)(P.ws + OFF_MIX); float* tail = (float*)(P.ws + OFF_TAIL);
    bf16_t* pball = (bf16_t*)P.out;
    float* dtbuf = (float*)(P.ws + OFF_DT); float* cdecay = (float*)(P.ws + OFF_CD);
    pg8::StaticOrder S;
    volatile LAS unsigned* xst = (volatile LAS unsigned*)(lds + LDS_BYTES - 16);
    if (threadIdx.x == 0) { xst[0] = 0u; xst[1] = 0u; }
    __syncthreads();
    const XcdBarrier xb = xcd_barrier_post((unsigned*)(P.ws + OFF_BAR), xst);

    phase0(P, lds, G, bid);
    grid.sync();
    int cur = 0;
#pragma unroll 1
    for (int l = 0; l < NL; ++l) {
        const bf16_t* wl = wt + (size_t)l * WLAYER;
        bf16_t* hb = cur ? hbuf[1] : hbuf[0]; bf16_t* hbn = cur ? hbuf[0] : hbuf[1];
        float* ss = cur ? ssbuf[1] : ssbuf[0]; float* ssn = cur ? ssbuf[0] : ssbuf[1];
        { RsOrder<false> SR; SR.init(T, NPROJ, G, bid); SR.ss = ss; SR.rsbuf = (LAS float*)(lds + 139264); SR.cw = nullptr; SR.cb = nullptr; SR.pbuf = nullptr; SR.na = 0;
          EpiIn E{proj, (const LAS float*)(lds + 139264), 0}; pg8::gemm_phase<EpiIn, RsOrder<false>, true, true>(lds, pg8::Gemm{hb, wl + WIN, T, NPROJ, D}, SR, E); }
        xcd_barrier(xb);
        SsdCtx C{proj, hb, ss, wl + WDT, P.conv_w + (size_t)l * 4 * 1024, P.conv_b + (size_t)l * 1024, P.dt_bias + l * 8, P.a_log + l * 8, P.d_skip + l * 8, P.norm_g + l * 512,
                 states, dtbuf, cdecay, mix, wl + WPOOL};
        for (int job = bid; job < 512 + 256; job += G) {
            if (job < 512) ssd_s1_job(C, lds, job >> 8, (job >> 1) & 127, job & 1);
            else pool_job(C, job - 512);
        }
        xcd_barrier(xb);
        scan_phase(states, cdecay, G, bid);
        xcd_barrier(xb);
        for (int job = bid; job < 512; job += G) ssd_s3_job(C, lds, job >> 8, (job >> 1) & 127, job & 1);
        xcd_barrier(xb);
        { S.init(T, D, G, bid); EpiRes<false> E{hb, hb, ss, nullptr, nullptr}; pg8::gemm_phase<EpiRes<false>, pg8::StaticOrder, true, true>(lds, pg8::Gemm{mix, wl + WOUT, T, D, D}, S, E); }
        xcd_barrier(xb);
        { RsOrder<true> SU; SU.init(T, DUP, G, bid); SU.ss = ss; SU.rsbuf = (LAS float*)(lds + 139264); SU.cw = P.fconv_w + (size_t)l * 3 * DUP; SU.cb = P.fconv_b + (size_t)l * DUP; SU.pbuf = (LAS float*)(lds + 131072); SU.na = 0;
          EpiUp E{act, (const LAS float*)(lds + 139264), (const LAS float*)(lds + 131072), head, tail, 0}; pg8::gemm_phase<EpiUp, RsOrder<true>, true, true>(lds, pg8::Gemm{hb, wl + WUP, T, DUP, D}, SU, E); }
        xcd_barrier(xb);
        fixup_phase(P, l, act, head, tail, G, bid);
        xcd_barrier(xb);
        { S.init(T, D, G, bid); EpiRes<false> E{hb, hb, ss, nullptr, nullptr}; pg8::gemm_phase<EpiRes<false>, pg8::StaticOrder, true, true>(lds, pg8::Gemm{act, wl + WDOWN, T, D, DFF}, S, E); }
        { S.init(T, D, G, bid); EpiQ E{qb}; pg8::gemm_phase<EpiQ, pg8::StaticOrder, true, true>(lds, pg8::Gemm{pball + (size_t)l * T * DPLE, wl + WPLE, T, D, DPLE}, S, E); }
        xcd_barrier(xb);
        { S.init(T, D, G, bid); EpiRes<true> E{hb, hbn, ssn, ss, qb}; pg8::gemm_phase<EpiRes<true>, pg8::StaticOrder, true, true>(lds, pg8::Gemm{hb, wl + WGATE, T, D, D}, S, E); }
        xcd_barrier(xb);
        cur ^= 1;
    }
    {
        const int lane = threadIdx.x & 63, wave = threadIdx.x >> 6;
        const float* ss = cur ? ssbuf[1] : ssbuf[0]; const bf16_t* hb = cur ? hbuf[1] : hbuf[0];
        for (int row = bid * 8 + wave; row < T; row += G * 8) {
            const float rs = row_rstd(ss, row); const u32x2* hr = (const u32x2*)(hb + (size_t)row * D) + lane; f32x4* xr = (f32x4*)(P.out + (size_t)row * D) + lane; const f32x4* gr = (const f32x4*)P.final_g + lane;
#pragma unroll
            for (int j = 0; j < 4; ++j) { const u32x2 hh = hr[64 * j]; const f32x4 gg = gr[64 * j]; f32x4 v = {bf_lo(hh.x), bf_hi(hh.x), bf_lo(hh.y), bf_hi(hh.y)}; v = v * rs * gg; xr[64 * j] = v; }
        }
    }
}

extern "C" void kernel_launch(void* const* d_in, const int* in_sizes, int n_in, void* d_out, int out_size, void* d_ws, size_t ws_size, hipStream_t stream) {
    static int grid = 0;
    if (grid == 0) {
        if (n_in != 22 || ws_size < WS_END) { fprintf(stderr, "kernel_launch: unexpected inputs (n_in %d, ws %zu, need %zu)\n", n_in, ws_size, (size_t)WS_END); grid = -1; return; }
        int dev = 0, cus = 0, per_cu = 0;
        (void)hipGetDevice(&dev); (void)hipDeviceGetAttribute(&cus, hipDeviceAttributeMultiprocessorCount, dev);
        if (hipFuncSetAttribute((const void*)hymba_fwd, hipFuncAttributeMaxDynamicSharedMemorySize, LDS_BYTES) != hipSuccess) { fprintf(stderr, "kernel_launch: hipFuncSetAttribute failed\n"); grid = -1; return; }
        if (hipOccupancyMaxActiveBlocksPerMultiprocessor(&per_cu, (const void*)hymba_fwd, 512, LDS_BYTES) != hipSuccess || per_cu < 1) { fprintf(stderr, "kernel_launch: occupancy query says %d blocks per CU\n", per_cu); per_cu = 1; }
        (void)hipGetLastError();
        grid = cus;
    }
    if (grid < 0) return;
    Params p{};
    const float** pp = (const float**)&p;
    for (int i = 0; i < 22; ++i) pp[i] = (const float*)d_in[i];
    p.out = (float*)d_out; p.ws = (unsigned char*)d_ws;
    if (hipMemsetAsync((char*)d_ws + OFF_BAR, 0, 16384, stream) != hipSuccess) { fprintf(stderr, "kernel_launch: memset failed\n"); return; }
    void* args[] = {&p};
    hipError_t e = hipLaunchCooperativeKernel((const void*)hymba_fwd, dim3(grid), dim3(512), args, LDS_BYTES, stream);
    if (e != hipSuccess) fprintf(stderr, "cooperative launch failed: %s (grid %d)\n", hipGetErrorString(e), grid);
}
```

```cpp
#include <hip/hip_runtime.h>
#include <hip/hip_cooperative_groups.h>
#include <cstdio>
#include <cstdint>
namespace cg = cooperative_groups;
namespace pg8 {
#define PG8_LAS __attribute__((address_space(3)))
typedef unsigned short bf16_t;
typedef short bf16x8 __attribute__((ext_vector_type(8)));
typedef float f32x4 __attribute__((ext_vector_type(4)));
typedef unsigned u32x4 __attribute__((ext_vector_type(4)));
constexpr int BM = 256, BK = 64, HALF = 128, HTB = HALF * BK * 2  , STAGE_BYTES = 8 * HTB, NXCD = 8, WGM = 8;

__host__ __device__ __forceinline__ int lds_byte(int r, int c) { const int st = (r >> 4) * 2 + (c >> 5), rr = r & 15, cc = c & 31, ob = rr * 64 + cc * 2; return st * 1024 + (ob ^ (((ob >> 9) & 1) << 5)); }
__host__ __device__ __forceinline__ void stage_rc(int b, int& R, int& C) { const int st = b / 1024, sb = b % 1024, swz = sb ^ (((sb >> 9) & 1) << 5); R = (st >> 1) * 16 + swz / 64; C = (st & 1) * 32 + (swz % 64) / 2; }
__host__ __device__ __forceinline__ int perm32(int rho) { const int n = rho >> 4, i = rho & 15; return 8 * (i >> 2) + 4 * n + (i & 3); }

struct Unit { int pm, pn; };
struct Gemm { const bf16_t* A; const bf16_t* Bt; int M, N, K; };

struct StaticOrder {
    int nM, nN, nwg, G, c;
    __host__ __device__ void init(int M, int N, int G_, int c_) { nM = M / BM; nN = N / BM; nwg = nM * nN; G = G_; c = c_; }
    __host__ __device__ bool next(int i, Unit& u) const {
        const long L = (long)i * G + c; if (L >= nwg) return false;
        int wgid = (int)L; { const int q = nwg / NXCD, r = nwg % NXCD, xcd = wgid % NXCD, off = wgid / NXCD; wgid = (xcd < r ? xcd * (q + 1) : r * (q + 1) + (xcd - r) * q) + off; }
        const int nig = WGM * nN, gid = wgid / nig, fm = gid * WGM, gsz = (nM - fm) < WGM ? (nM - fm) : WGM;
        u.pm = fm + ((wgid % nig) % gsz); u.pn = (wgid % nig) / gsz; return true;
    }
    __device__ __forceinline__ void a_ready(const Unit&) const {}
    __device__ __forceinline__ void done(const Unit&) const {}
};
__device__ __forceinline__ unsigned cvt_pk_bf16(float lo, float hi) { unsigned r; asm volatile("v_cvt_pk_bf16_f32 %0, %1, %2" : "=v"(r) : "v"(lo), "v"(hi)); return r; }

template <class Epi, class Sched, bool ALIGN_EPI = false, bool SP2 = false>
__device__ __forceinline__ void gemm_phase(PG8_LAS unsigned char* lds, const Gemm g, const Sched& S, const Epi& E) {
    int tid_ = threadIdx.x; asm volatile("" : "+v"(tid_));
    const int tid = tid_, wid = __builtin_amdgcn_readfirstlane(tid >> 6), lane = tid & 63, wr = wid >> 2, wc = wid & 3, fr = lane & 15, fq = lane >> 4;
    int K_ = g.K; asm volatile("" : "+s"(K_));
    const int K = K_, nt = K / BK;
    unsigned voffA[2], voffB[2];
#pragma unroll
    for (int i = 0; i < 2; ++i) { int R, C; stage_rc(tid * 16 + i * 8192, R, C); const int Rb = Epi::PERM ? ((R & ~31) + perm32(R & 31)) : R;
        voffA[i] = (unsigned)(R * K + C) * 2u; voffB[i] = (unsigned)(Rb * K + C) * 2u; }
    const size_t kstep = (size_t)(BK * 2);
    const size_t hstep = (size_t)HALF * K * 2;
    const size_t tstep = 2 * hstep;
    const unsigned ldsw = (unsigned)wid * 1024u;
    const int aoff = lds_byte(wr * 64 + fr, fq * 8), boff = lds_byte(wc * 32 + fr, fq * 8);
#define PG8_SA(b, h) (((b) * 2 + (h)) * HTB)
#define PG8_SB(b, h) ((4 + (b) * 2 + (h)) * HTB)
#define PG8_STAGE(bufoff, gbase, voff) do { _Pragma("unroll") for (int _i = 0; _i < 2; ++_i) \
        __builtin_amdgcn_global_load_lds((const unsigned*)((const char*)(gbase) + (voff)[_i]), (PG8_LAS unsigned*)(lds + (bufoff) + ldsw + _i * 8192), 16, 0, 0); } while (0)
#define PG8_LDA(dst, b, h) do { _Pragma("unroll") for (int m = 0; m < 4; ++m) _Pragma("unroll") for (int k = 0; k < 2; ++k) dst[m][k] = *(const PG8_LAS bf16x8*)(lds + PG8_SA(b, h) + aoff + m * 2048 + k * 1024); } while (0)
#define PG8_LDB(dst, b, h) do { _Pragma("unroll") for (int n = 0; n < 2; ++n) _Pragma("unroll") for (int k = 0; k < 2; ++k) dst[n][k] = *(const PG8_LAS bf16x8*)(lds + PG8_SB(b, h) + boff + n * 2048 + k * 1024); } while (0)
#define PG8_MMA(ai, bj, At, Bt) do { __builtin_amdgcn_s_setprio(1); _Pragma("unroll") for (int m = 0; m < 4; ++m) _Pragma("unroll") for (int n = 0; n < 2; ++n) _Pragma("unroll") for (int k = 0; k < 2; ++k) \
        acc[ai][bj][m][n] = __builtin_amdgcn_mfma_f32_16x16x32_bf16(Bt[n][k], At[m][k], acc[ai][bj][m][n], 0, 0, 0); __builtin_amdgcn_s_setprio(0); } while (0)
#define PG8_WAIT_V(n) asm volatile("s_waitcnt vmcnt(" #n ")" ::: "memory")
#define PG8_WAIT_L(n) asm volatile("s_waitcnt lgkmcnt(" #n ")" ::: "memory")
#define PG8_BAR __builtin_amdgcn_s_barrier()
#define PG8_SCHED __builtin_amdgcn_sched_barrier(0)
    Unit cur, nxt; int ui = 0;
    if (!S.next(0, cur)) return;
    f32x4 acc[2][2][4][2];
#pragma unroll
    for (int a = 0; a < 2; ++a)
#pragma unroll
        for (int b = 0; b < 2; ++b)
#pragma unroll
            for (int m = 0; m < 4; ++m)
#pragma unroll
                for (int n = 0; n < 2; ++n) acc[a][b][m][n] = (f32x4){0.f, 0.f, 0.f, 0.f};
    bf16x8 At[4][2], B0[2][2], B1[2][2];
    const char* cA = (const char*)g.A + (size_t)cur.pm * tstep; const char* cB = (const char*)g.Bt + (size_t)cur.pn * tstep;
    S.a_ready(cur);
    if constexpr (SP2) {
        PG8_STAGE(PG8_SB(0, 0), cB, voffB); PG8_STAGE(PG8_SB(0, 1), cB + hstep, voffB); PG8_STAGE(PG8_SA(0, 0), cA, voffA); PG8_STAGE(PG8_SA(0, 1), cA + hstep, voffA);
        if (wr == 1) PG8_BAR;
        PG8_WAIT_V(2); PG8_BAR;
        PG8_STAGE(PG8_SB(1, 0), cB + kstep, voffB); PG8_STAGE(PG8_SA(1, 0), cA + kstep, voffA); PG8_STAGE(PG8_SB(1, 1), cB + hstep + kstep, voffB);
        PG8_WAIT_V(6); PG8_BAR;
    } else {
        PG8_STAGE(PG8_SB(0, 0), cB, voffB); PG8_STAGE(PG8_SA(0, 0), cA, voffA); PG8_STAGE(PG8_SB(0, 1), cB + hstep, voffB); PG8_STAGE(PG8_SA(0, 1), cA + hstep, voffA);
        if (wr == 1) PG8_BAR;
        PG8_WAIT_V(4); PG8_BAR;
        PG8_STAGE(PG8_SB(1, 0), cB + kstep, voffB); PG8_STAGE(PG8_SA(1, 0), cA + kstep, voffA); PG8_STAGE(PG8_SB(1, 1), cB + hstep + kstep, voffB);
        PG8_WAIT_V(6); PG8_BAR;
    }
    for (;;) {
        const bool has_next = S.next(ui + 1, nxt);
        const char* nA = has_next ? (const char*)g.A + (size_t)nxt.pm * tstep : cA; const char* nB = has_next ? (const char*)g.Bt + (size_t)nxt.pn * tstep : cB;
        for (int t = 0; t < nt; t += 2) {
            const bool last = (t == nt - 2);
            const char* a1 = cA + (size_t)(t + 1) * kstep;
            const char* a2 = last ? nA : cA + (size_t)(t + 2) * kstep; const char* b2 = last ? nB : cB + (size_t)(t + 2) * kstep;
            const char* a3 = a2 + kstep; const char* b3 = b2 + kstep;
            if (last && has_next) S.a_ready(nxt);
            if constexpr (SP2) {
            PG8_LDB(B0, 0, 0); PG8_LDB(B1, 0, 1); PG8_SCHED; PG8_LDA(At, 0, 0); PG8_STAGE(PG8_SA(1, 1), a1 + hstep, voffA);
            PG8_WAIT_V(8); PG8_WAIT_L(0); PG8_BAR; PG8_MMA(0, 0, At, B0); PG8_MMA(0, 1, At, B1); PG8_BAR; PG8_SCHED;
            PG8_LDA(At, 0, 1); PG8_STAGE(PG8_SB(0, 0), b2, voffB); PG8_STAGE(PG8_SB(0, 1), b2 + hstep, voffB); PG8_STAGE(PG8_SA(0, 0), a2, voffA);
            PG8_WAIT_V(8); PG8_WAIT_L(0); PG8_BAR; PG8_MMA(1, 0, At, B0); PG8_MMA(1, 1, At, B1); PG8_BAR; PG8_SCHED;
            PG8_LDB(B0, 1, 0); PG8_LDB(B1, 1, 1); PG8_SCHED; PG8_LDA(At, 1, 0); PG8_STAGE(PG8_SA(0, 1), a2 + hstep, voffA);
            PG8_WAIT_V(8); PG8_WAIT_L(0); PG8_BAR; PG8_MMA(0, 0, At, B0); PG8_MMA(0, 1, At, B1); PG8_BAR; PG8_SCHED;
            PG8_LDA(At, 1, 1); PG8_STAGE(PG8_SB(1, 0), b3, voffB); PG8_STAGE(PG8_SB(1, 1), b3 + hstep, voffB); PG8_STAGE(PG8_SA(1, 0), a3, voffA);
            PG8_WAIT_V(8); PG8_WAIT_L(0); PG8_BAR; PG8_MMA(1, 0, At, B0); PG8_MMA(1, 1, At, B1); PG8_BAR; PG8_SCHED;
            } else {
            PG8_LDB(B0, 0, 0); PG8_SCHED; PG8_LDA(At, 0, 0); PG8_STAGE(PG8_SA(1, 1), a1 + hstep, voffA);
            PG8_WAIT_L(8); PG8_BAR; PG8_WAIT_L(0); PG8_MMA(0, 0, At, B0); PG8_BAR; PG8_SCHED;
            PG8_LDB(B1, 0, 1); PG8_STAGE(PG8_SB(0, 0), b2, voffB);
            PG8_BAR; PG8_WAIT_L(0); PG8_MMA(0, 1, At, B1); PG8_BAR;
            PG8_LDA(At, 0, 1); PG8_STAGE(PG8_SA(0, 0), a2, voffA);
            PG8_BAR; PG8_WAIT_L(0); PG8_MMA(1, 0, At, B0); PG8_BAR; PG8_SCHED;
            PG8_STAGE(PG8_SB(0, 1), b2 + hstep, voffB);
            PG8_WAIT_V(6); PG8_BAR; PG8_MMA(1, 1, At, B1); PG8_BAR;
            PG8_LDB(B0, 1, 0); PG8_SCHED; PG8_LDA(At, 1, 0); PG8_STAGE(PG8_SA(0, 1), a2 + hstep, voffA);
            PG8_WAIT_L(8); PG8_BAR; PG8_WAIT_L(0); PG8_MMA(0, 0, At, B0); PG8_BAR; PG8_SCHED;
            PG8_LDB(B1, 1, 1); PG8_STAGE(PG8_SB(1, 0), b3, voffB);
            PG8_BAR; PG8_WAIT_L(0); PG8_MMA(0, 1, At, B1); PG8_BAR;
            PG8_LDA(At, 1, 1); PG8_STAGE(PG8_SA(1, 0), a3, voffA);
            PG8_BAR; PG8_WAIT_L(0); PG8_MMA(1, 0, At, B0); PG8_BAR; PG8_SCHED;
            PG8_STAGE(PG8_SB(1, 1), b3 + hstep, voffB);
            PG8_WAIT_V(6); PG8_BAR; PG8_MMA(1, 1, At, B1); PG8_BAR;
            }
        }
        if constexpr (ALIGN_EPI) { if (wr == 0) PG8_BAR; }
        if constexpr (!Epi::AFTER_DRAIN) { E(acc, cur, wr, wc, fr, fq); S.done(cur); }
        if (!has_next) break;
#pragma unroll
        for (int a = 0; a < 2; ++a)
#pragma unroll
            for (int b = 0; b < 2; ++b)
#pragma unroll
                for (int m = 0; m < 4; ++m)
#pragma unroll
                    for (int n = 0; n < 2; ++n) acc[a][b][m][n] = (f32x4){0.f, 0.f, 0.f, 0.f};
        cur = nxt; cA = nA; cB = nB; ++ui;
        if constexpr (ALIGN_EPI) { if (wr == 1) PG8_BAR; }
    }
    PG8_WAIT_V(0);
    if constexpr (!ALIGN_EPI) { if (wr == 0) PG8_BAR; }
    PG8_BAR;
    if constexpr (Epi::AFTER_DRAIN) { E.fused(acc, cur, wr, wc, fr, fq, lds, wid, lane); S.done(cur); }
#undef PG8_SA
#undef PG8_SB
#undef PG8_STAGE
#undef PG8_LDA
#undef PG8_LDB
#undef PG8_MMA
#undef PG8_WAIT_V
#undef PG8_WAIT_L
#undef PG8_BAR
#undef PG8_SCHED
}
}
#define LAS __attribute__((address_space(3)))
typedef pg8::bf16_t bf16_t; typedef pg8::bf16x8 bf16x8; typedef pg8::f32x4 f32x4; typedef pg8::u32x4 u32x4;
typedef float f32x16 __attribute__((ext_vector_type(16)));
typedef unsigned u32x2 __attribute__((ext_vector_type(2)));
typedef float f32x2 __attribute__((ext_vector_type(2)));
using pg8::cvt_pk_bf16;

constexpr int T = 32768, D = 1024, SEQ = 16384, NL = 4, NPROJ = 2048, DFF = 2816, DUP = 5632, DPLE = 256;
constexpr float EPS = 1e-6f;
constexpr size_t WIN = 0, WDT = WIN + (size_t)2048 * 1024, WOUT = WDT + (size_t)16 * 1024, WUP = WOUT + (size_t)1024 * 1024, WDOWN = WUP + (size_t)5632 * 1024,
                 WGATE = WDOWN + (size_t)1024 * 2816, WPLE = WGATE + (size_t)1024 * 1024, WPOOL = WPLE + (size_t)1024 * 256, WLAYER = WPOOL + (size_t)4 * 128 * 128;
constexpr size_t OFF_HB0 = 0, OFF_HB1 = OFF_HB0 + (size_t)T * D * 2, OFF_WT = OFF_HB1 + (size_t)T * D * 2, OFF_R = OFF_WT + WLAYER * 2 * NL,
                 OFF_ST = OFF_R + (size_t)T * NPROJ * 2, OFF_MIX = OFF_R + (size_t)T * DFF * 2, OFF_TAIL = OFF_MIX + (size_t)512 * 2 * DUP * 4,
                 OFF_PB = OFF_MIX + (size_t)T * D * 2, OFF_SS = OFF_PB + (size_t)T * DPLE * 2, OFF_DT = OFF_SS + (size_t)2 * T * 16 * 4,
                 OFF_CD = OFF_DT + (size_t)T * 8 * 4, OFF_BAR = OFF_CD + 8192, WS_END = OFF_BAR + 16384;
static_assert(OFF_ST + (size_t)2 * 128 * 8 * 64 * 128 * 2 <= OFF_MIX, "states must fit behind proj");
static_assert(WS_END <= (size_t)512 * 1024 * 1024, "workspace");
constexpr int LDS_BYTES = 147456;
constexpr int PIT = 136;

struct Params {
    const float *x, *p, *mix_g, *w_in, *conv_w, *conv_b, *dt_bias, *a_log, *d_skip, *norm_g, *pool_w, *pool_scale, *w_out, *ffn_g, *w_up, *fconv_w, *fconv_b, *w_down,
        *ple_g, *w_gate, *w_ple, *final_g;
    float* out; unsigned char* ws;
};

__device__ __forceinline__ float bf_lo(unsigned u) { return __uint_as_float(u << 16); }
__device__ __forceinline__ float bf_hi(unsigned u) { return __uint_as_float(u & 0xffff0000u); }
__device__ __forceinline__ float bf2f(bf16_t b) { return __uint_as_float(((unsigned)b) << 16); }
__device__ __forceinline__ bf16_t f2bf(float f) { return (bf16_t)(cvt_pk_bf16(f, 0.f) & 0xffffu); }
__device__ __forceinline__ float fast_sigmoid(float v) { return __builtin_amdgcn_rcpf(1.f + __builtin_amdgcn_exp2f(-1.4426950409f * v)); }
__device__ __forceinline__ float silu_f(float v) { return v * fast_sigmoid(v); }
__device__ __forceinline__ float gelu_tanh(float v) { const float t = v * (1.f + 0.044715f * v * v); return v * __builtin_amdgcn_rcpf(1.f + __builtin_amdgcn_exp2f(-2.302208198f * t)); }
__device__ __forceinline__ float softplus_f(float v) { return v > 20.f ? v : log1pf(__expf(v)); }
__device__ __forceinline__ float wave_sum(float v) {
#pragma unroll
    for (int o = 1; o < 64; o <<= 1) v += __shfl_xor(v, o);
    return v;
}
template <int CTRL> __device__ __forceinline__ float dppf(float v) { return __builtin_bit_cast(float, __builtin_amdgcn_update_dpp(0, __builtin_bit_cast(int, v), CTRL, 0xf, 0xf, true)); }
__device__ __forceinline__ float row_rstd(const float* ss, int row) {
    const f32x4* p = (const f32x4*)(ss + (size_t)row * 16);
    const f32x4 a = p[0], b = p[1], c = p[2], d = p[3];
    const float s = ((a.x + a.y) + (a.z + a.w)) + ((b.x + b.y) + (b.z + b.w)) + ((c.x + c.y) + (c.z + c.w)) + ((d.x + d.y) + (d.z + d.w));
    return rsqrtf(s * (1.f / 1024.f) + EPS);
}
__device__ __forceinline__ float row_rstd_coop(const float* ss, int row, int fq) {
    const f32x4 a = *(const f32x4*)(ss + (size_t)row * 16 + 4 * fq);
    float s = (a.x + a.y) + (a.z + a.w);
    s += __shfl_xor(s, 16); s += __shfl_xor(s, 32);
    return rsqrtf(s * (1.f / 1024.f) + EPS);
}
__device__ __forceinline__ void rstd8(const float* ss, int rbase, int fq, float (&rs)[2][4]) {
    f32x4 a[2][4];
#pragma unroll
    for (int ai = 0; ai < 2; ++ai)
#pragma unroll
        for (int m = 0; m < 4; ++m) a[ai][m] = *(const f32x4*)(ss + (size_t)(rbase + ai * 128 + m * 16) * 16 + 4 * fq);
#pragma unroll
    for (int ai = 0; ai < 2; ++ai)
#pragma unroll
        for (int m = 0; m < 4; ++m) { float s = (a[ai][m].x + a[ai][m].y) + (a[ai][m].z + a[ai][m].w); s += __shfl_xor(s, 16); s += __shfl_xor(s, 32); rs[ai][m] = rsqrtf(s * (1.f / 1024.f) + EPS); }
}
__device__ __forceinline__ void rstd4(const float* ss, int rbase, int fq, float (&rs)[4]) {
    f32x4 a[4];
#pragma unroll
    for (int m = 0; m < 4; ++m) a[m] = *(const f32x4*)(ss + (size_t)(rbase + m * 16) * 16 + 4 * fq);
#pragma unroll
    for (int m = 0; m < 4; ++m) { float s = (a[m].x + a[m].y) + (a[m].z + a[m].w); s += __shfl_xor(s, 16); s += __shfl_xor(s, 32); rs[m] = rsqrtf(s * (1.f / 1024.f) + EPS); }
}
#define LDS_FENCE() asm volatile("s_waitcnt lgkmcnt(0)" ::: "memory")

struct EpiIn {
    static constexpr bool PERM = true, AFTER_DRAIN = false;
    bf16_t* O; const LAS float* rsbuf; mutable int ne;
    __device__ __forceinline__ void operator()(const f32x4 (&acc)[2][2][4][2], const pg8::Unit& u, int wr, int wc, int fr, int fq) const {
        const int col0 = u.pn * 256 + wc * 32 + 8 * fq, rbase = u.pm * 256 + wr * 64 + fr;
        const LAS float* rp = rsbuf + (ne & 1) * 256 + wr * 64 + fr; ++ne;
#pragma unroll
        for (int ai = 0; ai < 2; ++ai)
#pragma unroll
            for (int m = 0; m < 4; ++m) {
                const int row = rbase + ai * 128 + m * 16; const float r1 = rp[ai * 128 + m * 16];
                bf16_t* rowp = O + (size_t)row * NPROJ + col0;
#pragma unroll
                for (int bj = 0; bj < 2; ++bj) { const f32x4 v0 = acc[ai][bj][m][0] * r1, v1 = acc[ai][bj][m][1] * r1;
                    u32x4 w; w.x = cvt_pk_bf16(v0[0], v0[1]); w.y = cvt_pk_bf16(v0[2], v0[3]); w.z = cvt_pk_bf16(v1[0], v1[1]); w.w = cvt_pk_bf16(v1[2], v1[3]);
                    *(u32x4*)(rowp + bj * 128) = w; } }
    }
};
struct EpiQ {
    static constexpr bool PERM = true, AFTER_DRAIN = false;
    bf16_t* O;
    __device__ __forceinline__ void operator()(const f32x4 (&acc)[2][2][4][2], const pg8::Unit& u, int wr, int wc, int fr, int fq) const {
        const int col0 = u.pn * 256 + wc * 32 + 8 * fq;
#pragma unroll
        for (int ai = 0; ai < 2; ++ai)
#pragma unroll
            for (int m = 0; m < 4; ++m) {
                const int row = u.pm * 256 + ai * 128 + wr * 64 + m * 16 + fr; bf16_t* rowp = O + (size_t)row * D + col0;
#pragma unroll
                for (int bj = 0; bj < 2; ++bj) { const f32x4 v0 = acc[ai][bj][m][0], v1 = acc[ai][bj][m][1];
                    u32x4 w; w.x = cvt_pk_bf16(v0[0], v0[1]); w.y = cvt_pk_bf16(v0[2], v0[3]); w.z = cvt_pk_bf16(v1[0], v1[1]); w.w = cvt_pk_bf16(v1[2], v1[3]);
                    *(u32x4*)(rowp + bj * 128) = w; } }
    }
};
template <bool GATE> struct EpiRes {
    static constexpr bool PERM = true, AFTER_DRAIN = false;
    const bf16_t* rin; bf16_t* hb; float* ssw; const float* ssr; const bf16_t* q;
    __device__ __forceinline__ void operator()(const f32x4 (&acc)[2][2][4][2], const pg8::Unit& u, int wr, int wc, int fr, int fq) const {
        constexpr int MB = GATE ? 2 : 4;
        const int col0 = u.pn * 256 + wc * 32 + 8 * fq, rbase = u.pm * 256 + wr * 64 + fr;
        float rs[2][4];
        if (GATE) rstd8(ssr, rbase, fq, rs);
#pragma unroll
        for (int ai = 0; ai < 2; ++ai)
#pragma unroll
            for (int mb = 0; mb < 4; mb += MB) {
                u32x4 hv[MB][2], qv[MB][2];
#pragma unroll
                for (int mm = 0; mm < MB; ++mm)
#pragma unroll
                    for (int bj = 0; bj < 2; ++bj) { const size_t off = (size_t)(rbase + ai * 128 + (mb + mm) * 16) * D + col0 + bj * 128;
                        hv[mm][bj] = *(const u32x4*)(rin + off); if (GATE) qv[mm][bj] = *(const u32x4*)(q + off); }
#pragma unroll
                for (int mm = 0; mm < MB; ++mm) { const int m = mb + mm, row = rbase + ai * 128 + m * 16; float sq = 0.f;
#pragma unroll
                    for (int bj = 0; bj < 2; ++bj) { const size_t off = (size_t)row * D + col0 + bj * 128;
                        const u32x4 hh = hv[mm][bj]; const f32x4 a0 = acc[ai][bj][m][0], a1 = acc[ai][bj][m][1];
                        float v[8] = {bf_lo(hh.x), bf_hi(hh.x), bf_lo(hh.y), bf_hi(hh.y), bf_lo(hh.z), bf_hi(hh.z), bf_lo(hh.w), bf_hi(hh.w)};
                        const float a[8] = {a0[0], a0[1], a0[2], a0[3], a1[0], a1[1], a1[2], a1[3]};
                        if (GATE) { const float r1 = rs[ai][m]; const u32x4 qq = qv[mm][bj];
                            const float qf[8] = {bf_lo(qq.x), bf_hi(qq.x), bf_lo(qq.y), bf_hi(qq.y), bf_lo(qq.z), bf_hi(qq.z), bf_lo(qq.w), bf_hi(qq.w)};
#pragma unroll
                            for (int k = 0; k < 8; ++k) v[k] += qf[k] * fast_sigmoid(a[k] * r1); }
                        else {
#pragma unroll
                            for (int k = 0; k < 8; ++k) v[k] += a[k]; }
                        u32x4 w; w.x = cvt_pk_bf16(v[0], v[1]); w.y = cvt_pk_bf16(v[2], v[3]); w.z = cvt_pk_bf16(v[4], v[5]); w.w = cvt_pk_bf16(v[6], v[7]);
                        *(u32x4*)(hb + off) = w;
                        const float r0 = bf_lo(w.x), r1v = bf_hi(w.x), r2 = bf_lo(w.y), r3 = bf_hi(w.y), r4 = bf_lo(w.z), r5 = bf_hi(w.z), r6 = bf_lo(w.w), r7 = bf_hi(w.w);
                        sq += ((r0 * r0 + r1v * r1v) + (r2 * r2 + r3 * r3)) + ((r4 * r4 + r5 * r5) + (r6 * r6 + r7 * r7)); }
                    sq += __shfl_xor(sq, 16); sq += __shfl_xor(sq, 32);
                    if (fq == 0) ssw[(size_t)row * 16 + u.pn * 4 + wc] = sq; } }
    }
};
template <bool UP> struct RsOrder : pg8::StaticOrder {
    const float* ss; LAS float* rsbuf; const float* cw; const float* cb; LAS float* pbuf; mutable int na;
    __device__ __forceinline__ void a_ready(const pg8::Unit& u) const {
        int t = threadIdx.x; asm volatile("" : "+v"(t));
        const int par = na & 1; ++na;
        if (UP) { const int qd = t >> 6, c = 2 * (t & 63);
            const float* src = ((qd & 3) == 3 ? cb : cw + (size_t)(qd & 3) * DUP) + (qd >> 2) * DFF + u.pn * 128 + c;
            const f32x2 v = *(const f32x2*)src;
            *(LAS f32x2*)(pbuf + par * 1024 + qd * 128 + c) = v; }
        if (t < 256) { rsbuf[par * 256 + t] = row_rstd(ss, u.pm * 256 + t); }
    }
};
__device__ __forceinline__ f32x2 gelu_tanh2(f32x2 v) {
    const f32x2 t = v * (v * v * 0.044715f + 1.0f), a = t * (-2.302208198f);
    f32x2 e; e.x = __builtin_amdgcn_exp2f(a.x); e.y = __builtin_amdgcn_exp2f(a.y);
    const f32x2 d = e + 1.0f; f32x2 r; r.x = __builtin_amdgcn_rcpf(d.x); r.y = __builtin_amdgcn_rcpf(d.y);
    return v * r;
}
struct EpiUp {
    static constexpr bool PERM = true, AFTER_DRAIN = false;
    bf16_t* act; const LAS float* rsbuf; const LAS float* pbuf; float* head; float* tail; mutable int ne;
    __device__ __forceinline__ void operator()(const f32x4 (&acc)[2][2][4][2], const pg8::Unit& u, int wr, int wc, int fr, int fq) const {
        const LAS float* pp = pbuf + (ne & 1) * 1024 + wc * 32 + 8 * fq; const LAS float* rp = rsbuf + (ne & 1) * 256 + wr * 64 + fr; ++ne;
        const int jg0 = u.pn * 128 + wc * 32 + 8 * fq, rb0 = u.pm * 256 + wr * 64 + fr;
#pragma unroll
        for (int ai = 0; ai < 2; ++ai) {
            const int rbase = rb0 + ai * 128, strip = u.pm * 4 + ai * 2 + wr;
            float rs[4];
#pragma unroll
            for (int m = 0; m < 4; ++m) rs[m] = rp[ai * 128 + m * 16];
            unsigned ow[4][4];
#pragma unroll
            for (int nj = 0; nj < 4; ++nj) {
                const int n = nj >> 1, j0 = 2 * (nj & 1), cl = 4 * n + j0, jg = jg0 + cl;
                const f32x2 w0g = *(const LAS f32x2*)(pp + cl), w1g = *(const LAS f32x2*)(pp + 128 + cl), w2g = *(const LAS f32x2*)(pp + 256 + cl), bg = *(const LAS f32x2*)(pp + 384 + cl);
                const f32x2 w0v = *(const LAS f32x2*)(pp + 512 + cl), w1v = *(const LAS f32x2*)(pp + 640 + cl), w2v = *(const LAS f32x2*)(pp + 768 + cl), bv = *(const LAS f32x2*)(pp + 896 + cl);
                f32x2 pg = {0.f, 0.f}, pv = {0.f, 0.f};
#pragma unroll
                for (int m = 0; m < 4; ++m) {
                    const float r1 = rs[m];
                    const f32x2 ag = {acc[ai][0][m][n][j0], acc[ai][0][m][n][j0 + 1]}, av = {acc[ai][1][m][n][j0], acc[ai][1][m][n][j0 + 1]};
                    const f32x2 xg = ag * r1, xv = av * r1;
                    if (m == 0 && fr < 2) { float* hp = head + ((size_t)(strip * 2 + fr)) * DUP + jg; *(f32x2*)hp = xg; *(f32x2*)(hp + DFF) = xv; }
                    if (m == 3 && fr >= 14) { float* tp = tail + ((size_t)(strip * 2 + fr - 14)) * DUP + jg; *(f32x2*)tp = xg; *(f32x2*)(tp + DFF) = xv; }
                    f32x2 g1, g2, v1, v2;
                    g1.x = dppf<0x111>(xg.x) + dppf<0x10F>(pg.x); g1.y = dppf<0x111>(xg.y) + dppf<0x10F>(pg.y);
                    g2.x = dppf<0x112>(xg.x) + dppf<0x10E>(pg.x); g2.y = dppf<0x112>(xg.y) + dppf<0x10E>(pg.y);
                    v1.x = dppf<0x111>(xv.x) + dppf<0x10F>(pv.x); v1.y = dppf<0x111>(xv.y) + dppf<0x10F>(pv.y);
                    v2.x = dppf<0x112>(xv.x) + dppf<0x10E>(pv.x); v2.y = dppf<0x112>(xv.y) + dppf<0x10E>(pv.y);
                    const f32x2 cgv = w2g * xg + (w1g * g1 + (w0g * g2 + bg));
                    const f32x2 cvv = w2v * xv + (w1v * v1 + (w0v * v2 + bv));
                    const f32x2 o = gelu_tanh2(cgv) * cvv;
                    ow[m][nj] = cvt_pk_bf16(o.x, o.y);
                    pg = xg; pv = xv; } }
#pragma unroll
            for (int m = 0; m < 4; ++m)
                if (!(m == 0 && fr < 2)) { u32x4 w; w.x = ow[m][0]; w.y = ow[m][1]; w.z = ow[m][2]; w.w = ow[m][3]; *(u32x4*)(act + (size_t)(rbase + 16 * m) * DFF + jg0) = w; } }
    }
};
__device__ __forceinline__ void tr_item(const float* W, int ldw, bf16_t* WT, int Kd, int k0, int n0, int sc0, const float* kscale, const float* nscale, LAS float* scr, int lane) {
#pragma unroll
    for (int i = 0; i < 32; ++i) { const int kk = 2 * i + (lane >> 5); float v = W[(size_t)(k0 + kk) * ldw + sc0 + (lane & 31)]; if (kscale) v *= kscale[k0 + kk]; scr[kk * 33 + (lane & 31)] = v; }
    LDS_FENCE();
    const int c = lane & 7;
#pragma unroll
    for (int j = 0; j < 4; ++j) { const int n = (lane >> 3) + 8 * j; const LAS float* s = scr + (8 * c) * 33 + n; const float ns = nscale ? nscale[sc0 + n] : 1.f;
        u32x4 o; o.x = cvt_pk_bf16(s[0] * ns, s[33] * ns); o.y = cvt_pk_bf16(s[2 * 33] * ns, s[3 * 33] * ns); o.z = cvt_pk_bf16(s[4 * 33] * ns, s[5 * 33] * ns); o.w = cvt_pk_bf16(s[6 * 33] * ns, s[7 * 33] * ns);
        *(u32x4*)(WT + (size_t)(n0 + n) * Kd + k0 + 8 * c) = o; }
    LDS_FENCE();
}
__device__ __forceinline__ void phase0(const Params& P, LAS unsigned char* lds, int G, int bid) {
    int tid_ = threadIdx.x; asm volatile("" : "+v"(tid_)); const int tid = tid_, lane = tid & 63, wave = tid >> 6;
    bf16_t* wt = (bf16_t*)(P.ws + OFF_WT);
    LAS float* scr = (LAS float*)(lds + wave * 8704);
    const int gw = bid * 8 + wave, NGW = G * 8;
    constexpr int IPL = 1024 + 256 + 2816 + 1408 + 512 + 128;
    for (int it = gw; it < NL * IPL; it += NGW) {
        const int l = it / IPL; int r = it % IPL;
        bf16_t* wl = wt + (size_t)l * WLAYER;
        const float* W; int ldw, Kd, kb, nb, sc0; bf16_t* WT; const float* ks = nullptr; const float* ns = nullptr;
        if (r < 1024) { W = P.w_in + (size_t)l * 1024 * 2056; ldw = 2056; Kd = 1024; WT = wl + WIN; ks = P.mix_g + l * 1024; kb = r / 64; nb = r % 64; sc0 = 32 * nb < 1536 ? 32 * nb : 32 * nb + 8; }
        else if ((r -= 1024) < 256) { W = P.w_out + (size_t)l * 1024 * 1024; ldw = 1024; Kd = 1024; WT = wl + WOUT; kb = r / 32; nb = r % 32; sc0 = 32 * nb; }
        else if ((r -= 256) < 2816) { W = P.w_up + (size_t)l * 1024 * DUP; ldw = DUP; Kd = 1024; WT = wl + WUP; ks = P.ffn_g + l * 1024; kb = r / 176; nb = r % 176;
            const int n0 = 32 * nb, pn = n0 >> 8, rr = n0 & 255; sc0 = rr < 128 ? 128 * pn + rr : DFF + 128 * pn + (rr - 128); }
        else if ((r -= 2816) < 1408) { W = P.w_down + (size_t)l * DFF * 1024; ldw = 1024; Kd = DFF; WT = wl + WDOWN; kb = r / 32; nb = r % 32; sc0 = 32 * nb; }
        else if ((r -= 1408) < 512) { W = P.w_gate + (size_t)l * 1024 * 1024; ldw = 1024; Kd = 1024; WT = wl + WGATE; ks = P.ple_g + l * 1024; kb = r / 32; nb = r % 32; sc0 = 32 * nb; }
        else { r -= 512; W = P.w_ple + (size_t)l * DPLE * 1024; ldw = 1024; Kd = DPLE; WT = wl + WPLE; kb = r / 32; nb = r % 32; sc0 = 32 * nb; }
        tr_item(W, ldw, WT, Kd, 64 * kb, 32 * nb, sc0, ks, ns, scr, lane);
    }
    __syncthreads();
    for (int job = bid; job < NL * 64; job += G) {
        const int l = job >> 6, gi = (job >> 4) & 3, nc = job & 15;
        LAS float* pwl = (LAS float*)lds;
        const float* pw = P.pool_w + (size_t)(l * 4 + gi) * 128 * 128; const float* sc = P.pool_scale + l * 512 + gi * 128;
        for (int i = tid; i < 4096; i += 512) { f32x4 v = *(const f32x4*)(pw + 4 * i); const f32x4 s4 = *(const f32x4*)(sc + ((4 * i) & 127)); v = v * s4; *(LAS f32x4*)(pwl + 4 * i) = v; }
        __syncthreads();
        const int n = nc * 64 + lane, cg = wave;
        const float* wo = P.w_out + (size_t)l * 1024 * 1024 + (size_t)(512 + gi * 128) * 1024 + n;
        float a[16];
#pragma unroll
        for (int jj = 0; jj < 16; ++jj) a[jj] = 0.f;
#pragma unroll 2
        for (int d4 = 0; d4 < 32; ++d4) {
            const float w0 = wo[(size_t)(4 * d4) * 1024], w1 = wo[(size_t)(4 * d4 + 1) * 1024], w2 = wo[(size_t)(4 * d4 + 2) * 1024], w3 = wo[(size_t)(4 * d4 + 3) * 1024];
#pragma unroll
            for (int jj = 0; jj < 16; ++jj) { const f32x4 p4 = *(const LAS f32x4*)(pwl + (cg * 16 + jj) * 128 + 4 * d4); a[jj] += (p4.x * w0 + p4.y * w1) + (p4.z * w2 + p4.w * w3); }
        }
        u32x4 o0, o1; o0.x = cvt_pk_bf16(a[0], a[1]); o0.y = cvt_pk_bf16(a[2], a[3]); o0.z = cvt_pk_bf16(a[4], a[5]); o0.w = cvt_pk_bf16(a[6], a[7]);
        o1.x = cvt_pk_bf16(a[8], a[9]); o1.y = cvt_pk_bf16(a[10], a[11]); o1.z = cvt_pk_bf16(a[12], a[13]); o1.w = cvt_pk_bf16(a[14], a[15]);
        bf16_t* dst = wt + (size_t)l * WLAYER + WOUT + (size_t)n * 1024 + 512 + gi * 128 + cg * 16;
        *(u32x4*)dst = o0; *(u32x4*)(dst + 8) = o1;
        __syncthreads();
    }
    for (int idx = bid * 512 + tid; idx < NL * 16 * 1024; idx += G * 512) {
        const int l = idx >> 14, j = (idx >> 10) & 15, k = idx & 1023;
        const float v = j < 8 ? P.w_in[(size_t)l * 1024 * 2056 + (size_t)k * 2056 + 1536 + j] * P.mix_g[l * 1024 + k] : 0.f;
        wt[(size_t)l * WLAYER + WDT + j * 1024 + k] = f2bf(v);
    }
    {
        const f32x4* ps = (const f32x4*)P.p; bf16_t* pb = (bf16_t*)P.out; const int NT = G * 512; constexpr int NV = NL * T * DPLE / 4;
        for (int idx = bid * 512 + tid; idx < NV; idx += 8 * NT) {
            f32x4 v[8];
#pragma unroll
            for (int k = 0; k < 8; ++k) if (idx + k * NT < NV) v[k] = __builtin_nontemporal_load(ps + idx + k * NT);
#pragma unroll
            for (int k = 0; k < 8; ++k) if (idx + k * NT < NV) { u32x2 w; w.x = cvt_pk_bf16(v[k].x, v[k].y); w.y = cvt_pk_bf16(v[k].z, v[k].w); *(u32x2*)(pb + (size_t)(idx + k * NT) * 4) = w; }
        }
    }
    bf16_t* hb0 = (bf16_t*)(P.ws + OFF_HB0); float* ss0 = (float*)(P.ws + OFF_SS);
    for (int row = gw; row < T; row += NGW) {
        const f32x4* xr = (const f32x4*)(P.x + (size_t)row * D) + lane; float s = 0.f;
#pragma unroll
        for (int j = 0; j < 4; ++j) { const f32x4 v = xr[64 * j]; s += (v.x * v.x + v.y * v.y) + (v.z * v.z + v.w * v.w);
            u32x2 w; w.x = cvt_pk_bf16(v.x, v.y); w.y = cvt_pk_bf16(v.z, v.w); *(u32x2*)(hb0 + (size_t)row * D + 4 * lane + 256 * j) = w; }
        s = wave_sum(s);
        if (lane < 16) ss0[(size_t)row * 16 + lane] = lane == 0 ? s : 0.f;
    }
}

#define MFMA32(a, b, c) __builtin_amdgcn_mfma_f32_32x32x16_bf16((a), (b), (c), 0, 0, 0)
struct ConvIn { unsigned v[11]; f32x2 w0, w1, w2, w3, bb; };
__device__ __forceinline__ void conv_load(const bf16_t* proj, long row0, int tl0, bool seqstart, int pcol, const float* cw, const float* cb, int xch, ConvIn& ci) {
#pragma unroll
    for (int i = 0; i < 11; ++i) { const int tl = tl0 - 3 + i; ci.v[i] = (tl >= 0 || !seqstart) ? *(const unsigned*)(proj + (size_t)(row0 + tl) * NPROJ + pcol) : 0u; }
    ci.w0 = *(const f32x2*)(cw + xch); ci.w1 = *(const f32x2*)(cw + 1024 + xch); ci.w2 = *(const f32x2*)(cw + 2048 + xch); ci.w3 = *(const f32x2*)(cw + 3072 + xch); ci.bb = *(const f32x2*)(cb + xch);
}
__device__ __forceinline__ f32x2 silu2(f32x2 v) {
    const f32x2 a = v * (-1.4426950409f); f32x2 e; e.x = __builtin_amdgcn_exp2f(a.x); e.y = __builtin_amdgcn_exp2f(a.y);
    const f32x2 d = e + 1.0f; f32x2 r; r.x = __builtin_amdgcn_rcpf(d.x); r.y = __builtin_amdgcn_rcpf(d.y);
    return v * r;
}
__device__ __forceinline__ void conv_apply(const ConvIn& ci, float (&o0)[8], float (&o1)[8]) {
    f32x2 x[11];
#pragma unroll
    for (int i = 0; i < 11; ++i) { x[i].x = bf_lo(ci.v[i]); x[i].y = bf_hi(ci.v[i]); }
#pragma unroll
    for (int i = 0; i < 8; ++i) {
        const f32x2 a = ci.w3 * x[i + 3] + (ci.w2 * x[i + 2] + (ci.w1 * x[i + 1] + (ci.w0 * x[i] + ci.bb)));
        const f32x2 sv = silu2(a); o0[i] = sv.x; o1[i] = sv.y; }
}
__device__ __forceinline__ float chunk_cumsum(LAS float* dtT, LAS float* acs, int wave, int lane, float Ah) {
    float last = 0.f;
    if (wave < 4) {
        const float a0 = dtT[wave * 128 + 2 * lane] * Ah, a1 = dtT[wave * 128 + 2 * lane + 1] * Ah; float v = a0 + a1;
#pragma unroll
        for (int o = 1; o < 64; o <<= 1) { const float t = __shfl_up(v, o); if (lane >= o) v += t; }
        acs[wave * 128 + 2 * lane] = v - a1; acs[wave * 128 + 2 * lane + 1] = v;
        last = __shfl(v, 63);
    }
    return last;
}
struct SsdCtx { const bf16_t* proj; const bf16_t* hb; const float* ss; const bf16_t* wdt; const float* cw; const float* cb; const float* dt_bias; const float* a_log; const float* d_skip; const float* norm_g;
                bf16_t* states; float* dtbuf; float* cdecay; bf16_t* mix; const bf16_t* pwt; };

__device__ __forceinline__ void ssd_s1_chunk(const SsdCtx& C, LAS unsigned char* lds, int b, int c) {
    int tid_ = threadIdx.x; asm volatile("" : "+v"(tid_)); const int tid = tid_, lane = tid & 63, wave = tid >> 6;
    LAS bf16_t* XdT = (LAS bf16_t*)lds; LAS bf16_t* BT = (LAS bf16_t*)(lds + 256 * PIT * 2);
    LAS float* dt8 = (LAS float*)(lds + 139264); LAS float* acs = dt8 + 1024;
    const long row0 = (long)b * SEQ + c * 128;
    {
        pg8::f32x4 acc = {0.f, 0.f, 0.f, 0.f};
        const bf16_t* ar = C.hb + (size_t)(row0 + 16 * wave + (lane & 15)) * D + 8 * (lane >> 4);
        const bf16_t* br = C.wdt + (size_t)(lane & 15) * D + 8 * (lane >> 4);
#pragma unroll 1
        for (int kb = 0; kb < 2; ++kb) {
            bf16x8 a[16], bb[16];
#pragma unroll
            for (int i = 0; i < 16; ++i) { a[i] = *(const bf16x8*)(ar + 512 * kb + 32 * i); bb[i] = *(const bf16x8*)(br + 512 * kb + 32 * i); }
#pragma unroll
            for (int i = 0; i < 16; ++i) acc = __builtin_amdgcn_mfma_f32_16x16x32_bf16(a[i], bb[i], acc, 0, 0, 0);
        }
        const int head = lane & 15;
        if (head < 8) {
            const float bias = C.dt_bias[head];
#pragma unroll
            for (int rg = 0; rg < 4; ++rg) { const int tok = 16 * wave + 4 * (lane >> 4) + rg; const float rs = row_rstd(C.ss, (int)(row0 + tok));
                const float dt = softplus_f(acc[rg] * rs + bias); dt8[head * 128 + tok] = dt; C.dtbuf[(size_t)(row0 + tok) * 8 + head] = dt; } }
    }
    __syncthreads();
#pragma unroll 1
    for (int g = 0; g < 2; ++g) {
        LAS float* dtT = dt8 + g * 512;
        {
            const float Ah = wave < 4 ? -__expf(C.a_log[4 * g + wave]) : 0.f;
            const float last = chunk_cumsum(dtT, acs, wave, lane, Ah);
            if (wave < 4 && lane == 0) C.cdecay[(size_t)(b * 128 + c) * 8 + 4 * g + wave] = __expf(last);
        }
        __syncthreads();
#pragma unroll 1
        for (int bt = 0; bt < 2; ++bt) {
            ConvIn v[3];
#pragma unroll
            for (int k = 0; k < 3; ++k) { const int idx = tid + 512 * (3 * bt + k), cp = idx % 192, r = idx / 192; const int xch = cp < 128 ? g * 256 + 2 * cp : 512 + g * 128 + 2 * (cp - 128);
                conv_load(C.proj, row0, 8 * r, c == 0, 512 + xch, C.cw, C.cb, xch, v[k]); }
#pragma unroll
            for (int k = 0; k < 3; ++k) { const int idx = tid + 512 * (3 * bt + k), cp = idx % 192, r = idx / 192; const bool isx = cp < 128;
                float o0[8], o1[8];
                conv_apply(v[k], o0, o1);
                if (isx) { const int hh = cp >> 5; const float al = acs[hh * 128 + 127];
#pragma unroll
                    for (int i = 0; i < 8; ++i) { const float sc = dtT[hh * 128 + 8 * r + i] * __expf(al - acs[hh * 128 + 8 * r + i]); o0[i] *= sc; o1[i] *= sc; } }
                LAS bf16_t* dst = isx ? XdT + (2 * cp) * PIT + 8 * r : BT + (2 * (cp - 128)) * PIT + 8 * r;
                u32x4 w0, w1; w0.x = cvt_pk_bf16(o0[0], o0[1]); w0.y = cvt_pk_bf16(o0[2], o0[3]); w0.z = cvt_pk_bf16(o0[4], o0[5]); w0.w = cvt_pk_bf16(o0[6], o0[7]);
                w1.x = cvt_pk_bf16(o1[0], o1[1]); w1.y = cvt_pk_bf16(o1[2], o1[3]); w1.z = cvt_pk_bf16(o1[4], o1[5]); w1.w = cvt_pk_bf16(o1[6], o1[7]);
                *(LAS u32x4*)dst = w0; *(LAS u32x4*)(dst + PIT) = w1; }
        }
        __syncthreads();
        {
            const int hh = wave >> 1, nh = wave & 1, r = lane & 31, hq = lane >> 5;
            f32x16 acc[2][2];
#pragma unroll
            for (int i = 0; i < 2; ++i)
#pragma unroll
                for (int j = 0; j < 2; ++j)
#pragma unroll
                    for (int e = 0; e < 16; ++e) acc[i][j][e] = 0.f;
#pragma unroll 2
            for (int ks = 0; ks < 8; ++ks) {
                bf16x8 a[2], bb[2];
#pragma unroll
                for (int i = 0; i < 2; ++i) { a[i] = *(const LAS bf16x8*)(XdT + (64 * hh + 32 * i + r) * PIT + 16 * ks + 8 * hq); bb[i] = *(const LAS bf16x8*)(BT + (64 * nh + 32 * i + r) * PIT + 16 * ks + 8 * hq); }
#pragma unroll
                for (int i = 0; i < 2; ++i)
#pragma unroll
                    for (int j = 0; j < 2; ++j) acc[i][j] = MFMA32(a[i], bb[j], acc[i][j]);
            }
            __syncthreads();
#pragma unroll
            for (int i = 0; i < 2; ++i)
#pragma unroll
                for (int j = 0; j < 2; ++j)
#pragma unroll
                    for (int e = 0; e < 16; ++e) { const int p = 32 * i + (e & 3) + 8 * (e >> 2) + 4 * hq, n = 64 * nh + 32 * j + r; XdT[(64 * hh + p) * PIT + n] = f2bf(acc[i][j][e]); }
            __syncthreads();
            bf16_t* st = C.states + ((size_t)(b * 128 + c) * 8 + 4 * g) * 64 * 128;
#pragma unroll
            for (int k = 0; k < 8; ++k) { const int pc = tid + 512 * k, row = pc >> 4, c16 = pc & 15; *(u32x4*)(st + (size_t)row * 128 + c16 * 8) = *(const LAS u32x4*)(XdT + row * PIT + c16 * 8); }
        }
        __syncthreads();
    }
}

template <int W> __device__ __forceinline__ void pool_fill(const bf16_t* proj, long row0, bool seqstart, int gi, bf16_t* mix, int tid) {
    const int cp = tid & 63, run = tid >> 6, pcol = 1536 + gi * 128 + 2 * cp;
    float u0[31], u1[31];
#pragma unroll
    for (int i = 0; i < 31; ++i) { const int tl = 16 * run - 15 + i; const unsigned v = (tl >= 0 || !seqstart) ? *(const unsigned*)(proj + (size_t)(row0 + tl) * NPROJ + pcol) : 0u; u0[i] = bf_lo(v); u1[i] = bf_hi(v); }
    float s0 = 0.f, s1 = 0.f;
#pragma unroll
    for (int j = 1; j < W; ++j) { s0 += u0[15 - j]; s1 += u1[15 - j]; }
#pragma unroll
    for (int i = 0; i < 16; ++i) {
        s0 += u0[15 + i]; s1 += u1[15 + i];
        const int tl = 16 * run + i; const float dv = seqstart ? (float)(tl + 1 < W ? tl + 1 : W) : (float)W; const float inv = 1.f / dv;
        *(unsigned*)(mix + (size_t)(row0 + tl) * D + 512 + gi * 128 + 2 * cp) = cvt_pk_bf16(s0 * inv - u0[15 + i], s1 * inv - u1[15 + i]);
        s0 -= u0[15 + i - (W - 1)]; s1 -= u1[15 + i - (W - 1)];
    }
}
__device__ __forceinline__ void pool_job(const SsdCtx& C, int tb) {
    int tid_ = threadIdx.x; asm volatile("" : "+v"(tid_)); const int tid = tid_;
    const long row0 = (long)tb * 128; const bool seqstart = (tb & 127) == 0;
    pool_fill<2>(C.proj, row0, seqstart, 0, C.mix, tid); pool_fill<4>(C.proj, row0, seqstart, 1, C.mix, tid);
    pool_fill<8>(C.proj, row0, seqstart, 2, C.mix, tid); pool_fill<16>(C.proj, row0, seqstart, 3, C.mix, tid);
}

__device__ __forceinline__ void scan_phase(bf16_t* states, const float* cdecay, int G, int bid) {
    int tid_ = threadIdx.x; asm volatile("" : "+v"(tid_));
    for (int idx = bid * 512 + tid_; idx < 2 * 8 * 64 * 128; idx += G * 512) {
        const int n = idx & 127, p = (idx >> 7) & 63, h = (idx >> 13) & 7, b = idx >> 16;
        bf16_t* sp = states + ((size_t)b * 128 * 8 + h) * 8192 + p * 128 + n; const float* dp = cdecay + (size_t)b * 128 * 8 + h;
        float s = 0.f;
        for (int c0 = 0; c0 < 128; c0 += 16) {
            float v[16], d[16];
#pragma unroll
            for (int i = 0; i < 16; ++i) { v[i] = bf2f(sp[(size_t)(c0 + i) * 8 * 8192]); d[i] = dp[(c0 + i) * 8]; }
#pragma unroll
            for (int i = 0; i < 16; ++i) { sp[(size_t)(c0 + i) * 8 * 8192] = f2bf(s); s = s * d[i] + v[i]; }
        }
    }
}
__device__ __forceinline__ void ssd_s3_job(const SsdCtx& C, LAS unsigned char* lds, int b, int c, int g) {
    int tid_ = threadIdx.x; asm volatile("" : "+v"(tid_)); const int tid = tid_, lane = tid & 63, wave = tid >> 6;
    LAS bf16_t* Cn = (LAS bf16_t*)lds; LAS bf16_t* CBm = (LAS bf16_t*)(lds + 128 * PIT * 2); LAS bf16_t* Bn = (LAS bf16_t*)(lds + 256 * PIT * 2); LAS bf16_t* XT = Bn;
    LAS float* dtT = (LAS float*)(lds + 139264); LAS float* acs = dtT + 512; LAS float* red = dtT + 1024;
    const long row0 = (long)b * SEQ + c * 128;
    { const int tok = tid >> 2, hh = tid & 3; dtT[hh * 128 + tok] = C.dtbuf[(size_t)(row0 + tok) * 8 + 4 * g + hh]; }
    __syncthreads();
    { const float Ah = wave < 4 ? -__expf(C.a_log[4 * g + wave]) : 0.f; (void)chunk_cumsum(dtT, acs, wave, lane, Ah); }
    {
        ConvIn v[4];
#pragma unroll
        for (int k = 0; k < 4; ++k) { const int idx = tid + 512 * k, cp = idx & 127, r = idx >> 7; const int xch = cp < 64 ? 512 + g * 128 + 2 * cp : 768 + g * 128 + 2 * (cp - 64);
            conv_load(C.proj, row0, 8 * r, c == 0, 512 + xch, C.cw, C.cb, xch, v[k]); }
#pragma unroll
        for (int k = 0; k < 4; ++k) { const int idx = tid + 512 * k, cp = idx & 127, r = idx >> 7; const bool isB = cp < 64;
            const int xch = isB ? 512 + g * 128 + 2 * cp : 768 + g * 128 + 2 * (cp - 64);
            float o0[8], o1[8];
            conv_apply(v[k], o0, o1);
            LAS bf16_t* dst = (isB ? Bn + 2 * cp : Cn + 2 * (cp - 64)) + (8 * r) * PIT;
#pragma unroll
            for (int i = 0; i < 8; ++i) *(LAS unsigned*)(dst + i * PIT) = cvt_pk_bf16(o0[i], o1[i]); }
    }
    ConvIn vx[4];
#pragma unroll
    for (int k = 0; k < 4; ++k) { const int idx = tid + 512 * k, cp = idx & 127, r = idx >> 7; conv_load(C.proj, row0, 8 * r, c == 0, 512 + g * 256 + 2 * cp, C.cw, C.cb, g * 256 + 2 * cp, vx[k]); }
    __syncthreads();
    {
        const int mi = wave >> 1, r = lane & 31, hq = lane >> 5;
        f32x16 acc[2];
#pragma unroll
        for (int j = 0; j < 2; ++j)
#pragma unroll
            for (int e = 0; e < 16; ++e) acc[j][e] = 0.f;
#pragma unroll 2
        for (int ks = 0; ks < 8; ++ks) {
            const bf16x8 a = *(const LAS bf16x8*)(Cn + (32 * mi + r) * PIT + 16 * ks + 8 * hq);
#pragma unroll
            for (int j = 0; j < 2; ++j) { const int ni = 2 * (wave & 1) + j; const bf16x8 bb = *(const LAS bf16x8*)(Bn + (32 * ni + r) * PIT + 16 * ks + 8 * hq); acc[j] = MFMA32(a, bb, acc[j]); }
        }
#pragma unroll
        for (int j = 0; j < 2; ++j) { const int ni = 2 * (wave & 1) + j;
#pragma unroll
            for (int e = 0; e < 16; ++e) { const int l = 32 * mi + (e & 3) + 8 * (e >> 2) + 4 * hq; CBm[l * PIT + 32 * ni + r] = f2bf(acc[j][e]); } }
    }
    __syncthreads();
#pragma unroll
    for (int k = 0; k < 4; ++k) { const int idx = tid + 512 * k, cp = idx & 127, r = idx >> 7; const int xch = g * 256 + 2 * cp;
        float o0[8], o1[8];
        conv_apply(vx[k], o0, o1);
        LAS bf16_t* dst = XT + (2 * cp) * PIT + 8 * r;
        u32x4 w0, w1; w0.x = cvt_pk_bf16(o0[0], o0[1]); w0.y = cvt_pk_bf16(o0[2], o0[3]); w0.z = cvt_pk_bf16(o0[4], o0[5]); w0.w = cvt_pk_bf16(o0[6], o0[7]);
        w1.x = cvt_pk_bf16(o1[0], o1[1]); w1.y = cvt_pk_bf16(o1[2], o1[3]); w1.z = cvt_pk_bf16(o1[4], o1[5]); w1.w = cvt_pk_bf16(o1[6], o1[7]);
        *(LAS u32x4*)dst = w0; *(LAS u32x4*)(dst + PIT) = w1; }
    __syncthreads();
    const int hh = wave >> 1, lh = wave & 1, r = lane & 31, hq = lane >> 5, h = 4 * g + hh;
    f32x16 acc[2][2];
#pragma unroll
    for (int i = 0; i < 2; ++i)
#pragma unroll
        for (int j = 0; j < 2; ++j)
#pragma unroll
            for (int e = 0; e < 16; ++e) acc[i][j][e] = 0.f;
    constexpr int ZP = 264;
    LAS bf16_t* zbuf = (LAS bf16_t*)lds;
    u32x4 zr[8];
#pragma unroll
    for (int k = 0; k < 8; ++k) { const int pc = tid + 512 * k, zrow = pc >> 5, c16 = pc & 31; zr[k] = *(const u32x4*)(C.proj + (size_t)(row0 + zrow) * NPROJ + g * 256 + c16 * 8); }
    {
        const bf16_t* pv = C.states + ((size_t)(b * 128 + c) * 8 + h) * 64 * 128;
        bf16x8 pa[8][2];
#pragma unroll
        for (int ks = 0; ks < 8; ++ks)
#pragma unroll
            for (int i = 0; i < 2; ++i) pa[ks][i] = *(const bf16x8*)(pv + (32 * i + r) * 128 + 64 * hq + 8 * ks);
#pragma unroll
        for (int ks = 0; ks < 8; ++ks) {
            bf16x8 bb[2];
#pragma unroll
            for (int i = 0; i < 2; ++i) bb[i] = *(const LAS bf16x8*)(Cn + (64 * lh + 32 * i + r) * PIT + 64 * hq + 8 * ks);
#pragma unroll
            for (int i = 0; i < 2; ++i)
#pragma unroll
                for (int j = 0; j < 2; ++j) acc[i][j] = MFMA32(pa[ks][i], bb[j], acc[i][j]);
        }
#pragma unroll
        for (int j = 0; j < 2; ++j) { const float el = __expf(acs[hh * 128 + 64 * lh + 32 * j + r]);
#pragma unroll
            for (int i = 0; i < 2; ++i)
#pragma unroll
                for (int e = 0; e < 16; ++e) acc[i][j][e] *= el; }
    }
#pragma unroll
    for (int li = 0; li < 2; ++li) {
        const int l = 64 * lh + 32 * li + r; const float al = acs[hh * 128 + l];
        const int nks = 4 * lh + 2 * li + 2;
#pragma unroll 2
        for (int ks = 0; ks < nks; ++ks) {
            const int s0 = 16 * ks + 8 * hq;
            const u32x4 cb = *(const LAS u32x4*)(CBm + l * PIT + s0);
            const f32x4 as0 = *(const LAS f32x4*)(acs + hh * 128 + s0), as1 = *(const LAS f32x4*)(acs + hh * 128 + s0 + 4);
            const f32x4 d0 = *(const LAS f32x4*)(dtT + hh * 128 + s0), d1 = *(const LAS f32x4*)(dtT + hh * 128 + s0 + 4);
            float m[8];
            m[0] = bf_lo(cb.x) * __expf(al - as0[0]) * d0[0]; m[1] = bf_hi(cb.x) * __expf(al - as0[1]) * d0[1];
            m[2] = bf_lo(cb.y) * __expf(al - as0[2]) * d0[2]; m[3] = bf_hi(cb.y) * __expf(al - as0[3]) * d0[3];
            m[4] = bf_lo(cb.z) * __expf(al - as1[0]) * d1[0]; m[5] = bf_hi(cb.z) * __expf(al - as1[1]) * d1[1];
            m[6] = bf_lo(cb.w) * __expf(al - as1[2]) * d1[2]; m[7] = bf_hi(cb.w) * __expf(al - as1[3]) * d1[3];
#pragma unroll
            for (int j = 0; j < 8; ++j) m[j] = (s0 + j <= l) ? m[j] : 0.f;
            u32x4 mw; mw.x = cvt_pk_bf16(m[0], m[1]); mw.y = cvt_pk_bf16(m[2], m[3]); mw.z = cvt_pk_bf16(m[4], m[5]); mw.w = cvt_pk_bf16(m[6], m[7]);
            const bf16x8 mf = __builtin_bit_cast(bf16x8, mw);
#pragma unroll
            for (int pi = 0; pi < 2; ++pi) { const bf16x8 a = *(const LAS bf16x8*)(XT + (64 * hh + 32 * pi + r) * PIT + s0); acc[pi][li] = MFMA32(a, mf, acc[pi][li]); }
        }
    }
    __syncthreads();
#pragma unroll
    for (int k = 0; k < 8; ++k) { const int pc = tid + 512 * k, zrow = pc >> 5, c16 = pc & 31; *(LAS u32x4*)(zbuf + zrow * ZP + c16 * 8) = zr[k]; }
    __syncthreads();
    const float Dh = C.d_skip[h];
    float sq[2] = {0.f, 0.f};
#pragma unroll
    for (int li = 0; li < 2; ++li) { const int l = 64 * lh + 32 * li + r;
#pragma unroll
        for (int pi = 0; pi < 2; ++pi)
#pragma unroll
            for (int e4 = 0; e4 < 4; ++e4) { const int p0 = 32 * pi + 8 * e4 + 4 * hq;
                const u32x2 zz = *(const LAS u32x2*)(zbuf + l * ZP + hh * 64 + p0);
                const float zf[4] = {bf_lo(zz.x), bf_hi(zz.x), bf_lo(zz.y), bf_hi(zz.y)};
#pragma unroll
                for (int k = 0; k < 4; ++k) { const float xs = bf2f(XT[(64 * hh + p0 + k) * PIT + l]); float y = acc[pi][li][4 * e4 + k] + xs * Dh; y *= silu_f(zf[k]); acc[pi][li][4 * e4 + k] = y; sq[li] += y * y; } }
        sq[li] += __shfl_xor(sq[li], 32);
        if (hq == 0) red[hh * 128 + l] = sq[li]; }
    __syncthreads();
#pragma unroll
    for (int li = 0; li < 2; ++li) { const int l = 64 * lh + 32 * li + r;
        const float rstd = rsqrtf((red[l] + red[128 + l] + red[256 + l] + red[384 + l]) * (1.f / 256.f) + EPS);
#pragma unroll
        for (int pi = 0; pi < 2; ++pi)
#pragma unroll
            for (int e4 = 0; e4 < 4; ++e4) { const int p0 = 32 * pi + 8 * e4 + 4 * hq, ch = g * 256 + hh * 64 + p0;
                const f32x4 ng = *(const f32x4*)(C.norm_g + ch);
                u32x2 w; w.x = cvt_pk_bf16(acc[pi][li][4 * e4] * rstd * ng[0], acc[pi][li][4 * e4 + 1] * rstd * ng[1]); w.y = cvt_pk_bf16(acc[pi][li][4 * e4 + 2] * rstd * ng[2], acc[pi][li][4 * e4 + 3] * rstd * ng[3]);
                *(LAS u32x2*)(zbuf + l * ZP + hh * 64 + p0) = w; } }
    __syncthreads();
#pragma unroll
    for (int k = 0; k < 8; ++k) { const int pc = tid + 512 * k, zrow = pc >> 5, c16 = pc & 31; *(u32x4*)(C.mix + (size_t)(row0 + zrow) * D + g * 256 + c16 * 8) = *(const LAS u32x4*)(zbuf + zrow * ZP + c16 * 8); }
    __syncthreads();
}

struct FixIn { f32x2 tm2[2], tm1[2], h0[2], h1[2], w0[2], w1[2], w2[2], bb[2]; };
__device__ __forceinline__ void fix_load(const float* head, const float* tail, const float* cw, const float* cb, int s, int j, FixIn& f) {
    const bool first = (s & 255) == 0;
#pragma unroll
    for (int gv = 0; gv < 2; ++gv) { const int col = j + gv * DFF; const f32x2 z = {0.f, 0.f};
        f.tm2[gv] = first ? z : *(const f32x2*)(tail + (size_t)((s - 1) * 2) * DUP + col); f.tm1[gv] = first ? z : *(const f32x2*)(tail + (size_t)((s - 1) * 2 + 1) * DUP + col);
        f.h0[gv] = *(const f32x2*)(head + (size_t)(s * 2) * DUP + col); f.h1[gv] = *(const f32x2*)(head + (size_t)(s * 2 + 1) * DUP + col);
        f.w0[gv] = *(const f32x2*)(cw + col); f.w1[gv] = *(const f32x2*)(cw + DUP + col); f.w2[gv] = *(const f32x2*)(cw + 2 * DUP + col); f.bb[gv] = *(const f32x2*)(cb + col); }
}
__device__ __forceinline__ void fix_apply(const FixIn& f, bf16_t* act, int s, int j) {
    f32x2 c0[2], c1[2];
#pragma unroll
    for (int gv = 0; gv < 2; ++gv) { c0[gv] = f.bb[gv] + f.w0[gv] * f.tm2[gv] + f.w1[gv] * f.tm1[gv] + f.w2[gv] * f.h0[gv]; c1[gv] = f.bb[gv] + f.w0[gv] * f.tm1[gv] + f.w1[gv] * f.h0[gv] + f.w2[gv] * f.h1[gv]; }
    *(unsigned*)(act + (size_t)(64 * s) * DFF + j) = cvt_pk_bf16(gelu_tanh(c0[0].x) * c0[1].x, gelu_tanh(c0[0].y) * c0[1].y);
    *(unsigned*)(act + (size_t)(64 * s + 1) * DFF + j) = cvt_pk_bf16(gelu_tanh(c1[0].x) * c1[1].x, gelu_tanh(c1[0].y) * c1[1].y);
}
__device__ __forceinline__ void fixup_phase(const Params& P, int l, bf16_t* act, const float* head, const float* tail, int G, int bid) {
    const float* cw = P.fconv_w + (size_t)l * 3 * DUP; const float* cb = P.fconv_b + (size_t)l * DUP;
    int tid_ = threadIdx.x; asm volatile("" : "+v"(tid_)); const int gt = bid * 512 + tid_, NT = G * 512;
    constexpr int NI = 512 * (DFF / 2);
    for (int idx = gt; idx < NI; idx += 2 * NT) {
        const int i2 = idx + NT; const bool two = i2 < NI;
        FixIn f0, f1;
        fix_load(head, tail, cw, cb, idx / (DFF / 2), 2 * (idx % (DFF / 2)), f0);
        if (two) fix_load(head, tail, cw, cb, i2 / (DFF / 2), 2 * (i2 % (DFF / 2)), f1);
        fix_apply(f0, act, idx / (DFF / 2), 2 * (idx % (DFF / 2)));
        if (two) fix_apply(f1, act, i2 / (DFF / 2), 2 * (i2 % (DFF / 2)));
    }
}

#define XB_TMO      128
#define XB_XCNT(j)  (256  + 64 * (j))
#define XB_XSUB(j)  (1280 + 64 * (j))
#define XB_XGEN(j)  (2304 + 64 * (j))
#define XB_TOP      3328
#define XB_TOPGEN   3392
#define XCD_BAR_WORDS 3456
#define XB_SPIN_CAP (1u << 18)

__device__ __forceinline__ unsigned xb_ld(unsigned* p)              { return __hip_atomic_load(p, __ATOMIC_RELAXED, __HIP_MEMORY_SCOPE_AGENT); }
__device__ __forceinline__ unsigned xb_add(unsigned* p, unsigned v) { return __hip_atomic_fetch_add(p, v, __ATOMIC_RELAXED, __HIP_MEMORY_SCOPE_AGENT); }
__device__ __forceinline__ unsigned xb_xcc_id() { return (unsigned)__builtin_amdgcn_s_getreg((3 << 11) | 20) & 0xFu; }
#define XB_SPIN(cond, bar) do { unsigned _sp = 0; while (cond) { __builtin_amdgcn_s_sleep(1); \
    if ((++_sp & 255u) == 0u) { if (xb_ld(&(bar)[XB_TMO])) break; if (_sp > XB_SPIN_CAP) { atomicAdd(&(bar)[XB_TMO], 1u); break; } } } } while (0)

struct XcdBarrier {
    unsigned* bar; unsigned x;
    volatile LAS unsigned* st;
};

__device__ __forceinline__ XcdBarrier xcd_barrier_post(unsigned* bar, volatile LAS unsigned* st) {
    XcdBarrier b; b.bar = bar; b.x = xb_xcc_id(); b.st = st;
    if (threadIdx.x == 0) (void)xb_add(&bar[XB_XCNT(b.x)], 1u);
    return b;
}
__device__ __forceinline__ void xcd_barrier_complete(unsigned* bar, unsigned x, unsigned& nloc, unsigned& nx) {
    const unsigned G = gridDim.x * gridDim.y * gridDim.z;
    unsigned sum, cnt, mine, sp = 0u;
    for (;;) {
        sum = 0u; cnt = 0u; mine = 0u;
#pragma unroll
        for (unsigned j = 0; j < 16; ++j) { const unsigned c = xb_ld(&bar[XB_XCNT(j)]); sum += c; cnt += (c > 0u) ? 1u : 0u; mine = (j == x) ? c : mine; }
        if (sum == G) break;
        __builtin_amdgcn_s_sleep(1);
        if ((++sp & 255u) == 0u) { if (xb_ld(&bar[XB_TMO])) break; if (sp > XB_SPIN_CAP) { atomicAdd(&bar[XB_TMO], 1u); break; } }
    }
    nloc = mine > 0u ? mine : 1u; nx = cnt > 0u ? cnt : 1u;
}

__device__ __forceinline__ void xcd_barrier(const XcdBarrier& b) {
    asm volatile("s_waitcnt vmcnt(0)" ::: "memory");
    __syncthreads();
    if (threadIdx.x == 0) {
        unsigned* bar = b.bar;
        __builtin_amdgcn_s_waitcnt(0);
        unsigned nloc = b.st[0], nx = b.st[1];
        if (nloc == 0u) { xcd_barrier_complete(bar, b.x, nloc, nx); b.st[0] = nloc; b.st[1] = nx; }
        const unsigned old = xb_add(&bar[XB_XSUB(b.x)], 1u);
        const unsigned gen = old / nloc;
        if (old + 1u == (gen + 1u) * nloc) {
            __builtin_amdgcn_fence(__ATOMIC_RELEASE, "agent");
            asm volatile("s_waitcnt vmcnt(0)" ::: "memory");
            const unsigned og = xb_add(&bar[XB_TOP], 1u);
            const unsigned tg = og / nx;
            if (og + 1u == (tg + 1u) * nx) xb_add(&bar[XB_TOPGEN], 1u);
            else XB_SPIN(xb_ld(&bar[XB_TOPGEN]) == tg, bar);
            __builtin_amdgcn_fence(__ATOMIC_ACQUIRE, "agent");
            xb_add(&bar[XB_XGEN(b.x)], 1u);
            asm volatile("s_waitcnt vmcnt(0)" ::: "memory");
        } else {
            XB_SPIN(xb_ld(&bar[XB_XGEN(b.x)]) == gen, bar);
            __builtin_amdgcn_fence(__ATOMIC_ACQUIRE, "agent");
            asm volatile("s_waitcnt vmcnt(0)" ::: "memory");
        }
    }
    __syncthreads();
}


__global__ __launch_bounds__(512, 2) void hymba_fwd(Params P) {
    extern __shared__ __attribute__((aligned(16))) unsigned char shm[];
    LAS unsigned char* lds = (LAS unsigned char*)shm;
    cg::grid_group grid = cg::this_grid();
    const int G = (int)gridDim.x, bid = (int)blockIdx.x;
    bf16_t* hbuf[2] = {(bf16_t*)(P.ws + OFF_HB0), (bf16_t*)(P.ws + OFF_HB1)};
    float* ssbuf[2] = {(float*)(P.ws + OFF_SS), (float*)(P.ws + OFF_SS) + (size_t)T * 16};
    bf16_t* wt = (bf16_t*)(P.ws + OFF_WT);
    bf16_t* proj = (bf16_t*)(P.ws + OFF_R); bf16_t* act = proj; bf16_t* states = (bf16_t*)(P.ws + OFF_ST);
    bf16_t* mix = (bf16_t*)(P.ws + OFF_MIX); bf16_t* qb = mix; float* head = (float*)(P.ws + OFF_MIX); float* tail = (float*)(P.ws + OFF_TAIL);
    bf16_t* pball = (bf16_t*)P.out;
    float* dtbuf = (float*)(P.ws + OFF_DT); float* cdecay = (float*)(P.ws + OFF_CD);
    pg8::StaticOrder S;
    volatile LAS unsigned* xst = (volatile LAS unsigned*)(lds + LDS_BYTES - 16);
    if (threadIdx.x == 0) { xst[0] = 0u; xst[1] = 0u; }
    __syncthreads();
    const XcdBarrier xb = xcd_barrier_post((unsigned*)(P.ws + OFF_BAR), xst);

    phase0(P, lds, G, bid);
    grid.sync();
    int cur = 0;
#pragma unroll 1
    for (int l = 0; l < NL; ++l) {
        const bf16_t* wl = wt + (size_t)l * WLAYER;
        bf16_t* hb = cur ? hbuf[1] : hbuf[0]; bf16_t* hbn = cur ? hbuf[0] : hbuf[1];
        float* ss = cur ? ssbuf[1] : ssbuf[0]; float* ssn = cur ? ssbuf[0] : ssbuf[1];
        { RsOrder<false> SR; SR.init(T, NPROJ, G, bid); SR.ss = ss; SR.rsbuf = (LAS float*)(lds + 139264); SR.cw = nullptr; SR.cb = nullptr; SR.pbuf = nullptr; SR.na = 0;
          EpiIn E{proj, (const LAS float*)(lds + 139264), 0}; pg8::gemm_phase<EpiIn, RsOrder<false>, true, true>(lds, pg8::Gemm{hb, wl + WIN, T, NPROJ, D}, SR, E); }
        xcd_barrier(xb);
        SsdCtx C{proj, hb, ss, wl + WDT, P.conv_w + (size_t)l * 4 * 1024, P.conv_b + (size_t)l * 1024, P.dt_bias + l * 8, P.a_log + l * 8, P.d_skip + l * 8, P.norm_g + l * 512,
                 states, dtbuf, cdecay, mix, wl + WPOOL};
        for (int ch = bid; ch < 256; ch += G) ssd_s1_chunk(C, lds, ch >> 7, ch & 127);
        for (int tb = bid; tb < 256; tb += G) pool_job(C, tb);
        xcd_barrier(xb);
        scan_phase(states, cdecay, G, bid);
        xcd_barrier(xb);
        for (int job = bid; job < 512; job += G) ssd_s3_job(C, lds, job >> 8, (job >> 1) & 127, job & 1);
        xcd_barrier(xb);
        { S.init(T, D, G, bid); EpiRes<false> E{hb, hb, ss, nullptr, nullptr}; pg8::gemm_phase<EpiRes<false>, pg8::StaticOrder, true, true>(lds, pg8::Gemm{mix, wl + WOUT, T, D, D}, S, E); }
        xcd_barrier(xb);
        { RsOrder<true> SU; SU.init(T, DUP, G, bid); SU.ss = ss; SU.rsbuf = (LAS float*)(lds + 139264); SU.cw = P.fconv_w + (size_t)l * 3 * DUP; SU.cb = P.fconv_b + (size_t)l * DUP; SU.pbuf = (LAS float*)(lds + 131072); SU.na = 0;
          EpiUp E{act, (const LAS float*)(lds + 139264), (const LAS float*)(lds + 131072), head, tail, 0}; pg8::gemm_phase<EpiUp, RsOrder<true>, true, true>(lds, pg8::Gemm{hb, wl + WUP, T, DUP, D}, SU, E); }
        xcd_barrier(xb);
        fixup_phase(P, l, act, head, tail, G, bid);
        xcd_barrier(xb);
        { S.init(T, D, G, bid); EpiRes<false> E{hb, hb, ss, nullptr, nullptr}; pg8::gemm_phase<EpiRes<false>, pg8::StaticOrder, true, true>(lds, pg8::Gemm{act, wl + WDOWN, T, D, DFF}, S, E); }
        { S.init(T, D, G, bid); EpiQ E{qb}; pg8::gemm_phase<EpiQ, pg8::StaticOrder, true, true>(lds, pg8::Gemm{pball + (size_t)l * T * DPLE, wl + WPLE, T, D, DPLE}, S, E); }
        xcd_barrier(xb);
        { S.init(T, D, G, bid); EpiRes<true> E{hb, hbn, ssn, ss, qb}; pg8::gemm_phase<EpiRes<true>, pg8::StaticOrder, true, true>(lds, pg8::Gemm{hb, wl + WGATE, T, D, D}, S, E); }
        xcd_barrier(xb);
        cur ^= 1;
    }
    {
        const int lane = threadIdx.x & 63, wave = threadIdx.x >> 6;
        const float* ss = cur ? ssbuf[1] : ssbuf[0]; const bf16_t* hb = cur ? hbuf[1] : hbuf[0];
        for (int row = bid * 8 + wave; row < T; row += G * 8) {
            const float rs = row_rstd(ss, row); const u32x2* hr = (const u32x2*)(hb + (size_t)row * D) + lane; f32x4* xr = (f32x4*)(P.out + (size_t)row * D) + lane; const f32x4* gr = (const f32x4*)P.final_g + lane;
#pragma unroll
            for (int j = 0; j < 4; ++j) { const u32x2 hh = hr[64 * j]; const f32x4 gg = gr[64 * j]; f32x4 v = {bf_lo(hh.x), bf_hi(hh.x), bf_lo(hh.y), bf_hi(hh.y)}; v = v * rs * gg; xr[64 * j] = v; }
        }
    }
}

extern "C" void kernel_launch(void* const* d_in, const int* in_sizes, int n_in, void* d_out, int out_size, void* d_ws, size_t ws_size, hipStream_t stream) {
    static int grid = 0;
    if (grid == 0) {
        if (n_in != 22 || ws_size < WS_END) { fprintf(stderr, "kernel_launch: unexpected inputs (n_in %d, ws %zu, need %zu)\n", n_in, ws_size, (size_t)WS_END); grid = -1; return; }
        int dev = 0, cus = 0, per_cu = 0;
        (void)hipGetDevice(&dev); (void)hipDeviceGetAttribute(&cus, hipDeviceAttributeMultiprocessorCount, dev);
        if (hipFuncSetAttribute((const void*)hymba_fwd, hipFuncAttributeMaxDynamicSharedMemorySize, LDS_BYTES) != hipSuccess) { fprintf(stderr, "kernel_launch: hipFuncSetAttribute failed\n"); grid = -1; return; }
        if (hipOccupancyMaxActiveBlocksPerMultiprocessor(&per_cu, (const void*)hymba_fwd, 512, LDS_BYTES) != hipSuccess || per_cu < 1) { fprintf(stderr, "kernel_launch: occupancy query says %d blocks per CU\n", per_cu); per_cu = 1; }
        (void)hipGetLastError();
        grid = cus;
    }
    if (grid < 0) return;
    Params p{};
    const float** pp = (const float**)&p;
    for (int i = 0; i < 22; ++i) pp[i] = (const float*)d_in[i];
    p.out = (float*)d_out; p.ws = (unsigned char*)d_ws;
    if (hipMemsetAsync((char*)d_ws + OFF_BAR, 0, 16384, stream) != hipSuccess) { fprintf(stderr, "kernel_launch: memset failed\n"); return; }
    void* args[] = {&p};
    hipError_t e = hipLaunchCooperativeKernel((const void*)hymba_fwd, dim3(grid), dim3(512), args, LDS_BYTES, stream);
    if (e != hipSuccess) fprintf(stderr, "cooperative launch failed: %s (grid %d)\n", hipGetErrorString(e), grid);
}
```
